# Optimizing an MI355X kernel written in HIP

```python
import math
import jax, jax.numpy as jnp
from jax import lax
import numpy as np

D_MODEL = 1024
BATCH = 8
SEQ = 4096
DEPTH = 2

HEAD_DIM = 64
A_HEADS = 8
A_KV = 2
A_REP = A_HEADS // A_KV
A_WINDOW = 128
A_BLOCK = 128
B_HEADS = 8
B_KV = 2
B_REP = B_HEADS // B_KV
CMP_LEN = 32
CMP_STRIDE = 16
CMP_HIDDEN = 256
SEL_BLOCK = 64
SEL_TOPN = 16
SEL_Q_CHUNK = 64
B_WINDOW = 512
B_WIN_BLOCK = 128
N_BUCKETS = 32
MAX_EXACT = 16
MAX_DIST = 128
TOTAL_HEADS = A_HEADS + B_HEADS
N_GROUPS = 4
EXPERTS_PER_GROUP = 8
N_EXPERTS = N_GROUPS * EXPERTS_PER_GROUP
TOP_K_IN_GROUP = 2
EXPERT_FF = 512
MOE_BLOCK = 128

RMS_EPS = 1e-5
NEG = -1e30
FORCE = 1e9

A_QW = A_HEADS * HEAD_DIM
A_KVW = A_KV * HEAD_DIM
B_QW = B_HEADS * HEAD_DIM
B_KVW = B_KV * HEAD_DIM
IN_SIZES = (A_QW, A_KVW, A_KVW, B_QW, B_KVW, B_KVW, B_KVW, B_KVW, B_KVW, B_KVW, 3 * B_HEADS, 2 * D_MODEL)
IN_COLS = sum(IN_SIZES)

kernel_name = "hybrid_swa_sink_nsa_hier_moe"


def rmsnorm(x, g):
    xf = x.astype(jnp.float32)
    y = xf * lax.rsqrt(jnp.mean(xf * xf, axis=-1, keepdims=True) + RMS_EPS)
    return y.astype(x.dtype) * g


def t5_bucket(dist):
    n = jnp.maximum(dist, 0)
    nf = jnp.maximum(n, 1).astype(jnp.float32)
    large = MAX_EXACT + (jnp.log(nf / MAX_EXACT) / math.log(MAX_DIST / MAX_EXACT)
                         * (N_BUCKETS - MAX_EXACT)).astype(jnp.int32)
    large = jnp.minimum(large, N_BUCKETS - 1)
    return jnp.where(n < MAX_EXACT, n, large)


def softmax_with_sink(s, sink):
    sink = sink.astype(jnp.float32)
    m = jnp.maximum(jnp.max(s, axis=-1, keepdims=True), sink)
    e = jnp.exp(s - m)
    return e / (jnp.sum(e, axis=-1, keepdims=True) + jnp.exp(sink - m))


def banded_attention(q, k, v, window, block, bias_tab, sinks):
    B, S, G, R, Dh = q.shape
    nb = S // block
    npv = -(-(window - 1) // block)
    L = (npv + 1) * block
    qb = q.reshape(B, nb, block, G, R, Dh)
    pad = ((0, 0), (npv * block, 0), (0, 0), (0, 0))
    kp = jnp.pad(k, pad)
    vp = jnp.pad(v, pad)
    kidx = jnp.arange(nb)[:, None] * block + jnp.arange(L)[None, :]
    kb = kp[:, kidx]
    vb = vp[:, kidx]
    qpos = jnp.arange(nb)[:, None] * block + jnp.arange(block)[None, :]
    kpos = kidx - npv * block
    dist = qpos[:, :, None] - kpos[:, None, :]
    valid = (dist >= 0) & (dist < window) & (kpos[:, None, :] >= 0)
    bias = bias_tab[t5_bucket(dist)].reshape(nb, block, L, G, R)
    bias = jnp.transpose(bias, (3, 4, 0, 1, 2)).astype(jnp.float32)
    s = jnp.einsum('bnqgrd,bnkgd->bgrnqk', qb, kb).astype(jnp.float32) * (Dh ** -0.5) + bias
    s = jnp.where(valid, s, NEG)
    if sinks is None:
        p = jax.nn.softmax(s, axis=-1)
    else:
        p = softmax_with_sink(s, sinks.reshape(G, R, 1, 1, 1))
    o = jnp.einsum('bgrnqk,bnkgd->bnqgrd', p.astype(v.dtype), vb)
    return o.reshape(B, S, G * R * Dh)


def nsa_compressed_selected(q, kc, vc, ks, vs, pos_k, w1_k, w2_k, pos_v, w1_v, w2_v, bias_tab):
    B, S, G, R, Dh = q.shape
    nc = (S - CMP_LEN) // CMP_STRIDE + 1
    ns = S // SEL_BLOCK
    n_sel = min(SEL_TOPN, ns)
    cidx = jnp.arange(nc)[:, None] * CMP_STRIDE + jnp.arange(CMP_LEN)[None, :]

    def compress(t, pos, w1, w2):
        blocks = t[:, cidx] + pos[:, None, :]
        blocks = jnp.transpose(blocks, (0, 3, 1, 2, 4)).reshape(B, G, nc, CMP_LEN * Dh)
        return jax.nn.gelu(blocks @ w1) @ w2

    kcmp = compress(kc, pos_k, w1_k, w2_k)
    vcmp = compress(vc, pos_v, w1_v, w2_v)
    cstart = jnp.arange(nc) * CMP_STRIDE
    cend = cstart + CMP_LEN - 1
    sstart = jnp.arange(ns) * SEL_BLOCK
    overlap = ((cstart[:, None] < sstart[None, :] + SEL_BLOCK)
               & (cstart[:, None] + CMP_LEN > sstart[None, :])).astype(jnp.float32)
    ksb = jnp.transpose(ks.reshape(B, ns, SEL_BLOCK, G, Dh), (0, 3, 1, 2, 4))
    vsb = jnp.transpose(vs.reshape(B, ns, SEL_BLOCK, G, Dh), (0, 3, 1, 2, 4))
    tab = jnp.transpose(bias_tab.reshape(N_BUCKETS, G, R), (1, 0, 2))
    nq = S // SEL_Q_CHUNK
    qch = jnp.moveaxis(q.reshape(B, nq, SEL_Q_CHUNK, G, R, Dh), 1, 0)
    bi = jnp.arange(B)[:, None, None, None]
    gi = jnp.arange(G)[None, :, None, None]
    scale = Dh ** -0.5
    jsel = jnp.arange(ns)

    def chunk(args):
        qc, c = args
        t = c * SEL_Q_CHUNK + jnp.arange(SEL_Q_CHUNK)
        sc = jnp.einsum('bqgrd,bgnd->bgrqn', qc, kcmp).astype(jnp.float32) * scale
        cvalid = cend[None, :] <= t[:, None]
        pc = jax.nn.softmax(jnp.where(cvalid, sc, NEG), axis=-1) * cvalid
        o_cmp = jnp.einsum('bgrqn,bgnd->bqgrd', pc.astype(vcmp.dtype), vcmp)
        imp = jnp.einsum('bgrqn,nj->bgqj', pc, overlap)
        tb = t // SEL_BLOCK
        forced = (jsel[None, :] == 0) | (jsel[None, :] == tb[:, None]) | (jsel[None, :] == tb[:, None] - 1)
        causal = sstart[None, :] <= t[:, None]
        imp = jnp.where(causal, jnp.where(forced, FORCE, imp), NEG)
        top_val, top_idx = lax.top_k(imp, n_sel)
        sel_ok = top_val > NEG * 0.5
        kg = ksb[bi, gi, top_idx]
        vg = vsb[bi, gi, top_idx]
        kpos = top_idx[..., None] * SEL_BLOCK + jnp.arange(SEL_BLOCK)
        dist = t[:, None, None] - kpos
        svalid = sel_ok[..., None] & (dist >= 0)
        bias = tab[gi[..., None], t5_bucket(dist)]
        ss = (jnp.einsum('bqgrd,bgqnkd->bgrqnk', qc, kg).astype(jnp.float32) * scale
              + jnp.moveaxis(bias, -1, 2).astype(jnp.float32))
        ss = jnp.where(svalid[:, :, None], ss, NEG)
        ps = jax.nn.softmax(ss.reshape(B, G, R, SEL_Q_CHUNK, n_sel * SEL_BLOCK), axis=-1)
        ps = ps.reshape(B, G, R, SEL_Q_CHUNK, n_sel, SEL_BLOCK)
        o_slc = jnp.einsum('bgrqnk,bgqnkd->bqgrd', ps.astype(vg.dtype), vg)
        return o_cmp, o_slc

    o_cmp, o_slc = lax.map(chunk, (qch, jnp.arange(nq)))
    o_cmp = jnp.moveaxis(o_cmp, 0, 1).reshape(B, S, G * R * Dh)
    o_slc = jnp.moveaxis(o_slc, 0, 1).reshape(B, S, G * R * Dh)
    return o_cmp, o_slc


def hybrid_mixer(xn, w_in, a_sinks, cmp_pos_k, cmp_w1_k, cmp_w2_k, cmp_pos_v, cmp_w1_v, cmp_w2_v,
                 w_br_a, w_br_b, w_out, rel_bias):
    B, S, _ = xn.shape
    proj = xn @ w_in
    offs = np.cumsum(IN_SIZES)[:-1].tolist()
    aq, ak, av, bq, bkc, bvc, bks, bvs, bkw, bvw, bg, mg = jnp.split(proj, offs, axis=-1)
    o_a = banded_attention(aq.reshape(B, S, A_KV, A_REP, HEAD_DIM),
                           ak.reshape(B, S, A_KV, HEAD_DIM), av.reshape(B, S, A_KV, HEAD_DIM),
                           A_WINDOW, A_BLOCK, rel_bias[:, :A_HEADS], a_sinks)
    qb = bq.reshape(B, S, B_KV, B_REP, HEAD_DIM)
    kv = lambda t: t.reshape(B, S, B_KV, HEAD_DIM)
    bias_b = rel_bias[:, A_HEADS:]
    o_cmp, o_slc = nsa_compressed_selected(qb, kv(bkc), kv(bvc), kv(bks), kv(bvs),
                                           cmp_pos_k, cmp_w1_k, cmp_w2_k, cmp_pos_v, cmp_w1_v, cmp_w2_v,
                                           bias_b)
    o_win = banded_attention(qb, kv(bkw), kv(bvw), B_WINDOW, B_WIN_BLOCK, bias_b, None)
    gates = jax.nn.sigmoid(bg.astype(jnp.float32)).reshape(B, S, B_HEADS, 3)
    heads = lambda o: o.reshape(B, S, B_HEADS, HEAD_DIM)
    o_b = (gates[..., 0:1] * heads(o_cmp) + gates[..., 1:2] * heads(o_slc)
           + gates[..., 2:3] * heads(o_win)).astype(xn.dtype).reshape(B, S, B_QW)
    g_a, g_b = jnp.split(jax.nn.sigmoid(mg), 2, axis=-1)
    merged = g_a * (o_a @ w_br_a) + g_b * (o_b @ w_br_b)
    return merged @ w_out


def hier_moe(xn, w_group, b_group, w_expert, b_expert, w1, w3, w2):
    B, S, D = xn.shape
    T = B * S
    xt = xn.reshape(T, D)
    glog = (xt @ w_group).astype(jnp.float32) + b_group.astype(jnp.float32)
    gprob = jax.nn.softmax(glog, axis=-1)
    gsel = jnp.argmax(glog, axis=-1).astype(jnp.int32)
    gw = jnp.take_along_axis(gprob, gsel[:, None], axis=-1)
    elog = ((xt @ w_expert).astype(jnp.float32) + b_expert.astype(jnp.float32)).reshape(T, N_GROUPS, EXPERTS_PER_GROUP)
    elog_g = jnp.take_along_axis(elog, gsel[:, None, None], axis=1)[:, 0]
    ev, ei = lax.top_k(elog_g, TOP_K_IN_GROUP)
    ew = jax.nn.softmax(ev, axis=-1) * gw
    eid = gsel[:, None] * EXPERTS_PER_GROUP + ei.astype(jnp.int32)
    A = T * TOP_K_IN_GROUP
    e_flat = eid.reshape(A)
    w_flat = ew.reshape(A)
    tok = jnp.repeat(jnp.arange(T, dtype=jnp.int32), TOP_K_IN_GROUP)
    order = jnp.argsort(e_flat)
    e_s, tok_s, w_s = e_flat[order], tok[order], w_flat[order]
    counts = jnp.zeros((N_EXPERTS,), jnp.int32).at[e_flat].add(1)
    starts = jnp.cumsum(counts) - counts
    padded = (counts + MOE_BLOCK - 1) // MOE_BLOCK * MOE_BLOCK
    pstarts = jnp.cumsum(padded) - padded
    dest = pstarts[e_s] + (jnp.arange(A, dtype=jnp.int32) - starts[e_s])
    P = A + N_EXPERTS * MOE_BLOCK
    nblk = P // MOE_BLOCK
    buf_tok = jnp.full((P,), T, jnp.int32).at[dest].set(tok_s)
    buf_w = jnp.zeros((P,), jnp.float32).at[dest].set(w_s)
    blk_expert = jnp.clip(jnp.searchsorted(pstarts + padded, jnp.arange(nblk) * MOE_BLOCK, side='right'),
                          0, N_EXPERTS - 1)
    x_pad = jnp.concatenate([xt, jnp.zeros((1, D), xt.dtype)], axis=0)
    xin = x_pad[buf_tok].reshape(nblk, MOE_BLOCK, D)

    def expert_block(args):
        xb, e = args
        return (jax.nn.silu(xb @ w1[e]) * (xb @ w3[e])) @ w2[e]

    y = lax.map(expert_block, (xin, blk_expert)).reshape(P, D)
    out = jax.ops.segment_sum(y.astype(jnp.float32) * buf_w[:, None], buf_tok, num_segments=T + 1)[:T]
    return out.astype(xn.dtype).reshape(B, S, D)


def setup_inputs(seed: int = 0) -> dict:
    key = jax.random.key(seed)
    keys = iter(jax.random.split(key, 24))
    nrm = lambda shape, scale: jax.random.normal(next(keys), shape, jnp.float32) * scale
    L = DEPTH
    return {
        "x": nrm((BATCH, SEQ, D_MODEL), 1.0),
        "rel_bias": nrm((N_BUCKETS, TOTAL_HEADS), 0.5),
        "norm_mix": 1.0 + nrm((L, D_MODEL), 0.1),
        "w_in": nrm((L, D_MODEL, IN_COLS), D_MODEL ** -0.5),
        "a_sinks": nrm((L, A_HEADS), 0.5),
        "cmp_pos_k": nrm((L, CMP_LEN, HEAD_DIM), 0.5),
        "cmp_w1_k": nrm((L, CMP_LEN * HEAD_DIM, CMP_HIDDEN), (CMP_LEN * HEAD_DIM) ** -0.5),
        "cmp_w2_k": nrm((L, CMP_HIDDEN, HEAD_DIM), CMP_HIDDEN ** -0.5),
        "cmp_pos_v": nrm((L, CMP_LEN, HEAD_DIM), 0.5),
        "cmp_w1_v": nrm((L, CMP_LEN * HEAD_DIM, CMP_HIDDEN), (CMP_LEN * HEAD_DIM) ** -0.5),
        "cmp_w2_v": nrm((L, CMP_HIDDEN, HEAD_DIM), CMP_HIDDEN ** -0.5),
        "w_br_a": nrm((L, A_QW, D_MODEL), A_QW ** -0.5),
        "w_br_b": nrm((L, B_QW, D_MODEL), B_QW ** -0.5),
        "w_out": nrm((L, D_MODEL, D_MODEL), D_MODEL ** -0.5),
        "norm_ffn": 1.0 + nrm((L, D_MODEL), 0.1),
        "w_group": nrm((L, D_MODEL, N_GROUPS), D_MODEL ** -0.5),
        "b_group": nrm((L, N_GROUPS), 0.01),
        "w_expert": nrm((L, D_MODEL, N_EXPERTS), D_MODEL ** -0.5),
        "b_expert": nrm((L, N_EXPERTS), 0.01),
        "w1": nrm((L, N_EXPERTS, D_MODEL, EXPERT_FF), D_MODEL ** -0.5),
        "w3": nrm((L, N_EXPERTS, D_MODEL, EXPERT_FF), D_MODEL ** -0.5),
        "w2": nrm((L, N_EXPERTS, EXPERT_FF, D_MODEL), EXPERT_FF ** -0.5),
        "norm_final": 1.0 + nrm((D_MODEL,), 0.1),
    }


def reference(x, rel_bias, norm_mix, w_in, a_sinks, cmp_pos_k, cmp_w1_k, cmp_w2_k, cmp_pos_v, cmp_w1_v, cmp_w2_v,
              w_br_a, w_br_b, w_out, norm_ffn, w_group, b_group, w_expert, b_expert, w1, w3, w2, norm_final):
    h = x
    for l in range(DEPTH):
        hn = rmsnorm(h, norm_mix[l])
        h = h + hybrid_mixer(hn, w_in[l], a_sinks[l], cmp_pos_k[l], cmp_w1_k[l], cmp_w2_k[l],
                             cmp_pos_v[l], cmp_w1_v[l], cmp_w2_v[l], w_br_a[l], w_br_b[l], w_out[l], rel_bias)
        hn = rmsnorm(h, norm_ffn[l])
        h = h + hier_moe(hn, w_group[l], b_group[l], w_expert[l], b_expert[l], w1[l], w3[l], w2[l])
    return rmsnorm(h, norm_final)
```

```cpp
#include <string.h>
#include <hip/hip_runtime.h>
#include <stdint.h>

#define T_TOK 32768
#define SEQ 4096
#define DM 1024
#define INC 4120

__device__ const unsigned char kBucket[128] = {0, 1, 2, 3, 4, 5, 6, 7, 8, 9, 10, 11, 12, 13, 14, 15, 16, 16, 16, 17, 17, 18, 18, 18, 19, 19, 19, 20, 20, 20, 20, 21, 21, 21, 21, 22, 22, 22, 22, 22, 23, 23, 23, 23, 23, 23, 24, 24, 24, 24, 24, 24, 25, 25, 25, 25, 25, 25, 25, 26, 26, 26, 26, 26, 26, 26, 26, 27, 27, 27, 27, 27, 27, 27, 27, 27, 27, 28, 28, 28, 28, 28, 28, 28, 28, 28, 28, 29, 29, 29, 29, 29, 29, 29, 29, 29, 29, 29, 29, 30, 30, 30, 30, 30, 30, 30, 30, 30, 30, 30, 30, 30, 30, 31, 31, 31, 31, 31, 31, 31, 31, 31, 31, 31, 31, 31, 31, 31};

#define LAS __attribute__((address_space(3)))
typedef unsigned short bf16_t;
typedef short bf16x8 __attribute__((ext_vector_type(8)));
typedef float f32x4 __attribute__((ext_vector_type(4)));
typedef float f32x16 __attribute__((ext_vector_type(16)));
typedef unsigned u32x4 __attribute__((ext_vector_type(4)));
typedef unsigned u32x2 __attribute__((ext_vector_type(2)));


typedef unsigned u32x2s __attribute__((ext_vector_type(2)));
__device__ __forceinline__ float half_swap_max(float v) { const u32x2s r = __builtin_amdgcn_permlane32_swap(__float_as_uint(v), __float_as_uint(v), false, false); return fmaxf(__uint_as_float(r.x), __uint_as_float(r.y)); }
__device__ __forceinline__ float half_swap_sum(float v) { const u32x2s r = __builtin_amdgcn_permlane32_swap(__float_as_uint(v), __float_as_uint(v), false, false); return __uint_as_float(r.x) + __uint_as_float(r.y); }
__device__ __forceinline__ float half_other(float v, int hq) { const u32x2s r = __builtin_amdgcn_permlane32_swap(__float_as_uint(v), __float_as_uint(v), false, false); return __uint_as_float(hq ? r.x : r.y); }
template <int M> __device__ __forceinline__ float swz_xor(float v) { return __int_as_float(__builtin_amdgcn_ds_swizzle(__float_as_int(v), (M << 10) | 0x1f)); }
__device__ __forceinline__ float wave_sum_f(float v) {
    v += swz_xor<1>(v); v += swz_xor<2>(v); v += swz_xor<4>(v); v += swz_xor<8>(v); v += swz_xor<16>(v);
    return half_swap_sum(v);
}

#define NTHR 512
#define LDS_STAGE 131072
#define LDS_TAB_OFF 131072
#define LDS_MISC_OFF (131072 + 16384)
#define LDS_META_OFF (131072 + 16384 + 1024)
#define LDS_TOTAL (131072 + 16384 + 1024 + 12544)

#define QSCALE 0.18033688011112042f
#define LOG2E 1.4426950408889634f

__device__ __forceinline__ unsigned cvt_pk_bf16(float lo, float hi) { unsigned r; asm volatile("v_cvt_pk_bf16_f32 %0, %1, %2" : "=v"(r) : "v"(lo), "v"(hi)); return r; }
__device__ __forceinline__ float bf16_to_f(unsigned short b) { return __uint_as_float(((unsigned)b) << 16); }
__device__ __forceinline__ float bf16lo(unsigned w) { return __uint_as_float(w << 16); }
__device__ __forceinline__ float bf16hi(unsigned w) { return __uint_as_float(w & 0xffff0000u); }
__device__ __forceinline__ float fast_sigmoid(float x) { return __builtin_amdgcn_rcpf(1.0f + __builtin_amdgcn_exp2f(-1.4426950408889634f * x)); }

#define XB_TMO      128
#define XB_XCNT(j)  (256  + 64 * (j))
#define XB_XSUB(j)  (1280 + 64 * (j))
#define XB_XGEN(j)  (2304 + 64 * (j))
#define XB_TOP      3328
#define XB_TOPGEN   3392
#define XCD_BAR_WORDS 3456
#define XB_SPIN_CAP (1u << 18)

__device__ __forceinline__ unsigned xb_ld(unsigned* p)              { return __hip_atomic_load(p, __ATOMIC_RELAXED, __HIP_MEMORY_SCOPE_AGENT); }
__device__ __forceinline__ unsigned xb_add(unsigned* p, unsigned v) { return __hip_atomic_fetch_add(p, v, __ATOMIC_RELAXED, __HIP_MEMORY_SCOPE_AGENT); }
__device__ __forceinline__ unsigned xb_xcc_id() { return (unsigned)__builtin_amdgcn_s_getreg((3 << 11) | 20) & 0xFu; }
#define XB_SPIN(cond, bar) do { unsigned _sp = 0; while (cond) { __builtin_amdgcn_s_sleep(1); \
    if ((++_sp & 255u) == 0u) { if (xb_ld(&(bar)[XB_TMO])) break; if (_sp > XB_SPIN_CAP) { atomicAdd(&(bar)[XB_TMO], 1u); break; } } } } while (0)

struct XcdBarrier { unsigned* bar; unsigned x; volatile LAS unsigned* st; };

__device__ __forceinline__ XcdBarrier xcd_barrier_post(unsigned* bar, volatile LAS unsigned* st) {
    XcdBarrier b; b.bar = bar; b.x = xb_xcc_id(); b.st = st;
    if (threadIdx.x == 0) (void)xb_add(&bar[XB_XCNT(b.x)], 1u);
    return b;
}
__device__ __forceinline__ void xcd_barrier_complete(unsigned* bar, unsigned x, unsigned& nloc, unsigned& nx) {
    const unsigned G = gridDim.x * gridDim.y * gridDim.z;
    unsigned sum, cnt, mine, sp = 0u;
    for (;;) {
        sum = 0u; cnt = 0u; mine = 0u;
#pragma unroll
        for (unsigned j = 0; j < 16; ++j) { const unsigned c = xb_ld(&bar[XB_XCNT(j)]); sum += c; cnt += (c > 0u) ? 1u : 0u; mine = (j == x) ? c : mine; }
        if (sum == G) break;
        __builtin_amdgcn_s_sleep(1);
        if ((++sp & 255u) == 0u) { if (xb_ld(&bar[XB_TMO])) break; if (sp > XB_SPIN_CAP) { atomicAdd(&bar[XB_TMO], 1u); break; } }
    }
    nloc = mine > 0u ? mine : 1u; nx = cnt > 0u ? cnt : 1u;
}
__device__ __forceinline__ void xcd_barrier(const XcdBarrier& b) {
    asm volatile("s_waitcnt vmcnt(0)" ::: "memory");
    __syncthreads();
    if (threadIdx.x == 0) {
        unsigned* bar = b.bar;
        __builtin_amdgcn_s_waitcnt(0);
        unsigned nloc = b.st[0], nx = b.st[1];
        if (nloc == 0u) { xcd_barrier_complete(bar, b.x, nloc, nx); b.st[0] = nloc; b.st[1] = nx; }
        const unsigned old = xb_add(&bar[XB_XSUB(b.x)], 1u);
        const unsigned gen = old / nloc;
        if (old + 1u == (gen + 1u) * nloc) {
            __builtin_amdgcn_fence(__ATOMIC_RELEASE, "agent");
            asm volatile("s_waitcnt vmcnt(0)" ::: "memory");
            const unsigned og = xb_add(&bar[XB_TOP], 1u);
            const unsigned tg = og / nx;
            if (og + 1u == (tg + 1u) * nx) xb_add(&bar[XB_TOPGEN], 1u);
            else XB_SPIN(xb_ld(&bar[XB_TOPGEN]) == tg, bar);
            __builtin_amdgcn_fence(__ATOMIC_ACQUIRE, "agent");
            xb_add(&bar[XB_XGEN(b.x)], 1u);
            asm volatile("s_waitcnt vmcnt(0)" ::: "memory");
        } else {
            XB_SPIN(xb_ld(&bar[XB_XGEN(b.x)]) == gen, bar);
            __builtin_amdgcn_fence(__ATOMIC_ACQUIRE, "agent");
            asm volatile("s_waitcnt vmcnt(0)" ::: "memory");
        }
    }
    __syncthreads();
}

struct CvtTask {
    const float* src; bf16_t* dst; const float* scale;
    int ld, K, N, mapmode;
    int dld;
    int nb; int scstride;
    long sstride, dstride;
};
#define NCVT 16
struct Params {
    const float* x; const float* rel_bias; const float* norm_mix; const float* w_in; const float* a_sinks;
    const float* cmp_pos_k; const float* cmp_w1_k; const float* cmp_w2_k; const float* cmp_pos_v; const float* cmp_w1_v; const float* cmp_w2_v;
    const float* w_br_a; const float* w_br_b; const float* w_out; const float* norm_ffn; const float* w_group; const float* b_group;
    const float* w_expert; const float* b_expert; const float* w1; const float* w3; const float* w2; const float* norm_final;
    float* out;
    unsigned* bar;
    int* counts; int* cursor; int* ntiles; int* tile_e; int* cnt_tile;
    float* rsA; float* rsB; float* ssq16;
    bf16_t* HB;
    bf16_t* WinT;
    bf16_t* WabT; bf16_t* WoutT;
    bf16_t* CW1T; bf16_t* CW2T; float* CB1; float* CBP;
    bf16_t* W13T; bf16_t* W2T;
    bf16_t* W13T1; bf16_t* W2T1;
    int* cvtcur;
    bf16_t* WRH; bf16_t* WRL;
    bf16_t* QA; bf16_t* QB;
    bf16_t* KA; bf16_t* KVC; bf16_t* KS; bf16_t* KW;
    bf16_t* VAT; bf16_t* VST; bf16_t* VWT;
    float* G24;
    bf16_t* CHID; bf16_t* KCMP; bf16_t* VCMPT;
    bf16_t* OAB; bf16_t* OW;
    bf16_t* MERGED; bf16_t* TMP2;
    int* eid; float* ew; int* toks; float* slotw; int* slotdst;
    bf16_t* HMID; bf16_t* YS;
    CvtTask cvt[NCVT];
    int ph_lo, ph_hi, l_lo, l_hi;
};
#define PMAXF (65536 + 32 * 256)
#define NTILE_MAX (PMAXF / 256)

__device__ __forceinline__ int cvt_units(const CvtTask& t) { return t.nb * (t.K / 128) * ((t.N + 63) / 64); }
struct CvtRegs { float4 v[2][4]; };
__device__ __forceinline__ void cvt_decode(const CvtTask& t, int u, int& e, int& kt, int& nt) {
    int nkt = t.K / 128, nnt = (t.N + 63) / 64;
    asm volatile("" : "+s"(nkt), "+s"(nnt));
    e = u / (nkt * nnt); const int r = u % (nkt * nnt); kt = r / nnt; nt = r % nnt;
}
__device__ __forceinline__ void cvt_load2(const CvtTask& t, int tid, int ub, int G, int nu, CvtRegs& R) {
#pragma unroll
    for (int q = 0; q < 2; ++q) {
        const int uu = ub + q * G;
#pragma unroll
        for (int i = 0; i < 4; ++i) R.v[q][i] = make_float4(0.f, 0.f, 0.f, 0.f);
        if (uu < nu) {
            int e, kt, nt; cvt_decode(t, uu, e, kt, nt);
            const float* src = t.src + (long)e * t.sstride;
#pragma unroll
            for (int i = 0; i < 4; ++i) {
                const int k = (tid >> 4) + 32 * i, n4 = (tid & 15) * 4;
                const int gk = kt * 128 + k, gn = nt * 64 + n4;
                if (gn < t.N) {
                    float4 v = *(const float4*)(src + (long)gk * t.ld + gn);
                    if (t.scale) { const float s = t.scale[(long)e * t.scstride + gk]; v.x *= s; v.y *= s; v.z *= s; v.w *= s; }
                    R.v[q][i] = v;
                }
            }
        }
    }
}
__device__ __forceinline__ void cvt_store2(const CvtTask& t, int tid, int ub, int G, int nu, const CvtRegs& R, LAS float* tiles  ) {
    __syncthreads();
#pragma unroll
    for (int q = 0; q < 2; ++q)
#pragma unroll
        for (int i = 0; i < 4; ++i) {
            const int k = (tid >> 4) + 32 * i, n4 = (tid & 15) * 4;
            LAS float* tl = tiles + q * (128 * 65) + k * 65 + n4;
            tl[0] = R.v[q][i].x; tl[1] = R.v[q][i].y; tl[2] = R.v[q][i].z; tl[3] = R.v[q][i].w;
        }
    __syncthreads();
    const int n = tid >> 3, ks = (tid & 7) * 16;
#pragma unroll
    for (int q = 0; q < 2; ++q) {
        const int uu = ub + q * G;
        if (uu < nu) {
            int e, kt, nt; cvt_decode(t, uu, e, kt, nt);
            bf16_t* dst = t.dst + (long)e * t.dstride;
            const int gn = nt * 64 + n;
            if (gn < t.N) {
                int drow = gn;
                if (t.mapmode == 1) drow = (gn >> 7) * 256 + (gn & 127);
                else if (t.mapmode == 2) drow = (gn >> 7) * 256 + 128 + (gn & 127);
                const LAS float* tl = tiles + q * (128 * 65) + ks * 65 + n;
                u32x4 w0, w1;
                w0.x = cvt_pk_bf16(tl[0 * 65], tl[1 * 65]); w0.y = cvt_pk_bf16(tl[2 * 65], tl[3 * 65]);
                w0.z = cvt_pk_bf16(tl[4 * 65], tl[5 * 65]); w0.w = cvt_pk_bf16(tl[6 * 65], tl[7 * 65]);
                w1.x = cvt_pk_bf16(tl[8 * 65], tl[9 * 65]); w1.y = cvt_pk_bf16(tl[10 * 65], tl[11 * 65]);
                w1.z = cvt_pk_bf16(tl[12 * 65], tl[13 * 65]); w1.w = cvt_pk_bf16(tl[14 * 65], tl[15 * 65]);
                bf16_t* dp = dst + (long)drow * t.dld + kt * 128 + ks;
                *(u32x4*)dp = w0; *(u32x4*)(dp + 8) = w1;
            }
        }
    }
}
template <int t0, int t1>
__device__ __forceinline__ void cvt_phase(const Params& p, LAS unsigned char* lds) {
    LAS float* tiles = (LAS float*)lds;
    int tid = threadIdx.x; asm volatile("" : "+v"(tid));
    const int G = gridDim.x;
    int base = 0;
#pragma unroll
    for (int ti = t0; ti < t1; ++ti) {
        const CvtTask& t = p.cvt[ti];
        const int nu = cvt_units(t);
        int first = (int)blockIdx.x - (base % G); if (first < 0) first += G;
        CvtRegs A, B;
        if (first < nu) cvt_load2(t, tid, first, G, nu, A);
        for (int ub = first; ub < nu; ub += 2 * G) {
            const int un = ub + 2 * G;
            if (un < nu) cvt_load2(t, tid, un, G, nu, B);
            cvt_store2(t, tid, ub, G, nu, A, tiles);
            A = B;
        }
        base += nu;
    }
    __syncthreads();
}
#define JOB_CHUNKS 768
#define FILL_P1 0
#define FILL_P2C 0
#define FILL_P2A 0
#define FILL_P8 0
#define FILL_P9 0
#define NCH0 (JOB_CHUNKS - (128 * FILL_P1 + 32 * FILL_P2C + 96 * FILL_P2A))
template <int JOB>
__device__ __forceinline__ void cvt_job_chunk(const Params& p, int c, LAS float* tiles, int tid) {
    const int which = c >> 8, u0 = (c & 255) * 8;
    CvtTask t;
    const long eo = (long)JOB * 32 * 1024 * 512;
    const float* src = p.w1; if (which == 1) src = p.w3; if (which == 2) src = p.w2;
    t.src = src + eo;
    t.dst = (which == 2) ? (JOB ? p.W2T1 : p.W2T) : (JOB ? p.W13T1 : p.W13T);
    t.scale = (which == 2) ? nullptr : p.norm_ffn + JOB * 1024; t.scstride = 0;
    t.ld = (which == 2) ? 1024 : 512; t.K = (which == 2) ? 512 : 1024; t.N = (which == 2) ? 1024 : 512;
    t.dld = t.K; t.mapmode = (which == 2) ? 0 : 1 + which; t.nb = 32; t.sstride = (long)1024 * 512; t.dstride = (which == 2) ? (long)1024 * 512 : (long)1024 * 1024;
    CvtRegs A, B;
    cvt_load2(t, tid, u0, 1, 2048, A);
#pragma unroll 1
    for (int s2 = 0; s2 < 4; ++s2) {
        if (s2 < 3) cvt_load2(t, tid, u0 + 2 * (s2 + 1), 1, 2048, B);
        cvt_store2(t, tid, u0 + 2 * s2, 1, 2048, A, tiles);
        A = B;
    }
}
template <int JOB>
__device__ __forceinline__ void cvt_fill(const Params& p, LAS unsigned char* lds, int base, int max_chunks) {
    int tid = threadIdx.x; asm volatile("" : "+v"(tid));
    volatile LAS unsigned* slot = (volatile LAS unsigned*)(lds + LDS_MISC_OFF) + 32;
#pragma unroll 1
    for (int n = 0; n < max_chunks; ++n) {
        __syncthreads();
        if (tid == 0) *slot = (unsigned)__hip_atomic_fetch_add(p.cvtcur + JOB, 1, __ATOMIC_RELAXED, __HIP_MEMORY_SCOPE_AGENT);
        __syncthreads();
        const int c = base + __builtin_amdgcn_readfirstlane((int)*slot);
        if (c >= JOB_CHUNKS) break;
        cvt_job_chunk<JOB>(p, c, (LAS float*)lds, tid);
    }
    __syncthreads();
}
template <int JOB>
__device__ __forceinline__ void cvt_static(const Params& p, LAS unsigned char* lds, int n) {
    int tid = threadIdx.x; asm volatile("" : "+v"(tid));
#pragma unroll 1
    for (int c = blockIdx.x; c < n; c += gridDim.x) cvt_job_chunk<JOB>(p, c, (LAS float*)lds, tid);
    __syncthreads();
}
__device__ __forceinline__ void prep_small(const Params& p) {
    const int gtid = blockIdx.x * NTHR + threadIdx.x, gn = gridDim.x * NTHR;
    for (int i = gtid; i < 2 * 48 * 1024; i += gn) {
        const int l = i / (48 * 1024), r = i % (48 * 1024), n = r >> 10, k = r & 1023;
        float w = 0.f;
        if (n < 36) {
            const float g = p.norm_ffn[l * 1024 + k];
            w = g * ((n < 4) ? p.w_group[((long)l * 1024 + k) * 4 + n] : p.w_expert[((long)l * 1024 + k) * 32 + (n - 4)]);
        }
        const __bf16 hi = (__bf16)w; const __bf16 lo = (__bf16)(w - (float)hi);
        p.WRH[i] = __builtin_bit_cast(unsigned short, hi); p.WRL[i] = __builtin_bit_cast(unsigned short, lo);
    }
    for (int w = blockIdx.x; w < 256; w += gridDim.x) {
        const int cmb = w >> 6, sl = w & 63, l = cmb >> 1, kv = cmb & 1, n = threadIdx.x & 255, kh = threadIdx.x >> 8;
        const float* pos = (kv ? p.cmp_pos_v : p.cmp_pos_k) + (long)l * 2048 + sl * 32 + kh * 16;
        const float* wt = (kv ? p.cmp_w1_v : p.cmp_w1_k) + ((long)l * 2048 + sl * 32 + kh * 16) * 256 + n;
        float sacc = 0.f;
#pragma unroll
        for (int i = 0; i < 16; ++i) sacc = fmaf(pos[i], wt[(long)i * 256], sacc);
        p.CBP[((long)w * 2 + kh) * 256 + n] = sacc;
    }
    for (int i = gtid; i < 256 * 1024 / 8; i += gn) ((u32x4*)(p.HB + (long)T_TOK * DM))[i] = (u32x4){0u, 0u, 0u, 0u};
}

__device__ __forceinline__ void cb1_reduce(const Params& p) {
    const int wave = threadIdx.x >> 6, lane = threadIdx.x & 63;
    if (wave < 4) {
        for (int o = blockIdx.x * 4 + wave; o < 1024; o += gridDim.x * 4) {
            const int cmb = o >> 8, n = o & 255;
            const float* pp = p.CBP + ((long)cmb * 128) * 256 + n;
            float v = pp[(long)lane * 256] + pp[(long)(lane + 64) * 256];
            v = wave_sum_f(v);
            if (lane == 0) p.CB1[o] = v;
        }
    }
}
template <bool ADD_YS, bool LAST>
__device__ __forceinline__ void fin_phase(const Params& p, const float* hin, const float* gfinal) {
    int tid = threadIdx.x; asm volatile("" : "+v"(tid));
    const int wave = tid >> 6, lane = tid & 63;
    for (int row0 = (blockIdx.x * 8 + wave) * 2; row0 < T_TOK; row0 += gridDim.x * 16) {
        float v[2][2][8]; u32x4 ya[2][2], yb[2][2], hb[2][2];
#pragma unroll
        for (int q = 0; q < 2; ++q)
#pragma unroll
            for (int i = 0; i < 2; ++i) {
                if (ADD_YS) {
                    hb[q][i] = *(const u32x4*)(p.HB + (long)(row0 + q) * DM + i * 512 + lane * 8);
                    ya[q][i] = *(const u32x4*)(p.YS + ((long)(row0 + q) * 2) * DM + i * 512 + lane * 8);
                    yb[q][i] = *(const u32x4*)(p.YS + ((long)(row0 + q) * 2 + 1) * DM + i * 512 + lane * 8);
                } else {
                    const float4 a = *(const float4*)(hin + (long)(row0 + q) * DM + i * 512 + lane * 8), c = *(const float4*)(hin + (long)(row0 + q) * DM + i * 512 + lane * 8 + 4);
                    v[q][i][0] = a.x; v[q][i][1] = a.y; v[q][i][2] = a.z; v[q][i][3] = a.w; v[q][i][4] = c.x; v[q][i][5] = c.y; v[q][i][6] = c.z; v[q][i][7] = c.w;
                }
            }
#pragma unroll
        for (int q = 0; q < 2; ++q) {
            const int row = row0 + q;
            if (ADD_YS) {
#pragma unroll
                for (int i = 0; i < 2; ++i) {
                    const unsigned hw[4] = {hb[q][i].x, hb[q][i].y, hb[q][i].z, hb[q][i].w}, aw[4] = {ya[q][i].x, ya[q][i].y, ya[q][i].z, ya[q][i].w}, bw[4] = {yb[q][i].x, yb[q][i].y, yb[q][i].z, yb[q][i].w};
#pragma unroll
                    for (int j = 0; j < 4; ++j) {
                        v[q][i][2 * j] = bf16lo(hw[j]) + (bf16lo(aw[j]) + bf16lo(bw[j]));
                        v[q][i][2 * j + 1] = bf16hi(hw[j]) + (bf16hi(aw[j]) + bf16hi(bw[j]));
                    }
                }
            }
            float s = 0.f;
#pragma unroll
            for (int i = 0; i < 2; ++i)
#pragma unroll
                for (int j = 0; j < 8; ++j) s += v[q][i][j] * v[q][i][j];
            s = wave_sum_f(s);
            const float r = rsqrtf(s * (1.0f / DM) + 1e-5f);
            if (LAST) {
#pragma unroll
                for (int i = 0; i < 2; ++i) {
                    const float4 g0 = *(const float4*)(gfinal + i * 512 + lane * 8), g1 = *(const float4*)(gfinal + i * 512 + lane * 8 + 4);
                    float4 o0, o1;
                    o0.x = v[q][i][0] * r * g0.x; o0.y = v[q][i][1] * r * g0.y; o0.z = v[q][i][2] * r * g0.z; o0.w = v[q][i][3] * r * g0.w;
                    o1.x = v[q][i][4] * r * g1.x; o1.y = v[q][i][5] * r * g1.y; o1.z = v[q][i][6] * r * g1.z; o1.w = v[q][i][7] * r * g1.w;
                    *(float4*)(p.out + (long)row * DM + i * 512 + lane * 8) = o0; *(float4*)(p.out + (long)row * DM + i * 512 + lane * 8 + 4) = o1;
                }
            } else {
#pragma unroll
                for (int i = 0; i < 2; ++i) {
                    u32x4 w; w.x = cvt_pk_bf16(v[q][i][0], v[q][i][1]); w.y = cvt_pk_bf16(v[q][i][2], v[q][i][3]); w.z = cvt_pk_bf16(v[q][i][4], v[q][i][5]); w.w = cvt_pk_bf16(v[q][i][6], v[q][i][7]);
                    *(u32x4*)(p.HB + (long)row * DM + i * 512 + lane * 8) = w;
                }
                if (lane == 0) p.rsA[row] = r;
            }
        }
    }
}

namespace pg8 {
constexpr int BM = 256, BK = 64, HALF = 128, HTB = HALF * BK * 2, STAGE_BYTES = 8 * HTB, NXCD = 8, WGM = 8;
__host__ __device__ __forceinline__ int lds_byte(int r, int c) { const int st = (r >> 4) * 2 + (c >> 5), rr = r & 15, cc = c & 31, ob = rr * 64 + cc * 2; return st * 1024 + (ob ^ (((ob >> 9) & 1) << 5)); }
__host__ __device__ __forceinline__ void stage_rc(int b, int& R, int& C) { const int st = b / 1024, sb = b % 1024, swz = sb ^ (((sb >> 9) & 1) << 5); R = (st >> 1) * 16 + swz / 64; C = (st & 1) * 32 + (swz % 64) / 2; }
__host__ __device__ __forceinline__ int perm32(int rho) { const int n = rho >> 4, i = rho & 15; return 8 * (i >> 2) + 4 * n + (i & 3); }

struct Unit { int pm, pn, li; };
struct Gemm { const bf16_t* A; const bf16_t* Bt; int K, lda, ldb; const LAS int* gather; };

struct StaticOrder {
    int nM, nN, nwg, G, c;
    __device__ void init(int M, int N, int G_, int c_) { nM = M / BM; nN = N / BM; nwg = nM * nN; G = G_; c = c_; }
    __device__ bool next(int i, Unit& u) const {
        const long L = (long)i * G + c; if (L >= nwg) return false;
        int wgid = (int)L; { const int q = nwg / NXCD, r = nwg % NXCD, xcd = wgid % NXCD, off = wgid / NXCD; wgid = (xcd < r ? xcd * (q + 1) : r * (q + 1) + (xcd - r) * q) + off; }
        const int nig = WGM * nN, gid = wgid / nig, fm = gid * WGM, gsz = (nM - fm) < WGM ? (nM - fm) : WGM;
        u.pm = fm + ((wgid % nig) % gsz); u.pn = (wgid % nig) / gsz; u.li = 0; return true;
    }
};
struct CmpOrder {
    int c;
    __device__ bool next(int i, Unit& u) const { if (i > 0 || c >= 32) return false; u.pm = c; u.pn = c >> 4; u.li = 0; return true; }
};
struct MoeOrder {
    const LAS int* ul;
    __device__ bool next(int i, Unit& u) const {
        if (i >= ul[0]) return false;
        u.pm = ul[2 + 2 * i]; u.pn = ul[3 + 2 * i]; u.li = i; return true;
    }
};

template <class Epi, class Sched, bool GATHER, bool MID = false>
__device__ __forceinline__ void gemm_phase(LAS unsigned char* lds, const Gemm g, const Sched& S, const Epi& E) {
    int tid = threadIdx.x;
    asm volatile("" : "+v"(tid));
    const int wid = __builtin_amdgcn_readfirstlane(tid >> 6), lane = tid & 63, wr = wid >> 2, wc = wid & 3, fr = lane & 15, fq = lane >> 4;
    const int K = g.K, nt = K / BK;
    unsigned voffA[2], voffB[2];
#pragma unroll
    for (int i = 0; i < 2; ++i) { int R, C; stage_rc(tid * 16 + i * 8192, R, C); const int Rb = Epi::PERM ? ((R & ~31) + perm32(R & 31)) : R;
        voffA[i] = (unsigned)(R * g.lda + C) * 2u; voffB[i] = (unsigned)(Rb * g.ldb + C) * 2u; }
    const size_t kstep = (size_t)(BK * 2);
    const size_t hstepA = (size_t)HALF * g.lda * 2, tstepA = 2 * hstepA;
    const size_t hstepB = (size_t)HALF * g.ldb * 2, tstepB = 2 * hstepB;
    const unsigned ldsw = (unsigned)wid * 1024u;
    const int aoff = lds_byte(wr * 64 + fr, fq * 8), boff = lds_byte(wc * 32 + fr, fq * 8);
#define PG8_SA(b, h) (((b) * 2 + (h)) * HTB)
#define PG8_SB(b, h) ((4 + (b) * 2 + (h)) * HTB)
#define PG8_STAGE(bufoff, gbase, voff) do { _Pragma("unroll") for (int _i = 0; _i < 2; ++_i) \
        __builtin_amdgcn_global_load_lds((const unsigned*)((const char*)(gbase) + (voff)[_i]), (LAS unsigned*)(lds + (bufoff) + ldsw + _i * 8192), 16, 0, 0); } while (0)
#define PG8_STAGEG(bufoff, kb, o0, o1) do { \
        __builtin_amdgcn_global_load_lds((const unsigned*)((const char*)g.A + (kb) + (o0)), (LAS unsigned*)(lds + (bufoff) + ldsw), 16, 0, 0); \
        __builtin_amdgcn_global_load_lds((const unsigned*)((const char*)g.A + (kb) + (o1)), (LAS unsigned*)(lds + (bufoff) + ldsw + 8192), 16, 0, 0); } while (0)
#define PG8_STAGEA_CUR(bufoff, kb, h) do { if constexpr (GATHER) { PG8_STAGEG(bufoff, kb, oc[h][0], oc[h][1]); } else { PG8_STAGE(bufoff, cA + (kb) + (h) * hstepA, voffA); } } while (0)
#define PG8_STAGEA_SEL(bufoff, kb, h) do { if constexpr (GATHER) { PG8_STAGEG(bufoff, kb, (last ? on[h][0] : oc[h][0]), (last ? on[h][1] : oc[h][1])); } else { PG8_STAGE(bufoff, a2b + (kb) + (h) * hstepA, voffA); } } while (0)
#define PG8_LDA(dst, b, h) do { _Pragma("unroll") for (int m = 0; m < 4; ++m) _Pragma("unroll") for (int k = 0; k < 2; ++k) dst[m][k] = *(const LAS bf16x8*)(lds + PG8_SA(b, h) + aoff + m * 2048 + k * 1024); } while (0)
#define PG8_LDB(dst, b, h) do { _Pragma("unroll") for (int n = 0; n < 2; ++n) _Pragma("unroll") for (int k = 0; k < 2; ++k) dst[n][k] = *(const LAS bf16x8*)(lds + PG8_SB(b, h) + boff + n * 2048 + k * 1024); } while (0)
#define PG8_MMA(ai, bj, At, Bt) do { __builtin_amdgcn_s_setprio(1); _Pragma("unroll") for (int m = 0; m < 4; ++m) _Pragma("unroll") for (int n = 0; n < 2; ++n) _Pragma("unroll") for (int k = 0; k < 2; ++k) \
        acc[ai][bj][m][n] = __builtin_amdgcn_mfma_f32_16x16x32_bf16(Bt[n][k], At[m][k], acc[ai][bj][m][n], 0, 0, 0); __builtin_amdgcn_s_setprio(0); } while (0)
#define PG8_WAIT_V(n) asm volatile("s_waitcnt vmcnt(" #n ")" ::: "memory")
#define PG8_WAIT_L(n) asm volatile("s_waitcnt lgkmcnt(" #n ")" ::: "memory")
#define PG8_BAR __builtin_amdgcn_s_barrier()
#define PG8_SCHED __builtin_amdgcn_sched_barrier(0)
#define PG8_AOFF(dst, U) do { _Pragma("unroll") for (int _h = 0; _h < 2; ++_h) _Pragma("unroll") for (int _i = 0; _i < 2; ++_i) { \
        int _R, _C; stage_rc(tid * 16 + _i * 8192, _R, _C); const int _gr = g.gather[(U).li * BM + _h * HALF + _R]; \
        dst[_h][_i] = (unsigned)((_gr * g.lda + _C) * 2); } } while (0)
    Unit cur, nxt; int ui = 0;
    if (!S.next(0, cur)) return;
    f32x4 acc[2][2][4][2];
#pragma unroll
    for (int a = 0; a < 2; ++a)
#pragma unroll
        for (int b = 0; b < 2; ++b)
#pragma unroll
            for (int m = 0; m < 4; ++m)
#pragma unroll
                for (int n = 0; n < 2; ++n) acc[a][b][m][n] = (f32x4){0.f, 0.f, 0.f, 0.f};
    bf16x8 At[4][2], B0[2][2], B1[2][2];
    unsigned oc[2][2] = {{0u, 0u}, {0u, 0u}}, on[2][2] = {{0u, 0u}, {0u, 0u}};
    if constexpr (GATHER) { PG8_AOFF(oc, cur); }
    const char* cA = (const char*)g.A + (GATHER ? (size_t)0 : (size_t)cur.pm * tstepA);
    const char* cB = (const char*)g.Bt + (size_t)cur.pn * tstepB;
    PG8_STAGE(PG8_SB(0, 0), cB, voffB); PG8_STAGEA_CUR(PG8_SA(0, 0), 0, 0); PG8_STAGE(PG8_SB(0, 1), cB + hstepB, voffB); PG8_STAGEA_CUR(PG8_SA(0, 1), 0, 1);
    if (wr == 1) PG8_BAR;
    PG8_WAIT_V(4); PG8_BAR;
    PG8_STAGE(PG8_SB(1, 0), cB + kstep, voffB); PG8_STAGEA_CUR(PG8_SA(1, 0), kstep, 0); PG8_STAGE(PG8_SB(1, 1), cB + hstepB + kstep, voffB);
    PG8_WAIT_V(6); PG8_BAR;
    for (;;) {
        const bool has_next = S.next(ui + 1, nxt);
        if constexpr (GATHER) { if (has_next) { PG8_AOFF(on, nxt); } else { on[0][0] = oc[0][0]; on[0][1] = oc[0][1]; on[1][0] = oc[1][0]; on[1][1] = oc[1][1]; } }
        const char* nA = (has_next && !GATHER) ? (const char*)g.A + (size_t)nxt.pm * tstepA : cA;
        const char* nB = has_next ? (const char*)g.Bt + (size_t)nxt.pn * tstepB : cB;
        for (int t = 0; t < nt; t += 2) {
            if constexpr (MID) { if (t == nt / 2) E.mid(acc, cur, wr, wc, fr, fq); }
            const bool last = (t == nt - 2);
            const size_t k1 = (size_t)(t + 1) * kstep;
            const size_t k2 = last ? 0 : (size_t)(t + 2) * kstep, k3 = k2 + kstep;
            const char* a2b = last ? nA : cA;
            const char* b2 = last ? nB : cB + (size_t)(t + 2) * kstep; const char* b3 = b2 + kstep;
            PG8_LDB(B0, 0, 0); PG8_SCHED; PG8_LDA(At, 0, 0); PG8_STAGEA_CUR(PG8_SA(1, 1), k1, 1);
            PG8_WAIT_L(8); PG8_BAR; PG8_WAIT_L(0); PG8_MMA(0, 0, At, B0); PG8_BAR; PG8_SCHED;
            PG8_LDB(B1, 0, 1); PG8_STAGE(PG8_SB(0, 0), b2, voffB);
            PG8_BAR; PG8_WAIT_L(0); PG8_MMA(0, 1, At, B1); PG8_BAR;
            PG8_LDA(At, 0, 1); PG8_STAGEA_SEL(PG8_SA(0, 0), k2, 0);
            PG8_BAR; PG8_WAIT_L(0); PG8_MMA(1, 0, At, B0); PG8_BAR; PG8_SCHED;
            PG8_STAGE(PG8_SB(0, 1), b2 + hstepB, voffB);
            PG8_WAIT_V(6); PG8_BAR; PG8_MMA(1, 1, At, B1); PG8_BAR;
            PG8_LDB(B0, 1, 0); PG8_SCHED; PG8_LDA(At, 1, 0); PG8_STAGEA_SEL(PG8_SA(0, 1), k2, 1);
            PG8_WAIT_L(8); PG8_BAR; PG8_WAIT_L(0); PG8_MMA(0, 0, At, B0); PG8_BAR; PG8_SCHED;
            PG8_LDB(B1, 1, 1); PG8_STAGE(PG8_SB(1, 0), b3, voffB);
            PG8_BAR; PG8_WAIT_L(0); PG8_MMA(0, 1, At, B1); PG8_BAR;
            PG8_LDA(At, 1, 1); PG8_STAGEA_SEL(PG8_SA(1, 0), k3, 0);
            PG8_BAR; PG8_WAIT_L(0); PG8_MMA(1, 0, At, B0); PG8_BAR; PG8_SCHED;
            PG8_STAGE(PG8_SB(1, 1), b3 + hstepB, voffB);
            PG8_WAIT_V(6); PG8_BAR; PG8_MMA(1, 1, At, B1); PG8_BAR;
        }
        E(acc, cur, wr, wc, fr, fq);
        if (!has_next) break;
#pragma unroll
        for (int a = 0; a < 2; ++a)
#pragma unroll
            for (int b = 0; b < 2; ++b)
#pragma unroll
                for (int m = 0; m < 4; ++m)
#pragma unroll
                    for (int n = 0; n < 2; ++n) acc[a][b][m][n] = (f32x4){0.f, 0.f, 0.f, 0.f};
        cur = nxt; cA = nA; cB = nB; ++ui;
        if constexpr (GATHER) { oc[0][0] = on[0][0]; oc[0][1] = on[0][1]; oc[1][0] = on[1][0]; oc[1][1] = on[1][1]; }
    }
    PG8_WAIT_V(0);
    if (wr == 0) PG8_BAR;
    PG8_BAR;
#undef PG8_SA
#undef PG8_SB
#undef PG8_STAGE
#undef PG8_STAGEG
#undef PG8_STAGEA_CUR
#undef PG8_STAGEA_SEL
#undef PG8_LDA
#undef PG8_LDB
#undef PG8_MMA
#undef PG8_WAIT_V
#undef PG8_WAIT_L
#undef PG8_BAR
#undef PG8_SCHED
#undef PG8_AOFF
}
}

typedef f32x4 AccT[2][2][4][2];

struct EpiProj {
    static constexpr bool PERM = true;
    const float* rs; bf16_t* QA; bf16_t* KA; float* G24;
    __device__ __forceinline__ void operator()(const AccT& acc, const pg8::Unit& u, int wr, int wc, int fr, int fq) const {
        const int row0 = u.pm * 256 + wr * 64 + fr;
        const int pn = u.pn;
        float rr[2][4];
#pragma unroll
        for (int ai = 0; ai < 2; ++ai)
#pragma unroll
            for (int m = 0; m < 4; ++m) rr[ai][m] = rs[row0 + ai * 128 + m * 16];
        if (pn == 0 || pn == 1 || pn == 3 || pn == 4) {
            bf16_t* Q = QA + (long)((pn >= 3) ? 1 : 0) * T_TOK * 512 + ((pn == 1 || pn == 4) ? 256 : 0) + wc * 32 + fq * 8;
#pragma unroll
            for (int ai = 0; ai < 2; ++ai)
#pragma unroll
                for (int m = 0; m < 4; ++m) {
                    const int row = row0 + ai * 128 + m * 16;
                    const float sc = rr[ai][m] * QSCALE;
#pragma unroll
                    for (int bj = 0; bj < 2; ++bj) {
                        const f32x4 v0 = acc[ai][bj][m][0], v1 = acc[ai][bj][m][1];
                        u32x4 w; w.x = cvt_pk_bf16(v0[0] * sc, v0[1] * sc); w.y = cvt_pk_bf16(v0[2] * sc, v0[3] * sc); w.z = cvt_pk_bf16(v1[0] * sc, v1[1] * sc); w.w = cvt_pk_bf16(v1[2] * sc, v1[3] * sc);
                        *(u32x4*)(Q + (long)row * 512 + bj * 128) = w;
                    }
                    __builtin_amdgcn_sched_barrier(0);
                }
        } else if (pn == 8) {
            if (wc == 0 && fq < 3) {
#pragma unroll
                for (int ai = 0; ai < 2; ++ai)
#pragma unroll
                    for (int m = 0; m < 4; ++m) {
                        const int row = row0 + ai * 128 + m * 16;
                        const float r = rr[ai][m];
                        const f32x4 v0 = acc[ai][0][m][0], v1 = acc[ai][0][m][1];
                        float* gp = G24 + (long)row * 32 + fq * 8;
                        *(f32x4*)gp = (f32x4){fast_sigmoid(v0[0] * r), fast_sigmoid(v0[1] * r), fast_sigmoid(v0[2] * r), fast_sigmoid(v0[3] * r)};
                        *(f32x4*)(gp + 4) = (f32x4){fast_sigmoid(v1[0] * r), fast_sigmoid(v1[1] * r), fast_sigmoid(v1[2] * r), fast_sigmoid(v1[3] * r)};
                        __builtin_amdgcn_sched_barrier(0);
                    }
            }
        } else {
            const int g = wc >> 1, d0 = (wc & 1) * 32 + fq * 8;
            const int kslot = (pn == 2) ? 0 : (pn == 5) ? 1 : (pn - 3), vslot = (pn == 2) ? 5 : (pn == 5) ? 2 : pn;
            bf16_t* Kd = KA + (long)kslot * (16 * SEQ * 64) + (long)g * SEQ * 64 + d0;
            bf16_t* Vd = KA + (long)vslot * (16 * SEQ * 64);
            Vd += (pn == 5) ? ((long)g * SEQ * 64 + d0) : ((long)(g * 64 + d0) * SEQ);
#pragma unroll
            for (int ai = 0; ai < 2; ++ai)
#pragma unroll
                for (int m = 0; m < 4; ++m) {
                    const int row = row0 + ai * 128 + m * 16;
                    const float r = rr[ai][m];
                    const int b = row >> 12, s = row & 4095;
                    {
                        const f32x4 v0 = acc[ai][0][m][0], v1 = acc[ai][0][m][1];
                        u32x4 w; w.x = cvt_pk_bf16(v0[0] * r, v0[1] * r); w.y = cvt_pk_bf16(v0[2] * r, v0[3] * r); w.z = cvt_pk_bf16(v1[0] * r, v1[1] * r); w.w = cvt_pk_bf16(v1[2] * r, v1[3] * r);
                        *(u32x4*)(Kd + ((long)b * 2 * SEQ + s) * 64) = w;
                    }
                    const f32x4 v0 = acc[ai][1][m][0], v1 = acc[ai][1][m][1];
                    if (pn == 5) {
                        u32x4 w; w.x = cvt_pk_bf16(v0[0] * r, v0[1] * r); w.y = cvt_pk_bf16(v0[2] * r, v0[3] * r); w.z = cvt_pk_bf16(v1[0] * r, v1[1] * r); w.w = cvt_pk_bf16(v1[2] * r, v1[3] * r);
                        *(u32x4*)(Vd + ((long)b * 2 * SEQ + s) * 64) = w;
                    } else {
                        bf16_t* vp = Vd + (long)b * 2 * 64 * SEQ + s;
#pragma unroll
                        for (int j = 0; j < 4; ++j) {
                            vp[(long)j * SEQ] = (bf16_t)(cvt_pk_bf16(v0[j] * r, 0.f) & 0xffffu);
                            vp[(long)(4 + j) * SEQ] = (bf16_t)(cvt_pk_bf16(v1[j] * r, 0.f) & 0xffffu);
                        }
                    }
                    __builtin_amdgcn_sched_barrier(0);
                }
        }
    }
};
struct EpiCmp1 {
    static constexpr bool PERM = true;
    const float* cb1; bf16_t* CHID;
    __device__ __forceinline__ void operator()(const AccT& acc, const pg8::Unit& u, int wr, int wc, int fr, int fq) const {
        const int row0 = u.pm * 256 + wr * 64 + fr;
        const float* cb = cb1 + u.pn * 256 + wc * 32 + fq * 8;
#pragma unroll
        for (int bj = 0; bj < 2; ++bj) {
            const f32x4 b0 = *(const f32x4*)(cb + bj * 128), b1 = *(const f32x4*)(cb + bj * 128 + 4);
#pragma unroll
            for (int ai = 0; ai < 2; ++ai)
#pragma unroll
                for (int m = 0; m < 4; ++m) {
                    const int row = row0 + ai * 128 + m * 16;
                    float y[8];
#pragma unroll
                    for (int j = 0; j < 4; ++j) { y[j] = acc[ai][bj][m][0][j] + b0[j]; y[4 + j] = acc[ai][bj][m][1][j] + b1[j]; }
#pragma unroll
                    for (int j = 0; j < 8; ++j) { const float x = y[j]; const float uu = 0.7978845608028654f * (x + 0.044715f * x * x * x); y[j] = x * fast_sigmoid(2.0f * uu); }
                    u32x4 w; w.x = cvt_pk_bf16(y[0], y[1]); w.y = cvt_pk_bf16(y[2], y[3]); w.z = cvt_pk_bf16(y[4], y[5]); w.w = cvt_pk_bf16(y[6], y[7]);
                    *(u32x4*)(CHID + (long)row * 256 + bj * 128 + wc * 32 + fq * 8) = w;
                    __builtin_amdgcn_sched_barrier(0);
                }
        }
    }
};
__device__ __forceinline__ void cmp_gemm2(const Params& p, int l, int pm) {
    asm volatile("s_waitcnt vmcnt(0)" ::: "memory");
    __syncthreads();
    __builtin_amdgcn_fence(__ATOMIC_ACQUIRE, "agent");
    asm volatile("s_waitcnt vmcnt(0)" ::: "memory");
    int tid = threadIdx.x; asm volatile("" : "+v"(tid));
    const int wave = tid >> 6, lane = tid & 63, fr = lane & 15, fq = lane >> 4;
    const int kv = pm >> 4, bg = pm & 15;
    const bf16_t* A = p.CHID + ((long)pm * 256 + wave * 32) * 256;
    const bf16_t* Bt = p.CW2T + ((long)(l * 2 + kv) * 64) * 256;
    f32x4 acc[2][4];
#pragma unroll
    for (int rt = 0; rt < 2; ++rt)
#pragma unroll
        for (int ct = 0; ct < 4; ++ct) acc[rt][ct] = (f32x4){0.f, 0.f, 0.f, 0.f};
#pragma unroll
    for (int ks = 0; ks < 8; ++ks) {
        bf16x8 af[2], bf[4];
#pragma unroll
        for (int rt = 0; rt < 2; ++rt) af[rt] = *(const bf16x8*)(A + (long)(rt * 16 + fr) * 256 + ks * 32 + fq * 8);
#pragma unroll
        for (int ct = 0; ct < 4; ++ct) bf[ct] = *(const bf16x8*)(Bt + (long)(ct * 16 + fr) * 256 + ks * 32 + fq * 8);
#pragma unroll
        for (int rt = 0; rt < 2; ++rt)
#pragma unroll
            for (int ct = 0; ct < 4; ++ct) acc[rt][ct] = __builtin_amdgcn_mfma_f32_16x16x32_bf16(af[rt], bf[ct], acc[rt][ct], 0, 0, 0);
    }
#pragma unroll
    for (int rt = 0; rt < 2; ++rt)
#pragma unroll
        for (int ct = 0; ct < 4; ++ct) {
            const int n = ct * 16 + fr, i0 = wave * 32 + rt * 16 + 4 * fq;
            f32x4 v = acc[rt][ct];
            if (i0 + 3 == 255) v[3] = 0.f;
            if (kv == 0) {
#pragma unroll
                for (int j = 0; j < 4; ++j) p.KCMP[((long)bg * 256 + i0 + j) * 64 + n] = (bf16_t)(cvt_pk_bf16(v[j], 0.f) & 0xffffu);
            } else {
                u32x2 w; w.x = cvt_pk_bf16(v[0], v[1]); w.y = cvt_pk_bf16(v[2], v[3]);
                *(u32x2*)(p.VCMPT + ((long)bg * 64 + n) * 256 + i0) = w;
            }
        }
}

#define AT_ROWB 144
#define AT_KT(b) ((b) * 9216)
#define AT_VT(b) (18432 + (b) * 9216)
#define AT_IMP 36864
#define AT_SEL (36864 + 4 * 64 * 66 * 4)
#define NEG_INF (-INFINITY)

struct AttSt { f32x16 O0, O1, CI; float m, l; };
__device__ __forceinline__ void att_init(AttSt& s, float cb = 0.f) {
#pragma unroll
    for (int i = 0; i < 16; ++i) { s.O0[i] = 0.f; s.O1[i] = 0.f; s.CI[i] = cb; }
    s.m = NEG_INF; s.l = 0.f;
}
__device__ __forceinline__ u32x4 at_gload(int tid, const bf16_t* base, long rstride) {
    const int row = tid >> 3, piece = tid & 7;
    return *(const u32x4*)(base + (long)row * rstride + piece * 8);
}
__device__ __forceinline__ void at_lwrite(int tid, LAS unsigned char* dst, u32x4 v) {
    const int row = tid >> 3, piece = tid & 7;
    *(LAS u32x4*)(dst + row * AT_ROWB + piece * 16) = v;
}
typedef __bf16 bf16x2n __attribute__((ext_vector_type(2)));
__device__ __forceinline__ unsigned pk_bf16_native(float lo, float hi) { bf16x2n v = {(__bf16)lo, (__bf16)hi}; return __builtin_bit_cast(unsigned, v); }
__device__ __forceinline__ float max3f(float a, float b, float c) { float r; asm("v_max3_f32 %0, %1, %2, %3" : "=v"(r) : "v"(a), "v"(b), "v"(c)); return r; }
__device__ __forceinline__ void at_scores(LAS const unsigned char* ktl, const bf16x8 (&qf)[4], f32x16& s0, f32x16& s1, const f32x16& ci) {
    bf16x8 kf[8];
#pragma unroll
    for (int s = 0; s < 4; ++s) { kf[2 * s] = *(LAS const bf16x8*)(ktl + s * 32); kf[2 * s + 1] = *(LAS const bf16x8*)(ktl + 32 * AT_ROWB + s * 32); }
    __builtin_amdgcn_sched_barrier(0);
    s0 = __builtin_amdgcn_mfma_f32_32x32x16_bf16(kf[0], qf[0], ci, 0, 0, 0);
    s1 = __builtin_amdgcn_mfma_f32_32x32x16_bf16(kf[1], qf[0], ci, 0, 0, 0);
#pragma unroll
    for (int s = 1; s < 4; ++s) {
        s0 = __builtin_amdgcn_mfma_f32_32x32x16_bf16(kf[2 * s], qf[s], s0, 0, 0, 0);
        s1 = __builtin_amdgcn_mfma_f32_32x32x16_bf16(kf[2 * s + 1], qf[s], s1, 0, 0, 0);
    }
}
__device__ __forceinline__ void at_scores0(LAS const unsigned char* ktl, const bf16x8 (&qf)[4], f32x16& s0, f32x16& s1) {
    f32x16 z;
#pragma unroll
    for (int i = 0; i < 16; ++i) z[i] = 0.f;
    at_scores(ktl, qf, s0, s1, z);
}
__device__ __forceinline__ void at_vload(LAS const unsigned char* vtl, bf16x8 (&vf)[8]) {
#pragma unroll
    for (int ks = 0; ks < 4; ++ks) { vf[2 * ks] = *(LAS const bf16x8*)(vtl + ks * 32); vf[2 * ks + 1] = *(LAS const bf16x8*)(vtl + 32 * AT_ROWB + ks * 32); }
}
template <bool MASKQ = false>
__device__ __forceinline__ void at_pv(const bf16x8 (&vf)[8], const f32x16& p0, const f32x16& p1, AttSt& st, bool mine = true) {
    bf16x8 pf[4];
#pragma unroll
    for (int sg = 0; sg < 2; ++sg) {
        u32x4 a, b;
        a.x = pk_bf16_native(p0[8 * sg + 0], p0[8 * sg + 1]); a.y = pk_bf16_native(p0[8 * sg + 2], p0[8 * sg + 3]); a.z = pk_bf16_native(p0[8 * sg + 4], p0[8 * sg + 5]); a.w = pk_bf16_native(p0[8 * sg + 6], p0[8 * sg + 7]);
        b.x = pk_bf16_native(p1[8 * sg + 0], p1[8 * sg + 1]); b.y = pk_bf16_native(p1[8 * sg + 2], p1[8 * sg + 3]); b.z = pk_bf16_native(p1[8 * sg + 4], p1[8 * sg + 5]); b.w = pk_bf16_native(p1[8 * sg + 6], p1[8 * sg + 7]);
        if (MASKQ) { a.x = mine ? a.x : 0u; a.y = mine ? a.y : 0u; a.z = mine ? a.z : 0u; a.w = mine ? a.w : 0u; b.x = mine ? b.x : 0u; b.y = mine ? b.y : 0u; b.z = mine ? b.z : 0u; b.w = mine ? b.w : 0u; }
        pf[sg] = __builtin_bit_cast(bf16x8, a); pf[2 + sg] = __builtin_bit_cast(bf16x8, b);
    }
#pragma unroll
    for (int ks = 0; ks < 4; ++ks) {
        st.O0 = __builtin_amdgcn_mfma_f32_32x32x16_bf16(vf[2 * ks], pf[ks], st.O0, 0, 0, 0);
        st.O1 = __builtin_amdgcn_mfma_f32_32x32x16_bf16(vf[2 * ks + 1], pf[ks], st.O1, 0, 0, 0);
    }
}
#define AT_THR 20.0f
template <bool MASKQ = false>
__device__ __forceinline__ void at_softmax_pv(LAS const unsigned char* vtl, f32x16& s0, f32x16& s1, AttSt& st, bool mine = true) {
    bf16x8 vf[8];
    at_vload(vtl, vf);
    __builtin_amdgcn_sched_barrier(0);
    float tm = fmaxf(s0[15], s1[15]);
#pragma unroll
    for (int i = 0; i < 15; ++i) tm = max3f(tm, s0[i], s1[i]);
    tm = half_swap_max(tm);
    if (MASKQ) tm = mine ? tm : NEG_INF;
    const bool unset = (st.m == NEG_INF);
    const bool need = unset ? (tm > NEG_INF) : (tm > AT_THR);
    if (__any(need)) {
        const float delta = need ? tm : 0.f;
        const float al = __builtin_amdgcn_exp2f(-delta);
#pragma unroll
        for (int i = 0; i < 16; ++i) { s0[i] -= delta; s1[i] -= delta; st.O0[i] *= al; st.O1[i] *= al; st.CI[i] -= delta; }
        st.l *= al;
        st.m = need ? ((unset ? 0.f : st.m) + delta) : st.m;
    }
    typedef float f32x2v __attribute__((ext_vector_type(2)));
    f32x2v ls = (f32x2v){0.f, 0.f};
#pragma unroll
    for (int i = 0; i < 16; ++i) { s0[i] = __builtin_amdgcn_exp2f(s0[i]); s1[i] = __builtin_amdgcn_exp2f(s1[i]); }
#pragma unroll
    for (int i = 0; i < 16; i += 2) { ls += (f32x2v){s0[i], s0[i + 1]}; ls += (f32x2v){s1[i], s1[i + 1]}; }
    const float lsum = ls.x + ls.y;
    st.l += MASKQ ? (mine ? lsum : 0.f) : lsum;
    at_pv<MASKQ>(vf, s0, s1, st, mine);
}
#define AT_KO(tau, reg) (32 * (tau) + 16 * ((reg) >> 3) + ((reg) & 7))

__device__ __forceinline__ void at_bias_table(f32x16& s0, f32x16& s1, LAS const float* tabl) {
#pragma unroll
    for (int i = 0; i < 16; ++i) { s0[i] += tabl[AT_KO(0, i)]; s1[i] += tabl[AT_KO(1, i)]; }
}
__device__ __forceinline__ void at_mask_gt(f32x16& s0, f32x16& s1, int thrl) {
#pragma unroll
    for (int i = 0; i < 16; ++i) { s0[i] = (AT_KO(0, i) > thrl) ? s0[i] : NEG_INF; s1[i] = (AT_KO(1, i) > thrl) ? s1[i] : NEG_INF; }
}
__device__ __forceinline__ void at_mask_lt(f32x16& s0, f32x16& s1, int thrl) {
#pragma unroll
    for (int i = 0; i < 16; ++i) { s0[i] = (AT_KO(0, i) < thrl) ? s0[i] : NEG_INF; s1[i] = (AT_KO(1, i) < thrl) ? s1[i] : NEG_INF; }
}
__device__ __forceinline__ void at_store(bf16_t* dst  , const AttSt& st, float scale, int hq) {
#pragma unroll
    for (int dl = 0; dl < 2; ++dl)
#pragma unroll
        for (int sg = 0; sg < 2; ++sg) {
            const f32x16& O = dl ? st.O1 : st.O0;
            u32x4 w;
            w.x = cvt_pk_bf16(O[8 * sg + 0] * scale, O[8 * sg + 1] * scale); w.y = cvt_pk_bf16(O[8 * sg + 2] * scale, O[8 * sg + 3] * scale);
            w.z = cvt_pk_bf16(O[8 * sg + 4] * scale, O[8 * sg + 5] * scale); w.w = cvt_pk_bf16(O[8 * sg + 6] * scale, O[8 * sg + 7] * scale);
            *(u32x4*)(dst + 32 * dl + 16 * sg + 8 * hq) = w;
        }
}
__device__ __forceinline__ int at_pi(int rho) { return (rho & 0x13) | ((rho & 4) << 1) | ((rho & 8) >> 1); }

__device__ __forceinline__ void build_tables(const Params& p, LAS unsigned char* lds) {
    LAS float* TR = (LAS float*)(lds + LDS_TAB_OFF);
    for (int e = threadIdx.x; e < 16 * 256; e += NTHR) {
        const int h = e >> 8, x = e & 255, dist = 191 - x;
        float v;
        if (dist < 0) v = NEG_INF;
        else if (dist < 128) v = (p.rel_bias[kBucket[dist] * 16 + h] - ((h < 8) ? 0.f : p.rel_bias[31 * 16 + h])) * LOG2E;
        else v = (h < 8) ? NEG_INF : 0.f;
        TR[e] = v;
    }
    __syncthreads();
}

#define AT_STEP(RKL, RVL, RKW, RVW, KB, KST, KRS, VB, VST, VRS, ...) { \
        { const int jl_ = (j + 3 < je_) ? j + 3 : je_; RKL = at_gload(tid, (KB) + (long)jl_ * (KST), (KRS)); RVL = at_gload(tid, (VB) + (long)jl_ * (VST), (VRS)); } \
        { const int buf = (j - j0_) & 1; __VA_ARGS__ \
          if (j < je_) { at_lwrite(tid, lds + AT_KT(buf ^ 1), RKW); at_lwrite(tid, lds + AT_VT(buf ^ 1), RVW); } } \
        __syncthreads(); \
        if (j == je_) break; \
        ++j; }
struct TileSets { u32x4 k0, v0, k1, v1, k2, v2; };
#define AT_PRELOAD(S, J0, JE, KB, KST, KRS, VB, VST, VRS) { \
        const int a_ = (J0), e_ = (JE); const int b_ = (a_ + 1 < e_) ? a_ + 1 : e_, c_ = (a_ + 2 < e_) ? a_ + 2 : e_; \
        S.k0 = at_gload(tid, (KB) + (long)a_ * (KST), (KRS)); S.v0 = at_gload(tid, (VB) + (long)a_ * (VST), (VRS)); \
        S.k1 = at_gload(tid, (KB) + (long)b_ * (KST), (KRS)); S.v1 = at_gload(tid, (VB) + (long)b_ * (VST), (VRS)); \
        S.k2 = at_gload(tid, (KB) + (long)c_ * (KST), (KRS)); S.v2 = at_gload(tid, (VB) + (long)c_ * (VST), (VRS)); }
#define AT_LOOP_FROM(S, J0, JE, KB, KST, KRS, VB, VST, VRS, ...) { \
        const int j0_ = (J0), je_ = (JE); \
        at_lwrite(tid, lds + AT_KT(0), S.k0); at_lwrite(tid, lds + AT_VT(0), S.v0); \
        __syncthreads(); \
        for (int j = j0_;;) { \
            AT_STEP(S.k0, S.v0, S.k1, S.v1, KB, KST, KRS, VB, VST, VRS, __VA_ARGS__) \
            AT_STEP(S.k1, S.v1, S.k2, S.v2, KB, KST, KRS, VB, VST, VRS, __VA_ARGS__) \
            AT_STEP(S.k2, S.v2, S.k0, S.v0, KB, KST, KRS, VB, VST, VRS, __VA_ARGS__) \
        } }

__device__ __forceinline__ void attn_aw_unit(const Params& p, int l, int b, int g, int c, LAS unsigned char* lds) {
    int tid = threadIdx.x; asm volatile("" : "+v"(tid));
    const int wave = tid >> 6, lane = tid & 63, r = wave & 3, th = wave >> 2, hq = lane >> 5, ql = lane & 31;
    const int h = g * 4 + r, bg = b * 2 + g;
    const int tl = 32 * th + ql;
    const long tok = (long)b * SEQ + 64 * c + tl;
    LAS const unsigned char* ktl = lds + at_pi(ql) * AT_ROWB + 16 * hq;
    LAS const unsigned char* vtl = lds + at_pi(ql) * AT_ROWB + 16 * hq;
    LAS const float* TR = (LAS const float*)(lds + LDS_TAB_OFF);
    bf16x8 qf[4], qfb[4];
    AttSt st;
    const bf16_t* KAp = p.KA + (long)bg * SEQ * 64; const bf16_t* VAp = p.VAT + (long)bg * 64 * SEQ;
    const bf16_t* KWp = p.KW + (long)bg * SEQ * 64; const bf16_t* VWp = p.VWT + (long)bg * 64 * SEQ;
    const int ja0 = (c - 2 < 0) ? 0 : c - 2, jw0 = (c - 8 < 0) ? 0 : c - 8;
    TileSets SA, SW;
#pragma unroll
    for (int s = 0; s < 4; ++s) qf[s] = *(const bf16x8*)(p.QA + tok * 512 + h * 64 + 16 * s + 8 * hq);
    AT_PRELOAD(SA, ja0, c, KAp, 4096, 64, VAp, 64, SEQ)
#pragma unroll
    for (int s = 0; s < 4; ++s) qfb[s] = *(const bf16x8*)(p.QB + tok * 512 + h * 64 + 16 * s + 8 * hq);
    AT_PRELOAD(SW, jw0, c, KWp, 4096, 64, VWp, 64, SEQ)
    const float gwin = p.G24[tok * 32 + h * 3 + 2];
    const float sinkv = p.a_sinks[l * 8 + h] * LOG2E;
    const float cbw = p.rel_bias[31 * 16 + 8 + h] * LOG2E;
    {
        att_init(st);
        AT_LOOP_FROM(SA, ja0, c, KAp, 4096, 64, VAp, 64, SEQ, {
            f32x16 s0, s1;
            at_scores(ktl + AT_KT(buf), qf, s0, s1, st.CI);
            const int drel = 64 * (c - j) + tl;
            at_bias_table(s0, s1, TR + h * 256 + (191 - drel + 8 * hq));
            at_softmax_pv(vtl + AT_VT(buf), s0, s1, st); })
        float lt = half_swap_sum(st.l);
        lt += __builtin_amdgcn_exp2f(sinkv - st.m);
        at_store(p.OAB + tok * 1024 + h * 64, st, 1.0f / lt, hq);
    }
    {
        att_init(st, cbw);
        AT_LOOP_FROM(SW, jw0, c, KWp, 4096, 64, VWp, 64, SEQ, {
            f32x16 s0, s1;
            at_scores(ktl + AT_KT(buf), qfb, s0, s1, st.CI);
            if (j >= c - 2) {
                const int drel = 64 * (c - j) + tl;
                at_bias_table(s0, s1, TR + (8 + h) * 256 + (191 - drel + 8 * hq));
            } else if (j == c - 8) at_mask_gt(s0, s1, tl - 8 * hq);
            at_softmax_pv(vtl + AT_VT(buf), s0, s1, st); })
        const float lt = half_swap_sum(st.l);
        at_store(p.OW + tok * 512 + h * 64, st, gwin / lt, hq);
    }
}

__device__ __forceinline__ void attn_cs_unit(const Params& p, int b, int g, int c, LAS unsigned char* lds) {
    int tid = threadIdx.x; asm volatile("" : "+v"(tid));
    const int wave = tid >> 6, lane = tid & 63, r = wave & 3, th = wave >> 2, hq = lane >> 5, ql = lane & 31;
    const int h = g * 4 + r, bg = b * 2 + g;
    const int tl = 32 * th + ql, tq = 64 * c + tl;
    const long tok = (long)b * SEQ + tq;
    LAS const unsigned char* ktl = lds + at_pi(ql) * AT_ROWB + 16 * hq;
    LAS const unsigned char* vtl = lds + at_pi(ql) * AT_ROWB + 16 * hq;
    LAS const float* TR = (LAS const float*)(lds + LDS_TAB_OFF);
    LAS float* IMP = (LAS float*)(lds + AT_IMP);
    LAS unsigned long long* SEL = (LAS unsigned long long*)(lds + AT_SEL);
    bf16x8 qf[4];
#pragma unroll
    for (int s = 0; s < 4; ++s) qf[s] = *(const bf16x8*)(p.QB + tok * 512 + h * 64 + 16 * s + 8 * hq);
    const int nv = (tq >= 31) ? ((tq - 31) / 16 + 1) : 0;
    const int nv_hi = (64 * c + 63 - 31) / 16 + 1;
    const int ntile = (nv_hi + 63) / 64;
    const bf16_t* KC = p.KCMP + (long)bg * 256 * 64; const bf16_t* VCT = p.VCMPT + (long)bg * 64 * 256;
    const bf16_t* KSp = p.KS + (long)bg * SEQ * 64; const bf16_t* VSp = p.VST + (long)bg * 64 * SEQ;
    TileSets S1, S2;
    AT_PRELOAD(S1, 0, ntile - 1, KC, 4096, 64, VCT, 64, 256)
    AT_PRELOAD(S2, 0, ntile - 1, KC, 4096, 64, VCT, 64, 256)
    const float g0 = p.G24[tok * 32 + h * 3 + 0], g1 = p.G24[tok * 32 + h * 3 + 1];
    u32x4 owp[4];
#pragma unroll
    for (int q4 = 0; q4 < 4; ++q4) owp[q4] = *(const u32x4*)(p.OW + tok * 512 + h * 64 + 32 * (q4 >> 1) + 16 * (q4 & 1) + 8 * hq);
    const float cbs = p.rel_bias[31 * 16 + 8 + h] * LOG2E;
    float m1 = NEG_INF, l1 = 0.f;
    AT_LOOP_FROM(S1, 0, ntile - 1, KC, 4096, 64, VCT, 64, 256, {
        f32x16 s0, s1;
        at_scores0(ktl + AT_KT(buf), qf, s0, s1);
        at_mask_lt(s0, s1, nv - 64 * j - 8 * hq);
        float tm = fmaxf(s0[15], s1[15]);
        _Pragma("unroll") for (int i = 0; i < 15; ++i) tm = max3f(tm, s0[i], s1[i]);
        tm = half_swap_max(tm);
        if (tm > m1) { l1 *= __builtin_amdgcn_exp2f(m1 - tm); m1 = tm; }
        const float mu = (m1 == NEG_INF) ? 0.f : m1;
        float ls = 0.f;
        _Pragma("unroll") for (int i = 0; i < 16; ++i) ls += __builtin_amdgcn_exp2f(s0[i] - mu) + __builtin_amdgcn_exp2f(s1[i] - mu);
        l1 += ls; })
    l1 = half_swap_sum(l1);
    const float inv1 = (l1 > 0.f) ? 1.0f / l1 : 0.f;
    const float mu1 = (m1 == NEG_INF) ? 0.f : m1;
    AttSt st; att_init(st);
    float imp_carry = 0.f;
    AT_PRELOAD(S1, 0, c, KSp, 4096, 64, VSp, 64, SEQ)
    AT_LOOP_FROM(S2, 0, ntile - 1, KC, 4096, 64, VCT, 64, 256, {
        f32x16 s0, s1;
        at_scores0(ktl + AT_KT(buf), qf, s0, s1);
        at_mask_lt(s0, s1, nv - 64 * j - 8 * hq);
        _Pragma("unroll") for (int i = 0; i < 16; ++i) { s0[i] = __builtin_amdgcn_exp2f(s0[i] - mu1) * inv1; s1[i] = __builtin_amdgcn_exp2f(s1[i] - mu1) * inv1; }
        if (c >= 16) { float G0[4], G1[4];
          _Pragma("unroll") for (int a = 0; a < 4; ++a) { G0[a] = (s0[4 * a] + s0[4 * a + 1]) + (s0[4 * a + 2] + s0[4 * a + 3]); G1[a] = (s1[4 * a] + s1[4 * a + 1]) + (s1[4 * a + 2] + s1[4 * a + 3]); }
          const float r01 = half_other(s0[7], hq), r03 = half_other(s0[15], hq), r11 = half_other(s1[7], hq), r13 = half_other(s1[15], hq);
          LAS float* irow = IMP + (r * 64 + tl) * 66 + 16 * j + 2 * hq;
          irow[0]  = G0[0] + (hq ? r01 : imp_carry);
          irow[1]  = G0[1] + s0[3];
          irow[4]  = G0[2] + (hq ? r03 : r01);
          irow[5]  = G0[3] + s0[11];
          irow[8]  = G1[0] + (hq ? r11 : r03);
          irow[9]  = G1[1] + s1[3];
          irow[12] = G1[2] + (hq ? r13 : r11);
          irow[13] = G1[3] + s1[11];
          imp_carry = r13; }
        { bf16x8 vf[8]; at_vload(vtl + AT_VT(buf), vf); at_pv(vf, s0, s1, st); } })
    {
        bf16_t* dst = p.OAB + tok * 1024 + 512 + h * 64;
#pragma unroll
        for (int dl = 0; dl < 2; ++dl)
#pragma unroll
            for (int sg = 0; sg < 2; ++sg) {
                const f32x16& O = dl ? st.O1 : st.O0;
                const u32x4 wv = owp[dl * 2 + sg];
                u32x4 w;
                w.x = cvt_pk_bf16(O[8 * sg + 0] * g0 + bf16lo(wv.x), O[8 * sg + 1] * g0 + bf16hi(wv.x)); w.y = cvt_pk_bf16(O[8 * sg + 2] * g0 + bf16lo(wv.y), O[8 * sg + 3] * g0 + bf16hi(wv.y));
                w.z = cvt_pk_bf16(O[8 * sg + 4] * g0 + bf16lo(wv.z), O[8 * sg + 5] * g0 + bf16hi(wv.z)); w.w = cvt_pk_bf16(O[8 * sg + 6] * g0 + bf16lo(wv.w), O[8 * sg + 7] * g0 + bf16hi(wv.w));
                *(u32x4*)(dst + 32 * dl + 16 * sg + 8 * hq) = w;
            }
    }
    unsigned long long mysel;
    if (c < 16) {
        mysel = (2ull << c) - 1ull;
    } else {
        const int js = lane, tb = c;
        const bool causal = js <= tb, forced = (js == 0) || (js == tb) || (js == tb - 1);
        const bool cand = causal && !forced;
        const unsigned long long mforced = __ballot(causal && forced), mcand = __ballot(cand);
        const int want = 16 - __builtin_popcountll(mforced);
#pragma unroll 1
        for (int k = 0; k < 8; k += 2) {
            const int t = 8 * wave + k;
            const unsigned va = __float_as_uint((IMP[t * 66 + js] + IMP[(64 + t) * 66 + js]) + (IMP[(128 + t) * 66 + js] + IMP[(192 + t) * 66 + js]));
            const unsigned vc = __float_as_uint((IMP[(t + 1) * 66 + js] + IMP[(65 + t) * 66 + js]) + (IMP[(129 + t) * 66 + js] + IMP[(193 + t) * 66 + js]));
            unsigned Ta = 0u, Tc = 0u; bool da = false, dc = false;
            unsigned long long msa = 0ull, msc = 0ull;
#pragma unroll 1
            for (int bit = 30; bit >= 0; --bit) {
                const unsigned tra = Ta | (1u << bit), trc = Tc | (1u << bit);
                const unsigned long long mga = __ballot(cand && va >= tra), mgc = __ballot(cand && vc >= trc);
                const int ca = __builtin_popcountll(mga), cc = __builtin_popcountll(mgc);
                if (!da) { if (ca == want) { msa = mga; da = true; } else Ta = (ca > want) ? tra : Ta; }
                if (!dc) { if (cc == want) { msc = mgc; dc = true; } else Tc = (cc > want) ? trc : Tc; }
                if (da && dc) break;
            }
            if (!da) {
                const unsigned long long mgt = __ballot(cand && va > Ta), meq = __ballot(cand && va == Ta);
                const int rq = want - __builtin_popcountll(mgt);
                const int below = __builtin_amdgcn_mbcnt_hi((unsigned)(meq >> 32), __builtin_amdgcn_mbcnt_lo((unsigned)meq, 0));
                msa = mgt | __ballot(cand && va == Ta && below < rq);
            }
            if (!dc) {
                const unsigned long long mgt = __ballot(cand && vc > Tc), meq = __ballot(cand && vc == Tc);
                const int rq = want - __builtin_popcountll(mgt);
                const int below = __builtin_amdgcn_mbcnt_hi((unsigned)(meq >> 32), __builtin_amdgcn_mbcnt_lo((unsigned)meq, 0));
                msc = mgt | __ballot(cand && vc == Tc && below < rq);
            }
            if (lane == 0) { SEL[t] = msa | mforced; SEL[t + 1] = msc | mforced; }
        }
        __syncthreads();
        mysel = SEL[tl];
    }
    {
        att_init(st, cbs);
        AT_LOOP_FROM(S1, 0, c, KSp, 4096, 64, VSp, 64, SEQ, {
            const bool mine = (mysel >> j) & 1ull;
            if (__ballot(mine) != 0ull) {
                f32x16 s0, s1;
                at_scores(ktl + AT_KT(buf), qf, s0, s1, st.CI);
                if (j >= c - 2) {
                    const int drel = 64 * (c - j) + tl;
                    at_bias_table(s0, s1, TR + (8 + h) * 256 + (191 - drel + 8 * hq));
                }
                at_softmax_pv<true>(vtl + AT_VT(buf), s0, s1, st, mine);
            } })
        const float lt = half_swap_sum(st.l);
        const float g1l = g1 / lt;
        bf16_t* dst = p.OAB + tok * 1024 + 512 + h * 64;
#pragma unroll
        for (int dl = 0; dl < 2; ++dl)
#pragma unroll
            for (int sg = 0; sg < 2; ++sg) {
                const f32x16& O = dl ? st.O1 : st.O0;
                const u32x4 wv = *(const u32x4*)(dst + 32 * dl + 16 * sg + 8 * hq);
                u32x4 w;
                w.x = cvt_pk_bf16(O[8 * sg + 0] * g1l + bf16lo(wv.x), O[8 * sg + 1] * g1l + bf16hi(wv.x)); w.y = cvt_pk_bf16(O[8 * sg + 2] * g1l + bf16lo(wv.y), O[8 * sg + 3] * g1l + bf16hi(wv.y));
                w.z = cvt_pk_bf16(O[8 * sg + 4] * g1l + bf16lo(wv.z), O[8 * sg + 5] * g1l + bf16hi(wv.z)); w.w = cvt_pk_bf16(O[8 * sg + 6] * g1l + bf16lo(wv.w), O[8 * sg + 7] * g1l + bf16hi(wv.w));
                *(u32x4*)(dst + 32 * dl + 16 * sg + 8 * hq) = w;
            }
    }
}
struct EpiGate {
    static constexpr bool PERM = true;
    const float* rs; bf16_t* DST;
    __device__ __forceinline__ void operator()(const AccT& acc, const pg8::Unit& u, int wr, int wc, int fr, int fq) const {
        const int row0 = u.pm * 256 + wr * 64 + fr;
        float rr[2][4];
#pragma unroll
        for (int ai = 0; ai < 2; ++ai)
#pragma unroll
            for (int m = 0; m < 4; ++m) rr[ai][m] = rs[row0 + ai * 128 + m * 16];
#pragma unroll
        for (int ai = 0; ai < 2; ++ai)
#pragma unroll
            for (int m = 0; m < 4; ++m) {
                const float r = rr[ai][m];
                bf16_t* dp = DST + (long)(row0 + ai * 128 + m * 16) * 1024 + u.pn * 256 + wc * 32 + fq * 8;
#pragma unroll
                for (int bj = 0; bj < 2; ++bj) {
                    const f32x4 v0 = acc[ai][bj][m][0], v1 = acc[ai][bj][m][1];
                    u32x4 w; w.x = cvt_pk_bf16(fast_sigmoid(v0[0] * r), fast_sigmoid(v0[1] * r)); w.y = cvt_pk_bf16(fast_sigmoid(v0[2] * r), fast_sigmoid(v0[3] * r));
                    w.z = cvt_pk_bf16(fast_sigmoid(v1[0] * r), fast_sigmoid(v1[1] * r)); w.w = cvt_pk_bf16(fast_sigmoid(v1[2] * r), fast_sigmoid(v1[3] * r));
                    *(u32x4*)(dp + bj * 128) = w;
                    __builtin_amdgcn_sched_barrier(0);
                }
            }
    }
};
struct EpiMerge2 {
    static constexpr bool PERM = true;
    bf16_t* MERGED; const bf16_t* GB;
    static __device__ __forceinline__ float gclamp(float g) { return fmaxf(g, 1e-30f); }
    __device__ __forceinline__ void mid(AccT& acc, const pg8::Unit& u, int wr, int wc, int fr, int fq) const {
        int row0 = u.pm * 256 + wr * 64 + fr;
        asm volatile("" : "+v"(row0));
        const long cbase = (long)u.pn * 256 + wc * 32 + fq * 8;
        u32x4 ac[2], bc[2], an[2], bn[2];
#pragma unroll
        for (int bj = 0; bj < 2; ++bj) {
            ac[bj] = *(const u32x4*)(MERGED + (long)row0 * 1024 + cbase + bj * 128); bc[bj] = *(const u32x4*)(GB + (long)row0 * 1024 + cbase + bj * 128);
            an[bj] = ac[bj]; bn[bj] = bc[bj];
        }
#pragma unroll
        for (int i = 0; i < 8; ++i) {
            const int ai = i >> 2, m = i & 3;
            if (i < 7) {
                const long on = (long)(row0 + ((i + 1) >> 2) * 128 + ((i + 1) & 3) * 16) * 1024 + cbase;
#pragma unroll
                for (int bj = 0; bj < 2; ++bj) { an[bj] = *(const u32x4*)(MERGED + on + bj * 128); bn[bj] = *(const u32x4*)(GB + on + bj * 128); }
            }
#pragma unroll
            for (int bj = 0; bj < 2; ++bj) {
                const u32x4 a = ac[bj], b = bc[bj];
                f32x4& v0 = acc[ai][bj][m][0]; f32x4& v1 = acc[ai][bj][m][1];
                v0[0] *= bf16lo(a.x) * __builtin_amdgcn_rcpf(gclamp(bf16lo(b.x))); v0[1] *= bf16hi(a.x) * __builtin_amdgcn_rcpf(gclamp(bf16hi(b.x)));
                v0[2] *= bf16lo(a.y) * __builtin_amdgcn_rcpf(gclamp(bf16lo(b.y))); v0[3] *= bf16hi(a.y) * __builtin_amdgcn_rcpf(gclamp(bf16hi(b.y)));
                v1[0] *= bf16lo(a.z) * __builtin_amdgcn_rcpf(gclamp(bf16lo(b.z))); v1[1] *= bf16hi(a.z) * __builtin_amdgcn_rcpf(gclamp(bf16hi(b.z)));
                v1[2] *= bf16lo(a.w) * __builtin_amdgcn_rcpf(gclamp(bf16lo(b.w))); v1[3] *= bf16hi(a.w) * __builtin_amdgcn_rcpf(gclamp(bf16hi(b.w)));
            }
#pragma unroll
            for (int bj = 0; bj < 2; ++bj) { ac[bj] = an[bj]; bc[bj] = bn[bj]; }
            __builtin_amdgcn_sched_barrier(0);
        }
    }
    __device__ __forceinline__ void operator()(const AccT& acc, const pg8::Unit& u, int wr, int wc, int fr, int fq) const {
        const int row0 = u.pm * 256 + wr * 64 + fr;
        const long cbase = (long)u.pn * 256 + wc * 32 + fq * 8;
        u32x4 gc[2], gn[2];
#pragma unroll
        for (int bj = 0; bj < 2; ++bj) { gc[bj] = *(const u32x4*)(GB + (long)row0 * 1024 + cbase + bj * 128); gn[bj] = gc[bj]; }
#pragma unroll
        for (int i = 0; i < 8; ++i) {
            const int ai = i >> 2, m = i & 3;
            const long o = (long)(row0 + ai * 128 + m * 16) * 1024 + cbase;
            if (i < 7) {
                const long on = (long)(row0 + ((i + 1) >> 2) * 128 + ((i + 1) & 3) * 16) * 1024 + cbase;
#pragma unroll
                for (int bj = 0; bj < 2; ++bj) gn[bj] = *(const u32x4*)(GB + on + bj * 128);
            }
#pragma unroll
            for (int bj = 0; bj < 2; ++bj) {
                const f32x4 v0 = acc[ai][bj][m][0], v1 = acc[ai][bj][m][1];
                const u32x4 gg = gc[bj];
                u32x4 w;
                w.x = cvt_pk_bf16(gclamp(bf16lo(gg.x)) * v0[0], gclamp(bf16hi(gg.x)) * v0[1]); w.y = cvt_pk_bf16(gclamp(bf16lo(gg.y)) * v0[2], gclamp(bf16hi(gg.y)) * v0[3]);
                w.z = cvt_pk_bf16(gclamp(bf16lo(gg.z)) * v1[0], gclamp(bf16hi(gg.z)) * v1[1]); w.w = cvt_pk_bf16(gclamp(bf16lo(gg.w)) * v1[2], gclamp(bf16hi(gg.w)) * v1[3]);
                *(u32x4*)(MERGED + o + bj * 128) = w;
            }
#pragma unroll
            for (int bj = 0; bj < 2; ++bj) gc[bj] = gn[bj];
            __builtin_amdgcn_sched_barrier(0);
        }
    }
};
struct EpiOut {
    static constexpr bool PERM = true;
    bf16_t* HB; float* ssq16;
    __device__ __forceinline__ void operator()(const AccT& acc, const pg8::Unit& u, int wr, int wc, int fr, int fq) const {
        const int row0 = u.pm * 256 + wr * 64 + fr;
        const long cbase = (long)u.pn * 256 + wc * 32 + fq * 8;
        u32x4 cur[2], nxt[2];
#pragma unroll
        for (int bj = 0; bj < 2; ++bj) cur[bj] = *(const u32x4*)(HB + (long)row0 * 1024 + cbase + bj * 128);
#pragma unroll
        for (int i = 0; i < 8; ++i) {
            const int ai = i >> 2, m = i & 3;
            const int row = row0 + ai * 128 + m * 16;
            if (i < 7) {
                const int rown = row0 + ((i + 1) >> 2) * 128 + ((i + 1) & 3) * 16;
#pragma unroll
                for (int bj = 0; bj < 2; ++bj) nxt[bj] = *(const u32x4*)(HB + (long)rown * 1024 + cbase + bj * 128);
            }
            float ss = 0.f;
#pragma unroll
            for (int bj = 0; bj < 2; ++bj) {
                const long oo = (long)row * 1024 + cbase + bj * 128;
                const u32x4 c = cur[bj];
                const f32x4 h0 = {bf16lo(c.x), bf16hi(c.x), bf16lo(c.y), bf16hi(c.y)}, h1 = {bf16lo(c.z), bf16hi(c.z), bf16lo(c.w), bf16hi(c.w)};
                const f32x4 v0 = h0 + acc[ai][bj][m][0], v1 = h1 + acc[ai][bj][m][1];
                u32x4 w; w.x = cvt_pk_bf16(v0[0], v0[1]); w.y = cvt_pk_bf16(v0[2], v0[3]); w.z = cvt_pk_bf16(v1[0], v1[1]); w.w = cvt_pk_bf16(v1[2], v1[3]);
                *(u32x4*)(HB + oo) = w;
                ss += ((v0[0] * v0[0] + v0[1] * v0[1]) + (v0[2] * v0[2] + v0[3] * v0[3])) + ((v1[0] * v1[0] + v1[1] * v1[1]) + (v1[2] * v1[2] + v1[3] * v1[3]));
            }
            ss += swz_xor<16>(ss); ss = half_swap_sum(ss);
            if (fq == 0) ssq16[(long)row * 16 + u.pn * 4 + wc] = ss;
#pragma unroll
            for (int bj = 0; bj < 2; ++bj) cur[bj] = nxt[bj];
            __builtin_amdgcn_sched_barrier(0);
        }
    }
};

__device__ __forceinline__ void gates24_phase(const Params& p, int l, LAS unsigned char* lds) {
    constexpr int WROW = 136;
    LAS bf16_t* WB = (LAS bf16_t*)lds;
    int tid = threadIdx.x; asm volatile("" : "+v"(tid));
    const int wave = tid >> 6, lane = tid & 63, fr = lane & 15, kq = lane >> 4;
    const bf16_t* W = p.WinT + ((long)l * 4352 + 2048) * 1024;
    for (int tile = blockIdx.x; tile < T_TOK / 128; tile += gridDim.x) {
        const long t0 = (long)tile * 128;
        const bf16_t* xrow = p.HB + (t0 + wave * 16 + fr) * DM + kq * 8;
        f32x4 acc[2];
#pragma unroll
        for (int ct = 0; ct < 2; ++ct) acc[ct] = (f32x4){0.f, 0.f, 0.f, 0.f};
        bf16x8 xv[8][4];
#pragma unroll
        for (int c8 = 0; c8 < 8; ++c8)
#pragma unroll
            for (int ks = 0; ks < 4; ++ks) xv[c8][ks] = *(const bf16x8*)(xrow + c8 * 128 + ks * 32);
        const int wrow = tid >> 4, wpiece = tid & 15;
        u32x4 wq = *(const u32x4*)(W + (long)wrow * 1024 + wpiece * 8);
#pragma unroll
        for (int c8 = 0; c8 < 8; ++c8) {
            __syncthreads();
            *(LAS u32x4*)(WB + wrow * WROW + wpiece * 8) = wq;
            if (c8 < 7) wq = *(const u32x4*)(W + (long)wrow * 1024 + (c8 + 1) * 128 + wpiece * 8);
            __syncthreads();
#pragma unroll
            for (int ks = 0; ks < 4; ++ks)
#pragma unroll
                for (int ct = 0; ct < 2; ++ct) {
                    const bf16x8 bw = *(LAS const bf16x8*)(WB + (ct * 16 + fr) * WROW + ks * 32 + kq * 8);
                    acc[ct] = __builtin_amdgcn_mfma_f32_16x16x32_bf16(xv[c8][ks], bw, acc[ct], 0, 0, 0);
                }
        }
#pragma unroll
        for (int j = 0; j < 4; ++j) {
            const long t = t0 + wave * 16 + 4 * kq + j;
            const float r = p.rsA[t];
            p.G24[t * 32 + fr] = fast_sigmoid(acc[0][j] * r);
            if (fr < 8) p.G24[t * 32 + 16 + fr] = fast_sigmoid(acc[1][j] * r);
        }
    }
    __syncthreads();
}
typedef __bf16 bf16x8n __attribute__((ext_vector_type(8)));
__device__ __forceinline__ void router_phase(const Params& p, int l, LAS unsigned char* lds) {
    constexpr int WROW = 136;
    LAS bf16_t* WB = (LAS bf16_t*)lds;
    LAS float* LG = (LAS float*)(lds + 2 * 48 * WROW * 2);
    LAS int* HIST = (LAS int*)(lds + 2 * 48 * WROW * 2 + 128 * 37 * 4);
    int tid = threadIdx.x; asm volatile("" : "+v"(tid));
    const int wave = tid >> 6, lane = tid & 63, fr = lane & 15, kq = lane >> 4;
    const bf16_t* WH = p.WRH + (long)l * 48 * 1024; const bf16_t* WL = p.WRL + (long)l * 48 * 1024;
    if (blockIdx.x == 0 && tid == 0) p.rsB[T_TOK] = 1.0f;
    for (int tile = blockIdx.x; tile < T_TOK / 128; tile += gridDim.x) {
        const long t0 = (long)tile * 128;
        const bf16_t* xrow = p.HB + (t0 + wave * 16 + fr) * DM + kq * 8;
        f32x4 acc[3];
#pragma unroll
        for (int ct = 0; ct < 3; ++ct) acc[ct] = (f32x4){0.f, 0.f, 0.f, 0.f};
        if (tid < 32) HIST[tid] = 0;
        bf16x8 xv[8][4];
#pragma unroll
        for (int c8 = 0; c8 < 8; ++c8)
#pragma unroll
            for (int ks = 0; ks < 4; ++ks) xv[c8][ks] = *(const bf16x8*)(xrow + c8 * 128 + ks * 32);
        u32x4 wq[3];
#pragma unroll
        for (int i = 0; i < 3; ++i) {
            const int idx = tid + 512 * i, part = idx / 768, rem = idx % 768, row = rem >> 4, piece = rem & 15;
            wq[i] = *(const u32x4*)((part ? WL : WH) + (long)row * 1024 + piece * 8);
        }
#pragma unroll
        for (int c8 = 0; c8 < 8; ++c8) {
            __syncthreads();
#pragma unroll
            for (int i = 0; i < 3; ++i) {
                const int idx = tid + 512 * i, part = idx / 768, rem = idx % 768, row = rem >> 4, piece = rem & 15;
                *(LAS u32x4*)(WB + (part * 48 + row) * WROW + piece * 8) = wq[i];
                if (c8 < 7) wq[i] = *(const u32x4*)((part ? WL : WH) + (long)row * 1024 + (c8 + 1) * 128 + piece * 8);
            }
            __syncthreads();
#pragma unroll
            for (int ks = 0; ks < 4; ++ks) {
#pragma unroll
                for (int ct = 0; ct < 3; ++ct) {
                    const bf16x8 bh = *(LAS const bf16x8*)(WB + (ct * 16 + fr) * WROW + ks * 32 + kq * 8);
                    const bf16x8 bl = *(LAS const bf16x8*)(WB + (48 + ct * 16 + fr) * WROW + ks * 32 + kq * 8);
                    acc[ct] = __builtin_amdgcn_mfma_f32_16x16x32_bf16(xv[c8][ks], bh, acc[ct], 0, 0, 0);
                    acc[ct] = __builtin_amdgcn_mfma_f32_16x16x32_bf16(xv[c8][ks], bl, acc[ct], 0, 0, 0);
                }
            }
        }
#pragma unroll
        for (int ct = 0; ct < 3; ++ct) {
            const int n = ct * 16 + fr;
            if (n < 36) {
#pragma unroll
                for (int j = 0; j < 4; ++j) LG[(wave * 16 + 4 * kq + j) * 37 + n] = acc[ct][j];
            }
        }
        __syncthreads();
        if (tid < 128) {
            const long t = t0 + tid;
            float ss = 0.f;
#pragma unroll
            for (int i = 0; i < 4; ++i) { const float4 q = *(const float4*)(p.ssq16 + t * 16 + i * 4); ss += (q.x + q.y) + (q.z + q.w); }
            const float r = rsqrtf(ss * (1.0f / DM) + 1e-5f);
            p.rsB[t] = r;
            float gl[4]; int gs = 0; float gmax;
#pragma unroll
            for (int j = 0; j < 4; ++j) gl[j] = LG[tid * 37 + j] * r + p.b_group[l * 4 + j];
            gmax = gl[0];
#pragma unroll
            for (int j = 1; j < 4; ++j) if (gl[j] > gmax) { gmax = gl[j]; gs = j; }
            float den = 0.f;
#pragma unroll
            for (int j = 0; j < 4; ++j) den += __expf(gl[j] - gmax);
            const float gw = 1.0f / den;
            float el[8];
#pragma unroll
            for (int j = 0; j < 8; ++j) el[j] = LG[tid * 37 + 4 + gs * 8 + j] * r + p.b_expert[l * 32 + gs * 8 + j];
            int i0 = 0; float v0 = el[0];
#pragma unroll
            for (int j = 1; j < 8; ++j) if (el[j] > v0) { v0 = el[j]; i0 = j; }
            int i1 = -1; float v1 = NEG_INF;
#pragma unroll
            for (int j = 0; j < 8; ++j) if (j != i0 && (i1 < 0 || el[j] > v1)) { v1 = el[j]; i1 = j; }
            const float ex = __expf(v1 - v0);
            const float w0 = 1.0f / (1.0f + ex), w1 = ex / (1.0f + ex);
            const int e0 = gs * 8 + i0, e1 = gs * 8 + i1;
            p.eid[t * 2] = e0; p.eid[t * 2 + 1] = e1;
            p.ew[t * 2] = w0 * gw; p.ew[t * 2 + 1] = w1 * gw;
            __hip_atomic_fetch_add(HIST + e0, 1, __ATOMIC_RELAXED, __HIP_MEMORY_SCOPE_WORKGROUP);
            __hip_atomic_fetch_add(HIST + e1, 1, __ATOMIC_RELAXED, __HIP_MEMORY_SCOPE_WORKGROUP);
        }
        __syncthreads();
        if (tid < 32) p.cnt_tile[tile * 32 + tid] = HIST[tid];
        __syncthreads();
    }
}
__device__ __forceinline__ void scatter_phase(const Params& p, LAS unsigned char* lds) {
    LAS int* PST = (LAS int*)lds;
    LAS int* CNT = PST + 64;
    LAS int* PRE = PST + 128;
    LAS int* LCN = PST + 192;
    int tid = threadIdx.x; asm volatile("" : "+v"(tid));
    for (int tile = blockIdx.x; tile < T_TOK / 128; tile += gridDim.x) {
        __syncthreads();
        {
            LAS int* RT = PST + 256;
            LAS int* RP = RT + 512;
            const int e = tid & 31, grp = tid >> 5;
            int tot = 0, pre = 0;
#pragma unroll
            for (int i = grp; i < T_TOK / 128; i += 16) { const int c = p.cnt_tile[i * 32 + e]; tot += c; pre += (i < tile) ? c : 0; }
            RT[grp * 32 + e] = tot; RP[grp * 32 + e] = pre;
        }
        __syncthreads();
        if (tid < 32) {
            int tot = 0, pre = 0;
#pragma unroll
            for (int gq = 0; gq < 16; ++gq) { tot += PST[256 + gq * 32 + tid]; pre += PST[256 + 512 + gq * 32 + tid]; }
            CNT[tid] = tot; PRE[tid] = pre; LCN[tid] = 0;
        }
        __syncthreads();
        if (tid == 0) { int acc = 0; for (int e = 0; e < 32; ++e) { PST[e] = acc; acc += (CNT[e] + 255) / 256 * 256; } PST[32] = acc; }
        __syncthreads();
        if (tile == 0 && tid == 0) p.ntiles[0] = PST[32] / 256;
        if (tile == 0 && tid < 32) { p.counts[tid] = PST[tid] / 256; p.counts[32 + tid] = (PST[tid + 1] - PST[tid]) / 256; }
        if (tile < 32) {
            const int e = tile, s0 = PST[e], s1 = PST[e + 1], c = CNT[e];
            for (int tI = s0 / 256 + tid; tI < s1 / 256; tI += NTHR) p.tile_e[tI] = e;
            for (int s = s0 + c + tid; s < s1; s += NTHR) { p.toks[s] = T_TOK; p.slotw[s] = 0.f; p.slotdst[s] = -1; }
        }
        if (tid < 256) {
            const int a = tile * 256 + tid;
            const int e = p.eid[a];
            const int lp = __hip_atomic_fetch_add(LCN + e, 1, __ATOMIC_RELAXED, __HIP_MEMORY_SCOPE_WORKGROUP);
            const int s = PST[e] + PRE[e] + lp;
            p.toks[s] = a >> 1; p.slotw[s] = p.ew[a]; p.slotdst[s] = a;
        }
    }
}
template <int WHICH>
__device__ __forceinline__ void moe_stage_units(const Params& p, LAS unsigned char* lds) {
    LAS int* ul = (LAS int*)(lds + LDS_META_OFF);
    LAS int* ia = ul + 64; LAS float* fa = (LAS float*)(ia + 6 * 256);
    int tid = threadIdx.x; asm volatile("" : "+v"(tid));
    const int nt = p.ntiles[0];
    const int W = (int)gridDim.x >> 3, x = (int)blockIdx.x & 7, r = (int)blockIdx.x >> 3;
    int mx = 0;
#pragma unroll
    for (int q = 0; q < 8; ++q) { const int s = p.counts[32 + q] + p.counts[40 + q] + p.counts[48 + q] + p.counts[56 + q]; mx = s > mx ? s : mx; }
    const int rounds_plain = (nt * 4 + (int)gridDim.x - 1) / (int)gridDim.x;
    const bool local = ((int)gridDim.x & 7) == 0 && W > 0 && (mx * 4 + W - 1) / W <= (rounds_plain < 6 ? rounds_plain : 6);
    if (local) {
        const int n0 = p.counts[32 + x], n1 = p.counts[40 + x], n2 = p.counts[48 + x], n3 = p.counts[56 + x], tot = 4 * (n0 + n1 + n2 + n3);
        if (tid < 6) {
            const int j = tid * W + r, jt = j >> 2;
            const bool ok = j < tot;
            int pm = 0;
            if (ok) {
                if (jt < n0) pm = p.counts[x] + jt;
                else if (jt < n0 + n1) pm = p.counts[8 + x] + (jt - n0);
                else if (jt < n0 + n1 + n2) pm = p.counts[16 + x] + (jt - n0 - n1);
                else pm = p.counts[24 + x] + (jt - n0 - n1 - n2);
            }
            ul[2 + 2 * tid] = pm; ul[3 + 2 * tid] = ok ? p.tile_e[pm] * 4 + (j & 3) : 0;
        }
        if (tid == 0) { const int n = tot > r ? (tot - r + W - 1) / W : 0; ul[0] = n > 6 ? 6 : n; }
    } else {
        if (tid < 6) {
            const long L = (long)tid * gridDim.x + blockIdx.x;
            const bool ok = L < (long)nt * 4;
            const int pm = ok ? (int)(L >> 2) : 0;
            ul[2 + 2 * tid] = pm; ul[3 + 2 * tid] = ok ? p.tile_e[pm] * 4 + (int)(L & 3) : 0;
        }
        if (tid == 0) { const long rem = (long)nt * 4 - blockIdx.x; int n = rem > 0 ? (int)((rem + gridDim.x - 1) / gridDim.x) : 0; ul[0] = n > 6 ? 6 : n; }
    }
    __syncthreads();
    const int nu = ul[0];
    {
        int v0[3]; float w0[3];
#pragma unroll
        for (int q = 0; q < 3; ++q) {
            const int e = tid + q * NTHR;
            if (e < nu * 256) {
                const int row = ul[2 + 2 * (e >> 8)] * 256 + (e & 255);
                if (WHICH == 0) v0[q] = p.toks[row]; else { v0[q] = p.slotdst[row]; w0[q] = p.slotw[row]; }
            }
        }
#pragma unroll
        for (int q = 0; q < 3; ++q) {
            const int e = tid + q * NTHR;
            if (e < nu * 256) { ia[e] = v0[q]; fa[e] = (WHICH == 0) ? p.rsB[v0[q]] : w0[q]; }
        }
    }
    __syncthreads();
}
struct EpiMoe1 {
    static constexpr bool PERM = true;
    const LAS float* rsl; bf16_t* HMID;
    __device__ __forceinline__ void operator()(const AccT& acc, const pg8::Unit& u, int wr, int wc, int fr, int fq) const {
        const int row0 = u.pm * 256 + wr * 64 + fr;
        const int q = u.pn & 3;
        float rr[2][4];
#pragma unroll
        for (int ai = 0; ai < 2; ++ai)
#pragma unroll
            for (int m = 0; m < 4; ++m) rr[ai][m] = rsl[u.li * 256 + wr * 64 + fr + ai * 128 + m * 16];
#pragma unroll
        for (int ai = 0; ai < 2; ++ai)
#pragma unroll
            for (int m = 0; m < 4; ++m) {
                const float r = rr[ai][m];
                float y[8];
#pragma unroll
                for (int j = 0; j < 4; ++j) {
                    const float a0 = acc[ai][0][m][0][j] * r, b0 = acc[ai][1][m][0][j] * r, a1 = acc[ai][0][m][1][j] * r, b1 = acc[ai][1][m][1][j] * r;
                    y[j] = a0 * fast_sigmoid(a0) * b0; y[4 + j] = a1 * fast_sigmoid(a1) * b1;
                }
                u32x4 w; w.x = cvt_pk_bf16(y[0], y[1]); w.y = cvt_pk_bf16(y[2], y[3]); w.z = cvt_pk_bf16(y[4], y[5]); w.w = cvt_pk_bf16(y[6], y[7]);
                *(u32x4*)(HMID + (long)(row0 + ai * 128 + m * 16) * 512 + q * 128 + wc * 32 + fq * 8) = w;
                __builtin_amdgcn_sched_barrier(0);
            }
    }
};
struct EpiMoe2 {
    static constexpr bool PERM = true;
    const LAS int* dstl; const LAS float* wl; bf16_t* YS;
    __device__ __forceinline__ void operator()(const AccT& acc, const pg8::Unit& u, int wr, int wc, int fr, int fq) const {
        const int row0 = u.pm * 256 + wr * 64 + fr;
        const int q = u.pn & 3;
        int dd[2][4]; float ww[2][4];
#pragma unroll
        for (int ai = 0; ai < 2; ++ai)
#pragma unroll
            for (int m = 0; m < 4; ++m) { const int lr = u.li * 256 + wr * 64 + fr + ai * 128 + m * 16; dd[ai][m] = dstl[lr]; ww[ai][m] = wl[lr]; }
#pragma unroll
        for (int ai = 0; ai < 2; ++ai)
#pragma unroll
            for (int m = 0; m < 4; ++m) {
                if (dd[ai][m] >= 0) {
                    const float wv = ww[ai][m];
                    bf16_t* dp = YS + (long)dd[ai][m] * 1024 + q * 256 + wc * 32 + fq * 8;
#pragma unroll
                    for (int bj = 0; bj < 2; ++bj) {
                        const f32x4 v0 = acc[ai][bj][m][0], v1 = acc[ai][bj][m][1];
                        u32x4 w; w.x = cvt_pk_bf16(v0[0] * wv, v0[1] * wv); w.y = cvt_pk_bf16(v0[2] * wv, v0[3] * wv); w.z = cvt_pk_bf16(v1[0] * wv, v1[1] * wv); w.w = cvt_pk_bf16(v1[2] * wv, v1[3] * wv);
                        *(u32x4*)(dp + bj * 128) = w;
                    }
                }
                __builtin_amdgcn_sched_barrier(0);
            }
    }
};

#define FAST_PHASES_2_TO_10 \
        if (IN(2)) { \
            if ((int)blockIdx.x < 32) { \
                pg8::Gemm g{p.KVC, p.CW1T + (size_t)l * 512 * 2048, 2048, 1024, 2048, nullptr}; \
                pg8::CmpOrder S{(int)blockIdx.x}; \
                EpiCmp1 E{p.CB1 + l * 512, p.CHID}; \
                pg8::gemm_phase<EpiCmp1, pg8::CmpOrder, false>(lds, g, S, E); \
                cmp_gemm2(p, l, blockIdx.x); \
                if (l == 0) cvt_fill<0>(p, lds, NCH0, FILL_P2C); \
            } else { \
                  \
                const int nw = (int)gridDim.x - 32; \
                if (__builtin_amdgcn_readfirstlane((int)threadIdx.x) >= 256) __builtin_amdgcn_s_setprio(1);     \
                for (int u = (int)blockIdx.x - 32; u < 1024; u += nw) attn_aw_unit(p, l, (u & 15) >> 1, u & 1, 63 - (u >> 4), lds); \
                __builtin_amdgcn_s_setprio(0); \
                if (l == 0 && (1024 - ((int)blockIdx.x - 32) + nw - 1) / nw < (1024 + nw - 1) / nw) cvt_fill<0>(p, lds, NCH0, FILL_P2A); \
            } \
            GRID_BAR(); \
        } \
        if (IN(3)) { \
            if (__builtin_amdgcn_readfirstlane((int)threadIdx.x) >= 256) __builtin_amdgcn_s_setprio(1); \
            for (int k = blockIdx.x; k < 1024; k += gridDim.x) { \
                const int bgk = k & 15, cg = (k >> 4) & 15, i4 = k >> 8; \
                const int c = (i4 == 0) ? 63 - cg : (i4 == 1) ? 32 + cg : (i4 == 2) ? 31 - cg : cg; \
                attn_cs_unit(p, bgk >> 1, bgk & 1, c, lds); \
            } \
            __builtin_amdgcn_s_setprio(0); \
            GRID_BAR(); \
        } \
        if (IN(4)) { \
            pg8::StaticOrder S; S.init(T_TOK, 1024, gridDim.x, blockIdx.x); \
            { pg8::Gemm g{p.HB, p.WinT + ((size_t)l * 4352 + 2072) * 1024, 1024, 1024, 1024, nullptr}; EpiGate E{p.rsA, p.MERGED}; \
              pg8::gemm_phase<EpiGate, pg8::StaticOrder, false>(lds, g, S, E); } \
            { pg8::Gemm g{p.HB, p.WinT + ((size_t)l * 4352 + 3096) * 1024, 1024, 1024, 1024, nullptr}; EpiGate E{p.rsA, p.TMP2}; \
              pg8::gemm_phase<EpiGate, pg8::StaticOrder, false>(lds, g, S, E); } \
            { pg8::Gemm g{p.OAB, p.WabT + (size_t)l * 1024 * 1024, 1024, 1024, 1024, nullptr}; EpiMerge2 E{p.MERGED, p.TMP2}; \
              pg8::gemm_phase<EpiMerge2, pg8::StaticOrder, false, true>(lds, g, S, E); } \
            GRID_BAR(); \
        } \
        if (IN(5)) { \
            pg8::StaticOrder S; S.init(T_TOK, 1024, gridDim.x, blockIdx.x); \
            pg8::Gemm g{p.MERGED, p.WoutT + (size_t)l * 1024 * 1024, 1024, 1024, 1024, nullptr}; \
            EpiOut E{p.HB, p.ssq16}; \
            pg8::gemm_phase<EpiOut, pg8::StaticOrder, false>(lds, g, S, E); \
            GRID_BAR(); \
        } \
        if (IN(6)) { router_phase(p, l, lds); GRID_BAR(); } \
        if (IN(7)) { if (l == 0) cvt_fill<0>(p, lds, NCH0, 100000); scatter_phase(p, lds); GRID_BAR(); } \
        if (IN(8)) { \
            moe_stage_units<0>(p, lds); \
            LAS int* ul_ = (LAS int*)(lds + LDS_META_OFF); \
            pg8::MoeOrder S{ul_}; \
            pg8::Gemm g{p.HB, l ? p.W13T1 : p.W13T, 1024, 1024, 1024, ul_ + 64}; \
            EpiMoe1 E{(LAS float*)(ul_ + 64 + 6 * 256), p.HMID}; \
            pg8::gemm_phase<EpiMoe1, pg8::MoeOrder, true>(lds, g, S, E); \
            if (l == 0 && ul_[0] < (p.ntiles[0] * 4 + (int)gridDim.x - 1) / (int)gridDim.x) cvt_fill<1>(p, lds, 0, FILL_P8); \
            GRID_BAR(); \
        } \
        if (IN(9)) { \
            moe_stage_units<1>(p, lds); \
            LAS int* ul_ = (LAS int*)(lds + LDS_META_OFF); \
            pg8::MoeOrder S{ul_}; \
            pg8::Gemm g{p.HMID, l ? p.W2T1 : p.W2T, 512, 512, 512, nullptr}; \
            EpiMoe2 E{ul_ + 64, (LAS float*)(ul_ + 64 + 6 * 256), p.YS}; \
            pg8::gemm_phase<EpiMoe2, pg8::MoeOrder, false>(lds, g, S, E); \
            if (l == 0 && ul_[0] < (p.ntiles[0] * 4 + (int)gridDim.x - 1) / (int)gridDim.x) cvt_fill<1>(p, lds, 0, FILL_P9); \
            GRID_BAR(); \
        } \
        if (IN(10)) { \
            if (l == 1) fin_phase<true, true>(p, nullptr, p.norm_final); \
            else { fin_phase<true, false>(p, nullptr, nullptr); cvt_fill<1>(p, lds, 0, 100000); } \
            GRID_BAR(); \
        }
__global__ void __launch_bounds__(NTHR, 2) mega(Params p) {
    extern __shared__ __attribute__((aligned(16))) unsigned char lds_raw[];
    LAS unsigned char* lds = (LAS unsigned char*)lds_raw;
    volatile LAS unsigned* misc = (volatile LAS unsigned*)(lds + LDS_MISC_OFF);
    if (threadIdx.x < 64) misc[threadIdx.x] = 0u;
    build_tables(p, lds);
    const bool multi = (p.ph_hi - p.ph_lo > 1) || (p.l_hi - p.l_lo > 1);
    XcdBarrier bar; bar.bar = p.bar; bar.x = 0; bar.st = misc;
    if (multi) bar = xcd_barrier_post(p.bar, misc);
#define GRID_BAR() do { if (multi) xcd_barrier(bar); } while (0)
#define IN(k) (p.ph_lo <= (k) && (k) < p.ph_hi)

    if (IN(0) && p.l_lo == 0) {
        cvt_phase<0, 8>(p, lds);
        cvt_static<0>(p, lds, NCH0);
        prep_small(p);
        fin_phase<false, false>(p, p.x, nullptr);
        GRID_BAR();
    }
    for (int l = p.l_lo; l < p.l_hi; ++l) {
        if (IN(1)) {
            if (l == 0) cb1_reduce(p);
            pg8::Gemm g{p.HB, p.WinT + (size_t)l * 4352 * 1024, 1024, 1024, 1024, nullptr};
            pg8::StaticOrder S; S.init(T_TOK, 2048, gridDim.x, blockIdx.x);
            EpiProj E{p.rsA, p.QA, p.KA, p.G24};
            pg8::gemm_phase<EpiProj, pg8::StaticOrder, false>(lds, g, S, E);
            gates24_phase(p, l, lds);
            GRID_BAR();
        }
        FAST_PHASES_2_TO_10
    }
#undef IN
#undef GRID_BAR
}

struct HostState { int grid; bool ok; };
static void setup_params(Params& p, void* const* d_in, void* d_out, void* d_ws, size_t ws_size, size_t& used) {
    p.x = (const float*)d_in[0]; p.rel_bias = (const float*)d_in[1]; p.norm_mix = (const float*)d_in[2]; p.w_in = (const float*)d_in[3];
    p.a_sinks = (const float*)d_in[4]; p.cmp_pos_k = (const float*)d_in[5]; p.cmp_w1_k = (const float*)d_in[6]; p.cmp_w2_k = (const float*)d_in[7];
    p.cmp_pos_v = (const float*)d_in[8]; p.cmp_w1_v = (const float*)d_in[9]; p.cmp_w2_v = (const float*)d_in[10];
    p.w_br_a = (const float*)d_in[11]; p.w_br_b = (const float*)d_in[12]; p.w_out = (const float*)d_in[13]; p.norm_ffn = (const float*)d_in[14];
    p.w_group = (const float*)d_in[15]; p.b_group = (const float*)d_in[16]; p.w_expert = (const float*)d_in[17]; p.b_expert = (const float*)d_in[18];
    p.w1 = (const float*)d_in[19]; p.w3 = (const float*)d_in[20]; p.w2 = (const float*)d_in[21]; p.norm_final = (const float*)d_in[22];
    p.out = (float*)d_out;
    char* ws = (char*)d_ws; size_t off = 0;
    auto alloc = [&](size_t bytes) { void* q = ws + off; off += (bytes + 4095) & ~(size_t)4095; return q; };
    p.bar = (unsigned*)alloc(XCD_BAR_WORDS * 4);
    p.counts = (int*)alloc(256); p.cursor = (int*)alloc(256); p.ntiles = (int*)alloc(256); p.tile_e = (int*)alloc(NTILE_MAX * 4 + 256); p.cnt_tile = (int*)alloc((size_t)(T_TOK / 128) * 32 * 4);
    p.rsA = (float*)alloc(T_TOK * 4); p.rsB = (float*)alloc(T_TOK * 4); p.ssq16 = (float*)alloc((size_t)T_TOK * 16 * 4);
    p.HB = (bf16_t*)alloc((size_t)(T_TOK + 256) * DM * 2);
    p.WinT = (bf16_t*)alloc((size_t)2 * 4352 * 1024 * 2);
    p.WabT = (bf16_t*)alloc((size_t)2 * 1024 * 1024 * 2); p.WoutT = (bf16_t*)alloc((size_t)2 * 1024 * 1024 * 2);
    p.CW1T = (bf16_t*)alloc((size_t)2 * 512 * 2048 * 2); p.CW2T = (bf16_t*)alloc((size_t)2 * 2 * 64 * 256 * 2); p.CB1 = (float*)alloc(1024 * 4); p.CBP = (float*)alloc((size_t)512 * 256 * 4);
    p.W13T = (bf16_t*)alloc((size_t)32 * 1024 * 1024 * 2); p.W2T = (bf16_t*)alloc((size_t)32 * 1024 * 512 * 2);
    p.W13T1 = (bf16_t*)d_out; p.W2T1 = p.W13T1 + (size_t)32 * 1024 * 1024;
    p.cvtcur = (int*)(p.bar + 3584);
    p.WRH = (bf16_t*)alloc((size_t)2 * 48 * 1024 * 2); p.WRL = (bf16_t*)alloc((size_t)2 * 48 * 1024 * 2);
    p.eid = (int*)alloc((size_t)T_TOK * 2 * 4); p.ew = (float*)alloc((size_t)T_TOK * 2 * 4);
    p.toks = (int*)alloc((size_t)PMAXF * 4); p.slotw = (float*)alloc((size_t)PMAXF * 4); p.slotdst = (int*)alloc((size_t)PMAXF * 4);
    const size_t region0 = off;
    p.QA = (bf16_t*)alloc((size_t)T_TOK * 512 * 2); p.QB = (bf16_t*)alloc((size_t)T_TOK * 512 * 2);
    {
        const size_t slot = (size_t)16 * SEQ * 64;
        p.KA = (bf16_t*)alloc(8 * slot * 2); p.KVC = p.KA + slot; p.KS = p.KA + 3 * slot; p.KW = p.KA + 4 * slot; p.VAT = p.KA + 5 * slot; p.VST = p.KA + 6 * slot; p.VWT = p.KA + 7 * slot;
    }
    p.G24 = (float*)alloc((size_t)T_TOK * 32 * 4);
    p.CHID = (bf16_t*)alloc((size_t)8192 * 256 * 2); p.KCMP = (bf16_t*)alloc((size_t)16 * 256 * 64 * 2); p.VCMPT = (bf16_t*)alloc((size_t)16 * 64 * 256 * 2);
    p.OAB = (bf16_t*)alloc((size_t)T_TOK * 1024 * 2); p.OW = (bf16_t*)alloc((size_t)T_TOK * 512 * 2);
    p.MERGED = (bf16_t*)alloc((size_t)T_TOK * 1024 * 2);
    const size_t region1 = off;
    p.TMP2 = p.QA;
    p.HMID = (bf16_t*)(ws + region0);
    size_t moe_end = region0 + (((size_t)PMAXF * 512 * 2 + 4095) & ~(size_t)4095);
    p.YS = (bf16_t*)(ws + moe_end); moe_end += (size_t)T_TOK * 2 * 1024 * 2;
    used = (moe_end > region1) ? moe_end : region1;
    (void)ws_size;
    auto task = [&](int i, const float* src, bf16_t* dst, const float* scale, int scstride, int ld, int K, int N, int mapmode, int nb, long ss, long ds, int dld = 0) {
        CvtTask& t = p.cvt[i]; t.dld = dld ? dld : K; t.src = src; t.dst = dst; t.scale = scale; t.scstride = scstride; t.ld = ld; t.K = K; t.N = N; t.mapmode = mapmode; t.nb = nb; t.sstride = ss; t.dstride = ds; };
    task(0, p.w_in, p.WinT, p.norm_mix, 1024, INC, 1024, INC, 0, 2, (long)1024 * INC, (long)4352 * 1024);
    task(1, p.w_br_a, p.WabT, nullptr, 0, 1024, 512, 1024, 0, 2, (long)512 * 1024, (long)1024 * 1024, 1024);
    task(2, p.w_br_b, p.WabT + 512, nullptr, 0, 1024, 512, 1024, 0, 2, (long)512 * 1024, (long)1024 * 1024, 1024);
    task(3, p.w_out, p.WoutT, nullptr, 0, 1024, 1024, 1024, 0, 2, (long)1024 * 1024, (long)1024 * 1024);
    task(4, p.cmp_w1_k, p.CW1T, nullptr, 0, 256, 2048, 256, 0, 2, (long)2048 * 256, (long)512 * 2048);
    task(5, p.cmp_w1_v, p.CW1T + (size_t)256 * 2048, nullptr, 0, 256, 2048, 256, 0, 2, (long)2048 * 256, (long)512 * 2048);
    task(6, p.cmp_w2_k, p.CW2T, nullptr, 0, 64, 256, 64, 0, 2, (long)256 * 64, (long)2 * 64 * 256);
    task(7, p.cmp_w2_v, p.CW2T + (size_t)64 * 256, nullptr, 0, 64, 256, 64, 0, 2, (long)256 * 64, (long)2 * 64 * 256);
}
static HostState& host_state() {
    static HostState hs{0, false};
    if (hs.grid == 0) {
        int dev = 0, cus = 0, per_cu = 0;
        hs.grid = -1;
        if (hipGetDevice(&dev) != hipSuccess) return hs;
        if (hipDeviceGetAttribute(&cus, hipDeviceAttributeMultiprocessorCount, dev) != hipSuccess) return hs;
        if (hipFuncSetAttribute((const void*)mega, hipFuncAttributeMaxDynamicSharedMemorySize, LDS_TOTAL) != hipSuccess) return hs;
        if (hipOccupancyMaxActiveBlocksPerMultiprocessor(&per_cu, (const void*)mega, NTHR, LDS_TOTAL) != hipSuccess || per_cu < 1) { (void)hipGetLastError(); return hs; }
        hs.grid = cus;
        hs.ok = true;
    }
    return hs;
}
static void launch_mega(const Params& base, int ph_lo, int ph_hi, int l_lo, int l_hi, hipStream_t stream) {
    Params p = base; p.ph_lo = ph_lo; p.ph_hi = ph_hi; p.l_lo = l_lo; p.l_hi = l_hi;
    hipLaunchKernelGGL(mega, dim3(host_state().grid), dim3(NTHR), LDS_TOTAL, stream, p);
}
extern "C" void kernel_launch(void* const* d_in, const int* in_sizes, int n_in, void* d_out, int out_size, void* d_ws, size_t ws_size,
                              hipStream_t stream) {
    HostState& hs = host_state();
    if (!hs.ok) return;
    Params P; memset(&P, 0, sizeof(P));
    size_t used = 0;
    setup_params(P, d_in, d_out, d_ws, ws_size, used);
    if (used > ws_size) return;
    (void)in_sizes; (void)n_in; (void)out_size;
    hipMemsetAsync(P.bar, 0, 16384, stream);
    launch_mega(P, 0, 11, 0, 2, stream);
}
```

```cpp
#include <string.h>
#include <hip/hip_runtime.h>
#include <stdint.h>

#define T_TOK 32768
#define SEQ 4096
#define DM 1024
#define INC 4120

__device__ const unsigned char kBucket[128] = {0, 1, 2, 3, 4, 5, 6, 7, 8, 9, 10, 11, 12, 13, 14, 15, 16, 16, 16, 17, 17, 18, 18, 18, 19, 19, 19, 20, 20, 20, 20, 21, 21, 21, 21, 22, 22, 22, 22, 22, 23, 23, 23, 23, 23, 23, 24, 24, 24, 24, 24, 24, 25, 25, 25, 25, 25, 25, 25, 26, 26, 26, 26, 26, 26, 26, 26, 27, 27, 27, 27, 27, 27, 27, 27, 27, 27, 28, 28, 28, 28, 28, 28, 28, 28, 28, 28, 29, 29, 29, 29, 29, 29, 29, 29, 29, 29, 29, 29, 30, 30, 30, 30, 30, 30, 30, 30, 30, 30, 30, 30, 30, 30, 31, 31, 31, 31, 31, 31, 31, 31, 31, 31, 31, 31, 31, 31, 31};

#define LAS __attribute__((address_space(3)))
typedef unsigned short bf16_t;
typedef short bf16x8 __attribute__((ext_vector_type(8)));
typedef float f32x4 __attribute__((ext_vector_type(4)));
typedef float f32x16 __attribute__((ext_vector_type(16)));
typedef unsigned u32x4 __attribute__((ext_vector_type(4)));
typedef unsigned u32x2 __attribute__((ext_vector_type(2)));


typedef unsigned u32x2s __attribute__((ext_vector_type(2)));
__device__ __forceinline__ float half_swap_max(float v) { const u32x2s r = __builtin_amdgcn_permlane32_swap(__float_as_uint(v), __float_as_uint(v), false, false); return fmaxf(__uint_as_float(r.x), __uint_as_float(r.y)); }
__device__ __forceinline__ float half_swap_sum(float v) { const u32x2s r = __builtin_amdgcn_permlane32_swap(__float_as_uint(v), __float_as_uint(v), false, false); return __uint_as_float(r.x) + __uint_as_float(r.y); }
__device__ __forceinline__ float half_other(float v, int hq) { const u32x2s r = __builtin_amdgcn_permlane32_swap(__float_as_uint(v), __float_as_uint(v), false, false); return __uint_as_float(hq ? r.x : r.y); }
template <int M> __device__ __forceinline__ float swz_xor(float v) { return __int_as_float(__builtin_amdgcn_ds_swizzle(__float_as_int(v), (M << 10) | 0x1f)); }
__device__ __forceinline__ float wave_sum_f(float v) {
    v += swz_xor<1>(v); v += swz_xor<2>(v); v += swz_xor<4>(v); v += swz_xor<8>(v); v += swz_xor<16>(v);
    return half_swap_sum(v);
}

#define NTHR 512
#define LDS_STAGE 131072
#define LDS_TAB_OFF 131072
#define LDS_MISC_OFF (131072 + 16384)
#define LDS_META_OFF (131072 + 16384 + 1024)
#define LDS_TOTAL (131072 + 16384 + 1024 + 12544)

#define QSCALE 0.18033688011112042f
#define LOG2E 1.4426950408889634f

__device__ __forceinline__ unsigned cvt_pk_bf16(float lo, float hi) { unsigned r; asm volatile("v_cvt_pk_bf16_f32 %0, %1, %2" : "=v"(r) : "v"(lo), "v"(hi)); return r; }
__device__ __forceinline__ float bf16_to_f(unsigned short b) { return __uint_as_float(((unsigned)b) << 16); }
__device__ __forceinline__ float bf16lo(unsigned w) { return __uint_as_float(w << 16); }
__device__ __forceinline__ float bf16hi(unsigned w) { return __uint_as_float(w & 0xffff0000u); }
__device__ __forceinline__ float fast_sigmoid(float x) { return __builtin_amdgcn_rcpf(1.0f + __builtin_amdgcn_exp2f(-1.4426950408889634f * x)); }

#define XB_TMO      128
#define XB_XCNT(j)  (256  + 64 * (j))
#define XB_XSUB(j)  (1280 + 64 * (j))
#define XB_XGEN(j)  (2304 + 64 * (j))
#define XB_TOP      3328
#define XB_TOPGEN   3392
#define XCD_BAR_WORDS 3456
#define XB_SPIN_CAP (1u << 18)

__device__ __forceinline__ unsigned xb_ld(unsigned* p)              { return __hip_atomic_load(p, __ATOMIC_RELAXED, __HIP_MEMORY_SCOPE_AGENT); }
__device__ __forceinline__ unsigned xb_add(unsigned* p, unsigned v) { return __hip_atomic_fetch_add(p, v, __ATOMIC_RELAXED, __HIP_MEMORY_SCOPE_AGENT); }
__device__ __forceinline__ unsigned xb_xcc_id() { return (unsigned)__builtin_amdgcn_s_getreg((3 << 11) | 20) & 0xFu; }
#define XB_SPIN(cond, bar) do { unsigned _sp = 0; while (cond) { __builtin_amdgcn_s_sleep(1); \
    if ((++_sp & 255u) == 0u) { if (xb_ld(&(bar)[XB_TMO])) break; if (_sp > XB_SPIN_CAP) { atomicAdd(&(bar)[XB_TMO], 1u); break; } } } } while (0)

struct XcdBarrier { unsigned* bar; unsigned x; volatile LAS unsigned* st; };

__device__ __forceinline__ XcdBarrier xcd_barrier_post(unsigned* bar, volatile LAS unsigned* st) {
    XcdBarrier b; b.bar = bar; b.x = xb_xcc_id(); b.st = st;
    if (threadIdx.x == 0) (void)xb_add(&bar[XB_XCNT(b.x)], 1u);
    return b;
}
__device__ __forceinline__ void xcd_barrier_complete(unsigned* bar, unsigned x, unsigned& nloc, unsigned& nx) {
    const unsigned G = gridDim.x * gridDim.y * gridDim.z;
    unsigned sum, cnt, mine, sp = 0u;
    for (;;) {
        sum = 0u; cnt = 0u; mine = 0u;
#pragma unroll
        for (unsigned j = 0; j < 16; ++j) { const unsigned c = xb_ld(&bar[XB_XCNT(j)]); sum += c; cnt += (c > 0u) ? 1u : 0u; mine = (j == x) ? c : mine; }
        if (sum == G) break;
        __builtin_amdgcn_s_sleep(1);
        if ((++sp & 255u) == 0u) { if (xb_ld(&bar[XB_TMO])) break; if (sp > XB_SPIN_CAP) { atomicAdd(&bar[XB_TMO], 1u); break; } }
    }
    nloc = mine > 0u ? mine : 1u; nx = cnt > 0u ? cnt : 1u;
}
__device__ __forceinline__ void xcd_barrier(const XcdBarrier& b) {
    asm volatile("s_waitcnt vmcnt(0)" ::: "memory");
    __syncthreads();
    if (threadIdx.x == 0) {
        unsigned* bar = b.bar;
        __builtin_amdgcn_s_waitcnt(0);
        unsigned nloc = b.st[0], nx = b.st[1];
        if (nloc == 0u) { xcd_barrier_complete(bar, b.x, nloc, nx); b.st[0] = nloc; b.st[1] = nx; }
        const unsigned old = xb_add(&bar[XB_XSUB(b.x)], 1u);
        const unsigned gen = old / nloc;
        if (old + 1u == (gen + 1u) * nloc) {
            __builtin_amdgcn_fence(__ATOMIC_RELEASE, "agent");
            asm volatile("s_waitcnt vmcnt(0)" ::: "memory");
            const unsigned og = xb_add(&bar[XB_TOP], 1u);
            const unsigned tg = og / nx;
            if (og + 1u == (tg + 1u) * nx) xb_add(&bar[XB_TOPGEN], 1u);
            else XB_SPIN(xb_ld(&bar[XB_TOPGEN]) == tg, bar);
            __builtin_amdgcn_fence(__ATOMIC_ACQUIRE, "agent");
            xb_add(&bar[XB_XGEN(b.x)], 1u);
            asm volatile("s_waitcnt vmcnt(0)" ::: "memory");
        } else {
            XB_SPIN(xb_ld(&bar[XB_XGEN(b.x)]) == gen, bar);
            __builtin_amdgcn_fence(__ATOMIC_ACQUIRE, "agent");
            asm volatile("s_waitcnt vmcnt(0)" ::: "memory");
        }
    }
    __syncthreads();
}

struct CvtTask {
    const float* src; bf16_t* dst; const float* scale;
    int ld, K, N, mapmode;
    int dld;
    int nb; int scstride;
    long sstride, dstride;
};
#define NCVT 16
struct Params {
    const float* x; const float* rel_bias; const float* norm_mix; const float* w_in; const float* a_sinks;
    const float* cmp_pos_k; const float* cmp_w1_k; const float* cmp_w2_k; const float* cmp_pos_v; const float* cmp_w1_v; const float* cmp_w2_v;
    const float* w_br_a; const float* w_br_b; const float* w_out; const float* norm_ffn; const float* w_group; const float* b_group;
    const float* w_expert; const float* b_expert; const float* w1; const float* w3; const float* w2; const float* norm_final;
    float* out;
    unsigned* bar;
    int* counts; int* cursor; int* ntiles; int* tile_e; int* cnt_tile;
    float* rsA; float* rsB; float* ssq16;
    bf16_t* HB;
    bf16_t* WinT;
    bf16_t* WabT; bf16_t* WoutT;
    bf16_t* CW1T; bf16_t* CW2T; float* CB1; float* CBP;
    bf16_t* W13T; bf16_t* W2T;
    bf16_t* W13T1; bf16_t* W2T1;
    int* cvtcur;
    bf16_t* WRH; bf16_t* WRL;
    bf16_t* QA; bf16_t* QB;
    bf16_t* KA; bf16_t* KVC; bf16_t* KS; bf16_t* KW;
    bf16_t* VAT; bf16_t* VST; bf16_t* VWT;
    float* G24;
    bf16_t* CHID; bf16_t* KCMP; bf16_t* VCMPT;
    bf16_t* OAB; bf16_t* OW;
    bf16_t* MERGED; bf16_t* TMP2;
    int* eid; float* ew; int* toks; float* slotw; int* slotdst;
    bf16_t* HMID; bf16_t* YS;
    CvtTask cvt[NCVT];
    int ph_lo, ph_hi, l_lo, l_hi;
};
#define PMAXF (65536 + 32 * 256)
#define NTILE_MAX (PMAXF / 256)

__device__ __forceinline__ int cvt_units(const CvtTask& t) { return t.nb * (t.K / 128) * ((t.N + 63) / 64); }
struct CvtRegs { float4 v[2][4]; };
__device__ __forceinline__ void cvt_decode(const CvtTask& t, int u, int& e, int& kt, int& nt) {
    int nkt = t.K / 128, nnt = (t.N + 63) / 64;
    asm volatile("" : "+s"(nkt), "+s"(nnt));
    e = u / (nkt * nnt); const int r = u % (nkt * nnt); kt = r / nnt; nt = r % nnt;
}
__device__ __forceinline__ void cvt_load2(const CvtTask& t, int tid, int ub, int G, int nu, CvtRegs& R) {
#pragma unroll
    for (int q = 0; q < 2; ++q) {
        const int uu = ub + q * G;
#pragma unroll
        for (int i = 0; i < 4; ++i) R.v[q][i] = make_float4(0.f, 0.f, 0.f, 0.f);
        if (uu < nu) {
            int e, kt, nt; cvt_decode(t, uu, e, kt, nt);
            const float* src = t.src + (long)e * t.sstride;
#pragma unroll
            for (int i = 0; i < 4; ++i) {
                const int k = (tid >> 4) + 32 * i, n4 = (tid & 15) * 4;
                const int gk = kt * 128 + k, gn = nt * 64 + n4;
                if (gn < t.N) {
                    float4 v = *(const float4*)(src + (long)gk * t.ld + gn);
                    if (t.scale) { const float s = t.scale[(long)e * t.scstride + gk]; v.x *= s; v.y *= s; v.z *= s; v.w *= s; }
                    R.v[q][i] = v;
                }
            }
        }
    }
}
__device__ __forceinline__ void cvt_store2(const CvtTask& t, int tid, int ub, int G, int nu, const CvtRegs& R, LAS float* tiles  ) {
    __syncthreads();
#pragma unroll
    for (int q = 0; q < 2; ++q)
#pragma unroll
        for (int i = 0; i < 4; ++i) {
            const int k = (tid >> 4) + 32 * i, n4 = (tid & 15) * 4;
            LAS float* tl = tiles + q * (128 * 65) + k * 65 + n4;
            tl[0] = R.v[q][i].x; tl[1] = R.v[q][i].y; tl[2] = R.v[q][i].z; tl[3] = R.v[q][i].w;
        }
    __syncthreads();
    const int n = tid >> 3, ks = (tid & 7) * 16;
#pragma unroll
    for (int q = 0; q < 2; ++q) {
        const int uu = ub + q * G;
        if (uu < nu) {
            int e, kt, nt; cvt_decode(t, uu, e, kt, nt);
            bf16_t* dst = t.dst + (long)e * t.dstride;
            const int gn = nt * 64 + n;
            if (gn < t.N) {
                int drow = gn;
                if (t.mapmode == 1) drow = (gn >> 7) * 256 + (gn & 127);
                else if (t.mapmode == 2) drow = (gn >> 7) * 256 + 128 + (gn & 127);
                const LAS float* tl = tiles + q * (128 * 65) + ks * 65 + n;
                u32x4 w0, w1;
                w0.x = cvt_pk_bf16(tl[0 * 65], tl[1 * 65]); w0.y = cvt_pk_bf16(tl[2 * 65], tl[3 * 65]);
                w0.z = cvt_pk_bf16(tl[4 * 65], tl[5 * 65]); w0.w = cvt_pk_bf16(tl[6 * 65], tl[7 * 65]);
                w1.x = cvt_pk_bf16(tl[8 * 65], tl[9 * 65]); w1.y = cvt_pk_bf16(tl[10 * 65], tl[11 * 65]);
                w1.z = cvt_pk_bf16(tl[12 * 65], tl[13 * 65]); w1.w = cvt_pk_bf16(tl[14 * 65], tl[15 * 65]);
                bf16_t* dp = dst + (long)drow * t.dld + kt * 128 + ks;
                *(u32x4*)dp = w0; *(u32x4*)(dp + 8) = w1;
            }
        }
    }
}
template <int t0, int t1>
__device__ __forceinline__ void cvt_phase(const Params& p, LAS unsigned char* lds) {
    LAS float* tiles = (LAS float*)lds;
    int tid = threadIdx.x; asm volatile("" : "+v"(tid));
    const int G = gridDim.x;
    int base = 0;
#pragma unroll
    for (int ti = t0; ti < t1; ++ti) {
        const CvtTask& t = p.cvt[ti];
        const int nu = cvt_units(t);
        int first = (int)blockIdx.x - (base % G); if (first < 0) first += G;
        CvtRegs A, B;
        if (first < nu) cvt_load2(t, tid, first, G, nu, A);
        for (int ub = first; ub < nu; ub += 2 * G) {
            const int un = ub + 2 * G;
            if (un < nu) cvt_load2(t, tid, un, G, nu, B);
            cvt_store2(t, tid, ub, G, nu, A, tiles);
            A = B;
        }
        base += nu;
    }
    __syncthreads();
}
#define JOB_CHUNKS 768
#define FILL_P1 0
#define FILL_P2C 0
#define FILL_P2A 0
#define FILL_P8 0
#define FILL_P9 0
#define NCH0 (JOB_CHUNKS - (128 * FILL_P1 + 32 * FILL_P2C + 96 * FILL_P2A))
template <int JOB>
__device__ __forceinline__ void cvt_job_chunk(const Params& p, int c, LAS float* tiles, int tid) {
    const int which = c >> 8, u0 = (c & 255) * 8;
    CvtTask t;
    const long eo = (long)JOB * 32 * 1024 * 512;
    const float* src = p.w1; if (which == 1) src = p.w3; if (which == 2) src = p.w2;
    t.src = src + eo;
    t.dst = (which == 2) ? (JOB ? p.W2T1 : p.W2T) : (JOB ? p.W13T1 : p.W13T);
    t.scale = (which == 2) ? nullptr : p.norm_ffn + JOB * 1024; t.scstride = 0;
    t.ld = (which == 2) ? 1024 : 512; t.K = (which == 2) ? 512 : 1024; t.N = (which == 2) ? 1024 : 512;
    t.dld = t.K; t.mapmode = (which == 2) ? 0 : 1 + which; t.nb = 32; t.sstride = (long)1024 * 512; t.dstride = (which == 2) ? (long)1024 * 512 : (long)1024 * 1024;
    CvtRegs A, B;
    cvt_load2(t, tid, u0, 1, 2048, A);
#pragma unroll 1
    for (int s2 = 0; s2 < 4; ++s2) {
        if (s2 < 3) cvt_load2(t, tid, u0 + 2 * (s2 + 1), 1, 2048, B);
        cvt_store2(t, tid, u0 + 2 * s2, 1, 2048, A, tiles);
        A = B;
    }
}
template <int JOB>
__device__ __forceinline__ void cvt_fill(const Params& p, LAS unsigned char* lds, int base, int max_chunks) {
    int tid = threadIdx.x; asm volatile("" : "+v"(tid));
    volatile LAS unsigned* slot = (volatile LAS unsigned*)(lds + LDS_MISC_OFF) + 32;
#pragma unroll 1
    for (int n = 0; n < max_chunks; ++n) {
        __syncthreads();
        if (tid == 0) *slot = (unsigned)__hip_atomic_fetch_add(p.cvtcur + JOB, 1, __ATOMIC_RELAXED, __HIP_MEMORY_SCOPE_AGENT);
        __syncthreads();
        const int c = base + __builtin_amdgcn_readfirstlane((int)*slot);
        if (c >= JOB_CHUNKS) break;
        cvt_job_chunk<JOB>(p, c, (LAS float*)lds, tid);
    }
    __syncthreads();
}
template <int JOB>
__device__ __forceinline__ void cvt_static(const Params& p, LAS unsigned char* lds, int n) {
    int tid = threadIdx.x; asm volatile("" : "+v"(tid));
#pragma unroll 1
    for (int c = blockIdx.x; c < n; c += gridDim.x) cvt_job_chunk<JOB>(p, c, (LAS float*)lds, tid);
    __syncthreads();
}
__device__ __forceinline__ void prep_small(const Params& p) {
    const int gtid = blockIdx.x * NTHR + threadIdx.x, gn = gridDim.x * NTHR;
    for (int i = gtid; i < 2 * 48 * 1024; i += gn) {
        const int l = i / (48 * 1024), r = i % (48 * 1024), n = r >> 10, k = r & 1023;
        float w = 0.f;
        if (n < 36) {
            const float g = p.norm_ffn[l * 1024 + k];
            w = g * ((n < 4) ? p.w_group[((long)l * 1024 + k) * 4 + n] : p.w_expert[((long)l * 1024 + k) * 32 + (n - 4)]);
        }
        const __bf16 hi = (__bf16)w; const __bf16 lo = (__bf16)(w - (float)hi);
        p.WRH[i] = __builtin_bit_cast(unsigned short, hi); p.WRL[i] = __builtin_bit_cast(unsigned short, lo);
    }
    for (int w = blockIdx.x; w < 256; w += gridDim.x) {
        const int cmb = w >> 6, sl = w & 63, l = cmb >> 1, kv = cmb & 1, n = threadIdx.x & 255, kh = threadIdx.x >> 8;
        const float* pos = (kv ? p.cmp_pos_v : p.cmp_pos_k) + (long)l * 2048 + sl * 32 + kh * 16;
        const float* wt = (kv ? p.cmp_w1_v : p.cmp_w1_k) + ((long)l * 2048 + sl * 32 + kh * 16) * 256 + n;
        float sacc = 0.f;
#pragma unroll
        for (int i = 0; i < 16; ++i) sacc = fmaf(pos[i], wt[(long)i * 256], sacc);
        p.CBP[((long)w * 2 + kh) * 256 + n] = sacc;
    }
    for (int i = gtid; i < 256 * 1024 / 8; i += gn) ((u32x4*)(p.HB + (long)T_TOK * DM))[i] = (u32x4){0u, 0u, 0u, 0u};
}

__device__ __forceinline__ void cb1_reduce(const Params& p) {
    const int wave = threadIdx.x >> 6, lane = threadIdx.x & 63;
    if (wave < 4) {
        for (int o = blockIdx.x * 4 + wave; o < 1024; o += gridDim.x * 4) {
            const int cmb = o >> 8, n = o & 255;
            const float* pp = p.CBP + ((long)cmb * 128) * 256 + n;
            float v = pp[(long)lane * 256] + pp[(long)(lane + 64) * 256];
            v = wave_sum_f(v);
            if (lane == 0) p.CB1[o] = v;
        }
    }
}
template <bool ADD_YS, bool LAST>
__device__ __forceinline__ void fin_phase(const Params& p, const float* hin, const float* gfinal) {
    int tid = threadIdx.x; asm volatile("" : "+v"(tid));
    const int wave = tid >> 6, lane = tid & 63;
    for (int row0 = (blockIdx.x * 8 + wave) * 2; row0 < T_TOK; row0 += gridDim.x * 16) {
        float v[2][2][8]; u32x4 ya[2][2], yb[2][2], hb[2][2];
#pragma unroll
        for (int q = 0; q < 2; ++q)
#pragma unroll
            for (int i = 0; i < 2; ++i) {
                if (ADD_YS) {
                    hb[q][i] = *(const u32x4*)(p.HB + (long)(row0 + q) * DM + i * 512 + lane * 8);
                    ya[q][i] = *(const u32x4*)(p.YS + ((long)(row0 + q) * 2) * DM + i * 512 + lane * 8);
                    yb[q][i] = *(const u32x4*)(p.YS + ((long)(row0 + q) * 2 + 1) * DM + i * 512 + lane * 8);
                } else {
                    const float4 a = *(const float4*)(hin + (long)(row0 + q) * DM + i * 512 + lane * 8), c = *(const float4*)(hin + (long)(row0 + q) * DM + i * 512 + lane * 8 + 4);
                    v[q][i][0] = a.x; v[q][i][1] = a.y; v[q][i][2] = a.z; v[q][i][3] = a.w; v[q][i][4] = c.x; v[q][i][5] = c.y; v[q][i][6] = c.z; v[q][i][7] = c.w;
                }
            }
#pragma unroll
        for (int q = 0; q < 2; ++q) {
            const int row = row0 + q;
            if (ADD_YS) {
#pragma unroll
                for (int i = 0; i < 2; ++i) {
                    const unsigned hw[4] = {hb[q][i].x, hb[q][i].y, hb[q][i].z, hb[q][i].w}, aw[4] = {ya[q][i].x, ya[q][i].y, ya[q][i].z, ya[q][i].w}, bw[4] = {yb[q][i].x, yb[q][i].y, yb[q][i].z, yb[q][i].w};
#pragma unroll
                    for (int j = 0; j < 4; ++j) {
                        v[q][i][2 * j] = bf16lo(hw[j]) + (bf16lo(aw[j]) + bf16lo(bw[j]));
                        v[q][i][2 * j + 1] = bf16hi(hw[j]) + (bf16hi(aw[j]) + bf16hi(bw[j]));
                    }
                }
            }
            float s = 0.f;
#pragma unroll
            for (int i = 0; i < 2; ++i)
#pragma unroll
                for (int j = 0; j < 8; ++j) s += v[q][i][j] * v[q][i][j];
            s = wave_sum_f(s);
            const float r = rsqrtf(s * (1.0f / DM) + 1e-5f);
            if (LAST) {
#pragma unroll
                for (int i = 0; i < 2; ++i) {
                    const float4 g0 = *(const float4*)(gfinal + i * 512 + lane * 8), g1 = *(const float4*)(gfinal + i * 512 + lane * 8 + 4);
                    float4 o0, o1;
                    o0.x = v[q][i][0] * r * g0.x; o0.y = v[q][i][1] * r * g0.y; o0.z = v[q][i][2] * r * g0.z; o0.w = v[q][i][3] * r * g0.w;
                    o1.x = v[q][i][4] * r * g1.x; o1.y = v[q][i][5] * r * g1.y; o1.z = v[q][i][6] * r * g1.z; o1.w = v[q][i][7] * r * g1.w;
                    *(float4*)(p.out + (long)row * DM + i * 512 + lane * 8) = o0; *(float4*)(p.out + (long)row * DM + i * 512 + lane * 8 + 4) = o1;
                }
            } else {
#pragma unroll
                for (int i = 0; i < 2; ++i) {
                    u32x4 w; w.x = cvt_pk_bf16(v[q][i][0], v[q][i][1]); w.y = cvt_pk_bf16(v[q][i][2], v[q][i][3]); w.z = cvt_pk_bf16(v[q][i][4], v[q][i][5]); w.w = cvt_pk_bf16(v[q][i][6], v[q][i][7]);
                    *(u32x4*)(p.HB + (long)row * DM + i * 512 + lane * 8) = w;
                }
                if (lane == 0) p.rsA[row] = r;
            }
        }
    }
}

namespace pg8 {
constexpr int BM = 256, BK = 64, HALF = 128, HTB = HALF * BK * 2, STAGE_BYTES = 8 * HTB, NXCD = 8, WGM = 8;
__host__ __device__ __forceinline__ int lds_byte(int r, int c) { const int st = (r >> 4) * 2 + (c >> 5), rr = r & 15, cc = c & 31, ob = rr * 64 + cc * 2; return st * 1024 + (ob ^ (((ob >> 9) & 1) << 5)); }
__host__ __device__ __forceinline__ void stage_rc(int b, int& R, int& C) { const int st = b / 1024, sb = b % 1024, swz = sb ^ (((sb >> 9) & 1) << 5); R = (st >> 1) * 16 + swz / 64; C = (st & 1) * 32 + (swz % 64) / 2; }
__host__ __device__ __forceinline__ int perm32(int rho) { const int n = rho >> 4, i = rho & 15; return 8 * (i >> 2) + 4 * n + (i & 3); }

struct Unit { int pm, pn, li; };
struct Gemm { const bf16_t* A; const bf16_t* Bt; int K, lda, ldb; const LAS int* gather; };

struct StaticOrder {
    int nM, nN, nwg, G, c;
    __device__ void init(int M, int N, int G_, int c_) { nM = M / BM; nN = N / BM; nwg = nM * nN; G = G_; c = c_; }
    __device__ bool next(int i, Unit& u) const {
        const long L = (long)i * G + c; if (L >= nwg) return false;
        int wgid = (int)L; { const int q = nwg / NXCD, r = nwg % NXCD, xcd = wgid % NXCD, off = wgid / NXCD; wgid = (xcd < r ? xcd * (q + 1) : r * (q + 1) + (xcd - r) * q) + off; }
        const int nig = WGM * nN, gid = wgid / nig, fm = gid * WGM, gsz = (nM - fm) < WGM ? (nM - fm) : WGM;
        u.pm = fm + ((wgid % nig) % gsz); u.pn = (wgid % nig) / gsz; u.li = 0; return true;
    }
};
struct CmpOrder {
    int c;
    __device__ bool next(int i, Unit& u) const { if (i > 0 || c >= 32) return false; u.pm = c; u.pn = c >> 4; u.li = 0; return true; }
};
struct MoeOrder {
    const LAS int* ul;
    __device__ bool next(int i, Unit& u) const {
        if (i >= ul[0]) return false;
        u.pm = ul[2 + 2 * i]; u.pn = ul[3 + 2 * i]; u.li = i; return true;
    }
};

template <class Epi, class Sched, bool GATHER, bool MID = false>
__device__ __forceinline__ void gemm_phase(LAS unsigned char* lds, const Gemm g, const Sched& S, const Epi& E) {
    int tid = threadIdx.x;
    asm volatile("" : "+v"(tid));
    const int wid = __builtin_amdgcn_readfirstlane(tid >> 6), lane = tid & 63, wr = wid >> 2, wc = wid & 3, fr = lane & 15, fq = lane >> 4;
    const int K = g.K, nt = K / BK;
    unsigned voffA[2], voffB[2];
#pragma unroll
    for (int i = 0; i < 2; ++i) { int R, C; stage_rc(tid * 16 + i * 8192, R, C); const int Rb = Epi::PERM ? ((R & ~31) + perm32(R & 31)) : R;
        voffA[i] = (unsigned)(R * g.lda + C) * 2u; voffB[i] = (unsigned)(Rb * g.ldb + C) * 2u; }
    const size_t kstep = (size_t)(BK * 2);
    const size_t hstepA = (size_t)HALF * g.lda * 2, tstepA = 2 * hstepA;
    const size_t hstepB = (size_t)HALF * g.ldb * 2, tstepB = 2 * hstepB;
    const unsigned ldsw = (unsigned)wid * 1024u;
    const int aoff = lds_byte(wr * 64 + fr, fq * 8), boff = lds_byte(wc * 32 + fr, fq * 8);
#define PG8_SA(b, h) (((b) * 2 + (h)) * HTB)
#define PG8_SB(b, h) ((4 + (b) * 2 + (h)) * HTB)
#define PG8_STAGE(bufoff, gbase, voff) do { _Pragma("unroll") for (int _i = 0; _i < 2; ++_i) \
        __builtin_amdgcn_global_load_lds((const unsigned*)((const char*)(gbase) + (voff)[_i]), (LAS unsigned*)(lds + (bufoff) + ldsw + _i * 8192), 16, 0, 0); } while (0)
#define PG8_STAGEG(bufoff, kb, o0, o1) do { \
        __builtin_amdgcn_global_load_lds((const unsigned*)((const char*)g.A + (kb) + (o0)), (LAS unsigned*)(lds + (bufoff) + ldsw), 16, 0, 0); \
        __builtin_amdgcn_global_load_lds((const unsigned*)((const char*)g.A + (kb) + (o1)), (LAS unsigned*)(lds + (bufoff) + ldsw + 8192), 16, 0, 0); } while (0)
#define PG8_STAGEA_CUR(bufoff, kb, h) do { if constexpr (GATHER) { PG8_STAGEG(bufoff, kb, oc[h][0], oc[h][1]); } else { PG8_STAGE(bufoff, cA + (kb) + (h) * hstepA, voffA); } } while (0)
#define PG8_STAGEA_SEL(bufoff, kb, h) do { if constexpr (GATHER) { PG8_STAGEG(bufoff, kb, (last ? on[h][0] : oc[h][0]), (last ? on[h][1] : oc[h][1])); } else { PG8_STAGE(bufoff, a2b + (kb) + (h) * hstepA, voffA); } } while (0)
#define PG8_LDA(dst, b, h) do { _Pragma("unroll") for (int m = 0; m < 4; ++m) _Pragma("unroll") for (int k = 0; k < 2; ++k) dst[m][k] = *(const LAS bf16x8*)(lds + PG8_SA(b, h) + aoff + m * 2048 + k * 1024); } while (0)
#define PG8_LDB(dst, b, h) do { _Pragma("unroll") for (int n = 0; n < 2; ++n) _Pragma("unroll") for (int k = 0; k < 2; ++k) dst[n][k] = *(const LAS bf16x8*)(lds + PG8_SB(b, h) + boff + n * 2048 + k * 1024); } while (0)
#define PG8_MMA(ai, bj, At, Bt) do { __builtin_amdgcn_s_setprio(1); _Pragma("unroll") for (int m = 0; m < 4; ++m) _Pragma("unroll") for (int n = 0; n < 2; ++n) _Pragma("unroll") for (int k = 0; k < 2; ++k) \
        acc[ai][bj][m][n] = __builtin_amdgcn_mfma_f32_16x16x32_bf16(Bt[n][k], At[m][k], acc[ai][bj][m][n], 0, 0, 0); __builtin_amdgcn_s_setprio(0); } while (0)
#define PG8_WAIT_V(n) asm volatile("s_waitcnt vmcnt(" #n ")" ::: "memory")
#define PG8_WAIT_L(n) asm volatile("s_waitcnt lgkmcnt(" #n ")" ::: "memory")
#define PG8_BAR __builtin_amdgcn_s_barrier()
#define PG8_SCHED __builtin_amdgcn_sched_barrier(0)
#define PG8_AOFF(dst, U) do { _Pragma("unroll") for (int _h = 0; _h < 2; ++_h) _Pragma("unroll") for (int _i = 0; _i < 2; ++_i) { \
        int _R, _C; stage_rc(tid * 16 + _i * 8192, _R, _C); const int _gr = g.gather[(U).li * BM + _h * HALF + _R]; \
        dst[_h][_i] = (unsigned)((_gr * g.lda + _C) * 2); } } while (0)
    Unit cur, nxt; int ui = 0;
    if (!S.next(0, cur)) return;
    f32x4 acc[2][2][4][2];
#pragma unroll
    for (int a = 0; a < 2; ++a)
#pragma unroll
        for (int b = 0; b < 2; ++b)
#pragma unroll
            for (int m = 0; m < 4; ++m)
#pragma unroll
                for (int n = 0; n < 2; ++n) acc[a][b][m][n] = (f32x4){0.f, 0.f, 0.f, 0.f};
    bf16x8 At[4][2], B0[2][2], B1[2][2];
    unsigned oc[2][2] = {{0u, 0u}, {0u, 0u}}, on[2][2] = {{0u, 0u}, {0u, 0u}};
    if constexpr (GATHER) { PG8_AOFF(oc, cur); }
    const char* cA = (const char*)g.A + (GATHER ? (size_t)0 : (size_t)cur.pm * tstepA);
    const char* cB = (const char*)g.Bt + (size_t)cur.pn * tstepB;
    PG8_STAGE(PG8_SB(0, 0), cB, voffB); PG8_STAGEA_CUR(PG8_SA(0, 0), 0, 0); PG8_STAGE(PG8_SB(0, 1), cB + hstepB, voffB); PG8_STAGEA_CUR(PG8_SA(0, 1), 0, 1);
    if (wr == 1) PG8_BAR;
    PG8_WAIT_V(4); PG8_BAR;
    PG8_STAGE(PG8_SB(1, 0), cB + kstep, voffB); PG8_STAGEA_CUR(PG8_SA(1, 0), kstep, 0); PG8_STAGE(PG8_SB(1, 1), cB + hstepB + kstep, voffB);
    PG8_WAIT_V(6); PG8_BAR;
    for (;;) {
        const bool has_next = S.next(ui + 1, nxt);
        if constexpr (GATHER) { if (has_next) { PG8_AOFF(on, nxt); } else { on[0][0] = oc[0][0]; on[0][1] = oc[0][1]; on[1][0] = oc[1][0]; on[1][1] = oc[1][1]; } }
        const char* nA = (has_next && !GATHER) ? (const char*)g.A + (size_t)nxt.pm * tstepA : cA;
        const char* nB = has_next ? (const char*)g.Bt + (size_t)nxt.pn * tstepB : cB;
        for (int t = 0; t < nt; t += 2) {
            if constexpr (MID) { if (t == nt / 2) E.mid(acc, cur, wr, wc, fr, fq); }
            const bool last = (t == nt - 2);
            const size_t k1 = (size_t)(t + 1) * kstep;
            const size_t k2 = last ? 0 : (size_t)(t + 2) * kstep, k3 = k2 + kstep;
            const char* a2b = last ? nA : cA;
            const char* b2 = last ? nB : cB + (size_t)(t + 2) * kstep; const char* b3 = b2 + kstep;
            PG8_LDB(B0, 0, 0); PG8_SCHED; PG8_LDA(At, 0, 0); PG8_STAGEA_CUR(PG8_SA(1, 1), k1, 1);
            PG8_WAIT_L(8); PG8_BAR; PG8_WAIT_L(0); PG8_MMA(0, 0, At, B0); PG8_BAR; PG8_SCHED;
            PG8_LDB(B1, 0, 1); PG8_STAGE(PG8_SB(0, 0), b2, voffB);
            PG8_BAR; PG8_WAIT_L(0); PG8_MMA(0, 1, At, B1); PG8_BAR;
            PG8_LDA(At, 0, 1); PG8_STAGEA_SEL(PG8_SA(0, 0), k2, 0);
            PG8_BAR; PG8_WAIT_L(0); PG8_MMA(1, 0, At, B0); PG8_BAR; PG8_SCHED;
            PG8_STAGE(PG8_SB(0, 1), b2 + hstepB, voffB);
            PG8_WAIT_V(6); PG8_BAR; PG8_MMA(1, 1, At, B1); PG8_BAR;
            PG8_LDB(B0, 1, 0); PG8_SCHED; PG8_LDA(At, 1, 0); PG8_STAGEA_SEL(PG8_SA(0, 1), k2, 1);
            PG8_WAIT_L(8); PG8_BAR; PG8_WAIT_L(0); PG8_MMA(0, 0, At, B0); PG8_BAR; PG8_SCHED;
            PG8_LDB(B1, 1, 1); PG8_STAGE(PG8_SB(1, 0), b3, voffB);
            PG8_BAR; PG8_WAIT_L(0); PG8_MMA(0, 1, At, B1); PG8_BAR;
            PG8_LDA(At, 1, 1); PG8_STAGEA_SEL(PG8_SA(1, 0), k3, 0);
            PG8_BAR; PG8_WAIT_L(0); PG8_MMA(1, 0, At, B0); PG8_BAR; PG8_SCHED;
            PG8_STAGE(PG8_SB(1, 1), b3 + hstepB, voffB);
            PG8_WAIT_V(6); PG8_BAR; PG8_MMA(1, 1, At, B1); PG8_BAR;
        }
        E(acc, cur, wr, wc, fr, fq);
        if (!has_next) break;
#pragma unroll
        for (int a = 0; a < 2; ++a)
#pragma unroll
            for (int b = 0; b < 2; ++b)
#pragma unroll
                for (int m = 0; m < 4; ++m)
#pragma unroll
                    for (int n = 0; n < 2; ++n) acc[a][b][m][n] = (f32x4){0.f, 0.f, 0.f, 0.f};
        cur = nxt; cA = nA; cB = nB; ++ui;
        if constexpr (GATHER) { oc[0][0] = on[0][0]; oc[0][1] = on[0][1]; oc[1][0] = on[1][0]; oc[1][1] = on[1][1]; }
    }
    PG8_WAIT_V(0);
    if (wr == 0) PG8_BAR;
    PG8_BAR;
#undef PG8_SA
#undef PG8_SB
#undef PG8_STAGE
#undef PG8_STAGEG
#undef PG8_STAGEA_CUR
#undef PG8_STAGEA_SEL
#undef PG8_LDA
#undef PG8_LDB
#undef PG8_MMA
#undef PG8_WAIT_V
#undef PG8_WAIT_L
#undef PG8_BAR
#undef PG8_SCHED
#undef PG8_AOFF
}
}

typedef f32x4 AccT[2][2][4][2];

struct EpiProj {
    static constexpr bool PERM = true;
    const float* rs; bf16_t* QA; bf16_t* KA; float* G24;
    __device__ __forceinline__ void operator()(const AccT& acc, const pg8::Unit& u, int wr, int wc, int fr, int fq) const {
        const int row0 = u.pm * 256 + wr * 64 + fr;
        const int pn = u.pn;
        float rr[2][4];
#pragma unroll
        for (int ai = 0; ai < 2; ++ai)
#pragma unroll
            for (int m = 0; m < 4; ++m) rr[ai][m] = rs[row0 + ai * 128 + m * 16];
        if (pn == 0 || pn == 1 || pn == 3 || pn == 4) {
            bf16_t* Q = QA + (long)((pn >= 3) ? 1 : 0) * T_TOK * 512 + ((pn == 1 || pn == 4) ? 256 : 0) + wc * 32 + fq * 8;
#pragma unroll
            for (int ai = 0; ai < 2; ++ai)
#pragma unroll
                for (int m = 0; m < 4; ++m) {
                    const int row = row0 + ai * 128 + m * 16;
                    const float sc = rr[ai][m] * QSCALE;
#pragma unroll
                    for (int bj = 0; bj < 2; ++bj) {
                        const f32x4 v0 = acc[ai][bj][m][0], v1 = acc[ai][bj][m][1];
                        u32x4 w; w.x = cvt_pk_bf16(v0[0] * sc, v0[1] * sc); w.y = cvt_pk_bf16(v0[2] * sc, v0[3] * sc); w.z = cvt_pk_bf16(v1[0] * sc, v1[1] * sc); w.w = cvt_pk_bf16(v1[2] * sc, v1[3] * sc);
                        *(u32x4*)(Q + (long)row * 512 + bj * 128) = w;
                    }
                    __builtin_amdgcn_sched_barrier(0);
                }
        } else if (pn == 8) {
            if (wc == 0 && fq < 3) {
#pragma unroll
                for (int ai = 0; ai < 2; ++ai)
#pragma unroll
                    for (int m = 0; m < 4; ++m) {
                        const int row = row0 + ai * 128 + m * 16;
                        const float r = rr[ai][m];
                        const f32x4 v0 = acc[ai][0][m][0], v1 = acc[ai][0][m][1];
                        float* gp = G24 + (long)row * 32 + fq * 8;
                        *(f32x4*)gp = (f32x4){fast_sigmoid(v0[0] * r), fast_sigmoid(v0[1] * r), fast_sigmoid(v0[2] * r), fast_sigmoid(v0[3] * r)};
                        *(f32x4*)(gp + 4) = (f32x4){fast_sigmoid(v1[0] * r), fast_sigmoid(v1[1] * r), fast_sigmoid(v1[2] * r), fast_sigmoid(v1[3] * r)};
                        __builtin_amdgcn_sched_barrier(0);
                    }
            }
        } else {
            const int g = wc >> 1, d0 = (wc & 1) * 32 + fq * 8;
            const int kslot = (pn == 2) ? 0 : (pn == 5) ? 1 : (pn - 3), vslot = (pn == 2) ? 5 : (pn == 5) ? 2 : pn;
            bf16_t* Kd = KA + (long)kslot * (16 * SEQ * 64) + (long)g * SEQ * 64 + d0;
            bf16_t* Vd = KA + (long)vslot * (16 * SEQ * 64);
            Vd += (pn == 5) ? ((long)g * SEQ * 64 + d0) : ((long)(g * 64 + d0) * SEQ);
#pragma unroll
            for (int ai = 0; ai < 2; ++ai)
#pragma unroll
                for (int m = 0; m < 4; ++m) {
                    const int row = row0 + ai * 128 + m * 16;
                    const float r = rr[ai][m];
                    const int b = row >> 12, s = row & 4095;
                    {
                        const f32x4 v0 = acc[ai][0][m][0], v1 = acc[ai][0][m][1];
                        u32x4 w; w.x = cvt_pk_bf16(v0[0] * r, v0[1] * r); w.y = cvt_pk_bf16(v0[2] * r, v0[3] * r); w.z = cvt_pk_bf16(v1[0] * r, v1[1] * r); w.w = cvt_pk_bf16(v1[2] * r, v1[3] * r);
                        *(u32x4*)(Kd + ((long)b * 2 * SEQ + s) * 64) = w;
                    }
                    const f32x4 v0 = acc[ai][1][m][0], v1 = acc[ai][1][m][1];
                    if (pn == 5) {
                        u32x4 w; w.x = cvt_pk_bf16(v0[0] * r, v0[1] * r); w.y = cvt_pk_bf16(v0[2] * r, v0[3] * r); w.z = cvt_pk_bf16(v1[0] * r, v1[1] * r); w.w = cvt_pk_bf16(v1[2] * r, v1[3] * r);
                        *(u32x4*)(Vd + ((long)b * 2 * SEQ + s) * 64) = w;
                    } else {
                        bf16_t* vp = Vd + (long)b * 2 * 64 * SEQ + s;
#pragma unroll
                        for (int j = 0; j < 4; ++j) {
                            vp[(long)j * SEQ] = (bf16_t)(cvt_pk_bf16(v0[j] * r, 0.f) & 0xffffu);
                            vp[(long)(4 + j) * SEQ] = (bf16_t)(cvt_pk_bf16(v1[j] * r, 0.f) & 0xffffu);
                        }
                    }
                    __builtin_amdgcn_sched_barrier(0);
                }
        }
    }
};
struct EpiCmp1 {
    static constexpr bool PERM = true;
    const float* cb1; bf16_t* CHID;
    __device__ __forceinline__ void operator()(const AccT& acc, const pg8::Unit& u, int wr, int wc, int fr, int fq) const {
        const int row0 = u.pm * 256 + wr * 64 + fr;
        const float* cb = cb1 + u.pn * 256 + wc * 32 + fq * 8;
#pragma unroll
        for (int bj = 0; bj < 2; ++bj) {
            const f32x4 b0 = *(const f32x4*)(cb + bj * 128), b1 = *(const f32x4*)(cb + bj * 128 + 4);
#pragma unroll
            for (int ai = 0; ai < 2; ++ai)
#pragma unroll
                for (int m = 0; m < 4; ++m) {
                    const int row = row0 + ai * 128 + m * 16;
                    float y[8];
#pragma unroll
                    for (int j = 0; j < 4; ++j) { y[j] = acc[ai][bj][m][0][j] + b0[j]; y[4 + j] = acc[ai][bj][m][1][j] + b1[j]; }
#pragma unroll
                    for (int j = 0; j < 8; ++j) { const float x = y[j]; const float uu = 0.7978845608028654f * (x + 0.044715f * x * x * x); y[j] = x * fast_sigmoid(2.0f * uu); }
                    u32x4 w; w.x = cvt_pk_bf16(y[0], y[1]); w.y = cvt_pk_bf16(y[2], y[3]); w.z = cvt_pk_bf16(y[4], y[5]); w.w = cvt_pk_bf16(y[6], y[7]);
                    *(u32x4*)(CHID + (long)row * 256 + bj * 128 + wc * 32 + fq * 8) = w;
                    __builtin_amdgcn_sched_barrier(0);
                }
        }
    }
};
__device__ __forceinline__ void cmp_gemm2(const Params& p, int l, int pm) {
    asm volatile("s_waitcnt vmcnt(0)" ::: "memory");
    __syncthreads();
    __builtin_amdgcn_fence(__ATOMIC_ACQUIRE, "agent");
    asm volatile("s_waitcnt vmcnt(0)" ::: "memory");
    int tid = threadIdx.x; asm volatile("" : "+v"(tid));
    const int wave = tid >> 6, lane = tid & 63, fr = lane & 15, fq = lane >> 4;
    const int kv = pm >> 4, bg = pm & 15;
    const bf16_t* A = p.CHID + ((long)pm * 256 + wave * 32) * 256;
    const bf16_t* Bt = p.CW2T + ((long)(l * 2 + kv) * 64) * 256;
    f32x4 acc[2][4];
#pragma unroll
    for (int rt = 0; rt < 2; ++rt)
#pragma unroll
        for (int ct = 0; ct < 4; ++ct) acc[rt][ct] = (f32x4){0.f, 0.f, 0.f, 0.f};
#pragma unroll
    for (int ks = 0; ks < 8; ++ks) {
        bf16x8 af[2], bf[4];
#pragma unroll
        for (int rt = 0; rt < 2; ++rt) af[rt] = *(const bf16x8*)(A + (long)(rt * 16 + fr) * 256 + ks * 32 + fq * 8);
#pragma unroll
        for (int ct = 0; ct < 4; ++ct) bf[ct] = *(const bf16x8*)(Bt + (long)(ct * 16 + fr) * 256 + ks * 32 + fq * 8);
#pragma unroll
        for (int rt = 0; rt < 2; ++rt)
#pragma unroll
            for (int ct = 0; ct < 4; ++ct) acc[rt][ct] = __builtin_amdgcn_mfma_f32_16x16x32_bf16(af[rt], bf[ct], acc[rt][ct], 0, 0, 0);
    }
#pragma unroll
    for (int rt = 0; rt < 2; ++rt)
#pragma unroll
        for (int ct = 0; ct < 4; ++ct) {
            const int n = ct * 16 + fr, i0 = wave * 32 + rt * 16 + 4 * fq;
            f32x4 v = acc[rt][ct];
            if (i0 + 3 == 255) v[3] = 0.f;
            if (kv == 0) {
#pragma unroll
                for (int j = 0; j < 4; ++j) p.KCMP[((long)bg * 256 + i0 + j) * 64 + n] = (bf16_t)(cvt_pk_bf16(v[j], 0.f) & 0xffffu);
            } else {
                u32x2 w; w.x = cvt_pk_bf16(v[0], v[1]); w.y = cvt_pk_bf16(v[2], v[3]);
                *(u32x2*)(p.VCMPT + ((long)bg * 64 + n) * 256 + i0) = w;
            }
        }
}

#define AT_ROWB 144
#define AT_KT(b) ((b) * 9216)
#define AT_VT(b) (18432 + (b) * 9216)
#define AT_IMP 36864
#define AT_SEL (36864 + 4 * 64 * 66 * 4)
#define NEG_INF (-INFINITY)

struct AttSt { f32x16 O0, O1, CI; float m, l; };
__device__ __forceinline__ void att_init(AttSt& s, float cb = 0.f) {
#pragma unroll
    for (int i = 0; i < 16; ++i) { s.O0[i] = 0.f; s.O1[i] = 0.f; s.CI[i] = cb; }
    s.m = NEG_INF; s.l = 0.f;
}
__device__ __forceinline__ u32x4 at_gload(int tid, const bf16_t* base, long rstride) {
    const int row = tid >> 3, piece = tid & 7;
    return *(const u32x4*)(base + (long)row * rstride + piece * 8);
}
__device__ __forceinline__ void at_lwrite(int tid, LAS unsigned char* dst, u32x4 v) {
    const int row = tid >> 3, piece = tid & 7;
    *(LAS u32x4*)(dst + row * AT_ROWB + piece * 16) = v;
}
typedef __bf16 bf16x2n __attribute__((ext_vector_type(2)));
__device__ __forceinline__ unsigned pk_bf16_native(float lo, float hi) { bf16x2n v = {(__bf16)lo, (__bf16)hi}; return __builtin_bit_cast(unsigned, v); }
__device__ __forceinline__ float max3f(float a, float b, float c) { float r; asm("v_max3_f32 %0, %1, %2, %3" : "=v"(r) : "v"(a), "v"(b), "v"(c)); return r; }
__device__ __forceinline__ void at_scores(LAS const unsigned char* ktl, const bf16x8 (&qf)[4], f32x16& s0, f32x16& s1, const f32x16& ci) {
    bf16x8 kf[8];
#pragma unroll
    for (int s = 0; s < 4; ++s) { kf[2 * s] = *(LAS const bf16x8*)(ktl + s * 32); kf[2 * s + 1] = *(LAS const bf16x8*)(ktl + 32 * AT_ROWB + s * 32); }
    __builtin_amdgcn_sched_barrier(0);
    s0 = __builtin_amdgcn_mfma_f32_32x32x16_bf16(kf[0], qf[0], ci, 0, 0, 0);
    s1 = __builtin_amdgcn_mfma_f32_32x32x16_bf16(kf[1], qf[0], ci, 0, 0, 0);
#pragma unroll
    for (int s = 1; s < 4; ++s) {
        s0 = __builtin_amdgcn_mfma_f32_32x32x16_bf16(kf[2 * s], qf[s], s0, 0, 0, 0);
        s1 = __builtin_amdgcn_mfma_f32_32x32x16_bf16(kf[2 * s + 1], qf[s], s1, 0, 0, 0);
    }
}
__device__ __forceinline__ void at_scores0(LAS const unsigned char* ktl, const bf16x8 (&qf)[4], f32x16& s0, f32x16& s1) {
    f32x16 z;
#pragma unroll
    for (int i = 0; i < 16; ++i) z[i] = 0.f;
    at_scores(ktl, qf, s0, s1, z);
}
__device__ __forceinline__ void at_vload(LAS const unsigned char* vtl, bf16x8 (&vf)[8]) {
#pragma unroll
    for (int ks = 0; ks < 4; ++ks) { vf[2 * ks] = *(LAS const bf16x8*)(vtl + ks * 32); vf[2 * ks + 1] = *(LAS const bf16x8*)(vtl + 32 * AT_ROWB + ks * 32); }
}
template <bool MASKQ = false>
__device__ __forceinline__ void at_pv(const bf16x8 (&vf)[8], const f32x16& p0, const f32x16& p1, AttSt& st, bool mine = true) {
    bf16x8 pf[4];
#pragma unroll
    for (int sg = 0; sg < 2; ++sg) {
        u32x4 a, b;
        a.x = pk_bf16_native(p0[8 * sg + 0], p0[8 * sg + 1]); a.y = pk_bf16_native(p0[8 * sg + 2], p0[8 * sg + 3]); a.z = pk_bf16_native(p0[8 * sg + 4], p0[8 * sg + 5]); a.w = pk_bf16_native(p0[8 * sg + 6], p0[8 * sg + 7]);
        b.x = pk_bf16_native(p1[8 * sg + 0], p1[8 * sg + 1]); b.y = pk_bf16_native(p1[8 * sg + 2], p1[8 * sg + 3]); b.z = pk_bf16_native(p1[8 * sg + 4], p1[8 * sg + 5]); b.w = pk_bf16_native(p1[8 * sg + 6], p1[8 * sg + 7]);
        if (MASKQ) { a.x = mine ? a.x : 0u; a.y = mine ? a.y : 0u; a.z = mine ? a.z : 0u; a.w = mine ? a.w : 0u; b.x = mine ? b.x : 0u; b.y = mine ? b.y : 0u; b.z = mine ? b.z : 0u; b.w = mine ? b.w : 0u; }
        pf[sg] = __builtin_bit_cast(bf16x8, a); pf[2 + sg] = __builtin_bit_cast(bf16x8, b);
    }
#pragma unroll
    for (int ks = 0; ks < 4; ++ks) {
        st.O0 = __builtin_amdgcn_mfma_f32_32x32x16_bf16(vf[2 * ks], pf[ks], st.O0, 0, 0, 0);
        st.O1 = __builtin_amdgcn_mfma_f32_32x32x16_bf16(vf[2 * ks + 1], pf[ks], st.O1, 0, 0, 0);
    }
}
#define AT_THR 20.0f
template <bool MASKQ = false>
__device__ __forceinline__ void at_softmax_pv(LAS const unsigned char* vtl, f32x16& s0, f32x16& s1, AttSt& st, bool mine = true) {
    bf16x8 vf[8];
    at_vload(vtl, vf);
    __builtin_amdgcn_sched_barrier(0);
    float tm = fmaxf(s0[15], s1[15]);
#pragma unroll
    for (int i = 0; i < 15; ++i) tm = max3f(tm, s0[i], s1[i]);
    tm = half_swap_max(tm);
    if (MASKQ) tm = mine ? tm : NEG_INF;
    const bool unset = (st.m == NEG_INF);
    const bool need = unset ? (tm > NEG_INF) : (tm > AT_THR);
    if (__any(need)) {
        const float delta = need ? tm : 0.f;
        const float al = __builtin_amdgcn_exp2f(-delta);
#pragma unroll
        for (int i = 0; i < 16; ++i) { s0[i] -= delta; s1[i] -= delta; st.O0[i] *= al; st.O1[i] *= al; st.CI[i] -= delta; }
        st.l *= al;
        st.m = need ? ((unset ? 0.f : st.m) + delta) : st.m;
    }
    typedef float f32x2v __attribute__((ext_vector_type(2)));
    f32x2v ls = (f32x2v){0.f, 0.f};
#pragma unroll
    for (int i = 0; i < 16; ++i) { s0[i] = __builtin_amdgcn_exp2f(s0[i]); s1[i] = __builtin_amdgcn_exp2f(s1[i]); }
#pragma unroll
    for (int i = 0; i < 16; i += 2) { ls += (f32x2v){s0[i], s0[i + 1]}; ls += (f32x2v){s1[i], s1[i + 1]}; }
    const float lsum = ls.x + ls.y;
    st.l += MASKQ ? (mine ? lsum : 0.f) : lsum;
    at_pv<MASKQ>(vf, s0, s1, st, mine);
}
#define AT_KO(tau, reg) (32 * (tau) + 16 * ((reg) >> 3) + ((reg) & 7))

__device__ __forceinline__ void at_bias_table(f32x16& s0, f32x16& s1, LAS const float* tabl) {
#pragma unroll
    for (int i = 0; i < 16; ++i) { s0[i] += tabl[AT_KO(0, i)]; s1[i] += tabl[AT_KO(1, i)]; }
}
__device__ __forceinline__ void at_mask_gt(f32x16& s0, f32x16& s1, int thrl) {
#pragma unroll
    for (int i = 0; i < 16; ++i) { s0[i] = (AT_KO(0, i) > thrl) ? s0[i] : NEG_INF; s1[i] = (AT_KO(1, i) > thrl) ? s1[i] : NEG_INF; }
}
__device__ __forceinline__ void at_mask_lt(f32x16& s0, f32x16& s1, int thrl) {
#pragma unroll
    for (int i = 0; i < 16; ++i) { s0[i] = (AT_KO(0, i) < thrl) ? s0[i] : NEG_INF; s1[i] = (AT_KO(1, i) < thrl) ? s1[i] : NEG_INF; }
}
__device__ __forceinline__ void at_store(bf16_t* dst  , const AttSt& st, float scale, int hq) {
#pragma unroll
    for (int dl = 0; dl < 2; ++dl)
#pragma unroll
        for (int sg = 0; sg < 2; ++sg) {
            const f32x16& O = dl ? st.O1 : st.O0;
            u32x4 w;
            w.x = cvt_pk_bf16(O[8 * sg + 0] * scale, O[8 * sg + 1] * scale); w.y = cvt_pk_bf16(O[8 * sg + 2] * scale, O[8 * sg + 3] * scale);
            w.z = cvt_pk_bf16(O[8 * sg + 4] * scale, O[8 * sg + 5] * scale); w.w = cvt_pk_bf16(O[8 * sg + 6] * scale, O[8 * sg + 7] * scale);
            *(u32x4*)(dst + 32 * dl + 16 * sg + 8 * hq) = w;
        }
}
__device__ __forceinline__ int at_pi(int rho) { return (rho & 0x13) | ((rho & 4) << 1) | ((rho & 8) >> 1); }

__device__ __forceinline__ void build_tables(const Params& p, LAS unsigned char* lds) {
    LAS float* TR = (LAS float*)(lds + LDS_TAB_OFF);
    for (int e = threadIdx.x; e < 16 * 256; e += NTHR) {
        const int h = e >> 8, x = e & 255, dist = 191 - x;
        float v;
        if (dist < 0) v = NEG_INF;
        else if (dist < 128) v = (p.rel_bias[kBucket[dist] * 16 + h] - ((h < 8) ? 0.f : p.rel_bias[31 * 16 + h])) * LOG2E;
        else v = (h < 8) ? NEG_INF : 0.f;
        TR[e] = v;
    }
    __syncthreads();
}

#define AT_STEP(RKL, RVL, RKW, RVW, KB, KST, KRS, VB, VST, VRS, ...) { \
        { const int jl_ = (j + 3 < je_) ? j + 3 : je_; RKL = at_gload(tid, (KB) + (long)jl_ * (KST), (KRS)); RVL = at_gload(tid, (VB) + (long)jl_ * (VST), (VRS)); } \
        { const int buf = (j - j0_) & 1; __VA_ARGS__ \
          if (j < je_) { at_lwrite(tid, lds + AT_KT(buf ^ 1), RKW); at_lwrite(tid, lds + AT_VT(buf ^ 1), RVW); } } \
        __syncthreads(); \
        if (j == je_) break; \
        ++j; }
struct TileSets { u32x4 k0, v0, k1, v1, k2, v2; };
#define AT_PRELOAD(S, J0, JE, KB, KST, KRS, VB, VST, VRS) { \
        const int a_ = (J0), e_ = (JE); const int b_ = (a_ + 1 < e_) ? a_ + 1 : e_, c_ = (a_ + 2 < e_) ? a_ + 2 : e_; \
        S.k0 = at_gload(tid, (KB) + (long)a_ * (KST), (KRS)); S.v0 = at_gload(tid, (VB) + (long)a_ * (VST), (VRS)); \
        S.k1 = at_gload(tid, (KB) + (long)b_ * (KST), (KRS)); S.v1 = at_gload(tid, (VB) + (long)b_ * (VST), (VRS)); \
        S.k2 = at_gload(tid, (KB) + (long)c_ * (KST), (KRS)); S.v2 = at_gload(tid, (VB) + (long)c_ * (VST), (VRS)); }
#define AT_LOOP_FROM(S, J0, JE, KB, KST, KRS, VB, VST, VRS, ...) { \
        const int j0_ = (J0), je_ = (JE); \
        at_lwrite(tid, lds + AT_KT(0), S.k0); at_lwrite(tid, lds + AT_VT(0), S.v0); \
        __syncthreads(); \
        for (int j = j0_;;) { \
            AT_STEP(S.k0, S.v0, S.k1, S.v1, KB, KST, KRS, VB, VST, VRS, __VA_ARGS__) \
            AT_STEP(S.k1, S.v1, S.k2, S.v2, KB, KST, KRS, VB, VST, VRS, __VA_ARGS__) \
            AT_STEP(S.k2, S.v2, S.k0, S.v0, KB, KST, KRS, VB, VST, VRS, __VA_ARGS__) \
        } }

__device__ __forceinline__ void attn_aw_unit(const Params& p, int l, int b, int g, int c, LAS unsigned char* lds) {
    int tid = threadIdx.x; asm volatile("" : "+v"(tid));
    const int wave = tid >> 6, lane = tid & 63, r = wave & 3, th = wave >> 2, hq = lane >> 5, ql = lane & 31;
    const int h = g * 4 + r, bg = b * 2 + g;
    const int tl = 32 * th + ql;
    const long tok = (long)b * SEQ + 64 * c + tl;
    LAS const unsigned char* ktl = lds + at_pi(ql) * AT_ROWB + 16 * hq;
    LAS const unsigned char* vtl = lds + at_pi(ql) * AT_ROWB + 16 * hq;
    LAS const float* TR = (LAS const float*)(lds + LDS_TAB_OFF);
    bf16x8 qf[4], qfb[4];
    AttSt st;
    const bf16_t* KAp = p.KA + (long)bg * SEQ * 64; const bf16_t* VAp = p.VAT + (long)bg * 64 * SEQ;
    const bf16_t* KWp = p.KW + (long)bg * SEQ * 64; const bf16_t* VWp = p.VWT + (long)bg * 64 * SEQ;
    const int ja0 = (c - 2 < 0) ? 0 : c - 2, jw0 = (c - 8 < 0) ? 0 : c - 8;
    TileSets SA, SW;
#pragma unroll
    for (int s = 0; s < 4; ++s) qf[s] = *(const bf16x8*)(p.QA + tok * 512 + h * 64 + 16 * s + 8 * hq);
    AT_PRELOAD(SA, ja0, c, KAp, 4096, 64, VAp, 64, SEQ)
#pragma unroll
    for (int s = 0; s < 4; ++s) qfb[s] = *(const bf16x8*)(p.QB + tok * 512 + h * 64 + 16 * s + 8 * hq);
    AT_PRELOAD(SW, jw0, c, KWp, 4096, 64, VWp, 64, SEQ)
    const float gwin = p.G24[tok * 32 + h * 3 + 2];
    const float sinkv = p.a_sinks[l * 8 + h] * LOG2E;
    const float cbw = p.rel_bias[31 * 16 + 8 + h] * LOG2E;
    {
        att_init(st);
        AT_LOOP_FROM(SA, ja0, c, KAp, 4096, 64, VAp, 64, SEQ, {
            f32x16 s0, s1;
            at_scores(ktl + AT_KT(buf), qf, s0, s1, st.CI);
            const int drel = 64 * (c - j) + tl;
            at_bias_table(s0, s1, TR + h * 256 + (191 - drel + 8 * hq));
            at_softmax_pv(vtl + AT_VT(buf), s0, s1, st); })
        float lt = half_swap_sum(st.l);
        lt += __builtin_amdgcn_exp2f(sinkv - st.m);
        at_store(p.OAB + tok * 1024 + h * 64, st, 1.0f / lt, hq);
    }
    {
        att_init(st, cbw);
        AT_LOOP_FROM(SW, jw0, c, KWp, 4096, 64, VWp, 64, SEQ, {
            f32x16 s0, s1;
            at_scores(ktl + AT_KT(buf), qfb, s0, s1, st.CI);
            if (j >= c - 2) {
                const int drel = 64 * (c - j) + tl;
                at_bias_table(s0, s1, TR + (8 + h) * 256 + (191 - drel + 8 * hq));
            } else if (j == c - 8) at_mask_gt(s0, s1, tl - 8 * hq);
            at_softmax_pv(vtl + AT_VT(buf), s0, s1, st); })
        const float lt = half_swap_sum(st.l);
        at_store(p.OW + tok * 512 + h * 64, st, gwin / lt, hq);
    }
}

__device__ __forceinline__ void attn_cs_unit(const Params& p, int b, int g, int c, LAS unsigned char* lds) {
    int tid = threadIdx.x; asm volatile("" : "+v"(tid));
    const int wave = tid >> 6, lane = tid & 63, r = wave & 3, th = wave >> 2, hq = lane >> 5, ql = lane & 31;
    const int h = g * 4 + r, bg = b * 2 + g;
    const int tl = 32 * th + ql, tq = 64 * c + tl;
    const long tok = (long)b * SEQ + tq;
    LAS const unsigned char* ktl = lds + at_pi(ql) * AT_ROWB + 16 * hq;
    LAS const unsigned char* vtl = lds + at_pi(ql) * AT_ROWB + 16 * hq;
    LAS const float* TR = (LAS const float*)(lds + LDS_TAB_OFF);
    LAS float* IMP = (LAS float*)(lds + AT_IMP);
    LAS unsigned long long* SEL = (LAS unsigned long long*)(lds + AT_SEL);
    bf16x8 qf[4];
#pragma unroll
    for (int s = 0; s < 4; ++s) qf[s] = *(const bf16x8*)(p.QB + tok * 512 + h * 64 + 16 * s + 8 * hq);
    const int nv = (tq >= 31) ? ((tq - 31) / 16 + 1) : 0;
    const int nv_hi = (64 * c + 63 - 31) / 16 + 1;
    const int ntile = (nv_hi + 63) / 64;
    const bf16_t* KC = p.KCMP + (long)bg * 256 * 64; const bf16_t* VCT = p.VCMPT + (long)bg * 64 * 256;
    const bf16_t* KSp = p.KS + (long)bg * SEQ * 64; const bf16_t* VSp = p.VST + (long)bg * 64 * SEQ;
    TileSets S1, S2;
    AT_PRELOAD(S1, 0, ntile - 1, KC, 4096, 64, VCT, 64, 256)
    AT_PRELOAD(S2, 0, ntile - 1, KC, 4096, 64, VCT, 64, 256)
    const float g0 = p.G24[tok * 32 + h * 3 + 0], g1 = p.G24[tok * 32 + h * 3 + 1];
    u32x4 owp[4];
#pragma unroll
    for (int q4 = 0; q4 < 4; ++q4) owp[q4] = *(const u32x4*)(p.OW + tok * 512 + h * 64 + 32 * (q4 >> 1) + 16 * (q4 & 1) + 8 * hq);
    const float cbs = p.rel_bias[31 * 16 + 8 + h] * LOG2E;
    float m1 = NEG_INF, l1 = 0.f;
    AT_LOOP_FROM(S1, 0, ntile - 1, KC, 4096, 64, VCT, 64, 256, {
        f32x16 s0, s1;
        at_scores0(ktl + AT_KT(buf), qf, s0, s1);
        at_mask_lt(s0, s1, nv - 64 * j - 8 * hq);
        float tm = fmaxf(s0[15], s1[15]);
        _Pragma("unroll") for (int i = 0; i < 15; ++i) tm = max3f(tm, s0[i], s1[i]);
        tm = half_swap_max(tm);
        if (tm > m1) { l1 *= __builtin_amdgcn_exp2f(m1 - tm); m1 = tm; }
        const float mu = (m1 == NEG_INF) ? 0.f : m1;
        float ls = 0.f;
        _Pragma("unroll") for (int i = 0; i < 16; ++i) ls += __builtin_amdgcn_exp2f(s0[i] - mu) + __builtin_amdgcn_exp2f(s1[i] - mu);
        l1 += ls; })
    l1 = half_swap_sum(l1);
    const float inv1 = (l1 > 0.f) ? 1.0f / l1 : 0.f;
    const float mu1 = (m1 == NEG_INF) ? 0.f : m1;
    AttSt st; att_init(st);
    float imp_carry = 0.f;
    AT_PRELOAD(S1, 0, c, KSp, 4096, 64, VSp, 64, SEQ)
    AT_LOOP_FROM(S2, 0, ntile - 1, KC, 4096, 64, VCT, 64, 256, {
        f32x16 s0, s1;
        at_scores0(ktl + AT_KT(buf), qf, s0, s1);
        at_mask_lt(s0, s1, nv - 64 * j - 8 * hq);
        _Pragma("unroll") for (int i = 0; i < 16; ++i) { s0[i] = __builtin_amdgcn_exp2f(s0[i] - mu1) * inv1; s1[i] = __builtin_amdgcn_exp2f(s1[i] - mu1) * inv1; }
        if (c >= 16) { float G0[4], G1[4];
          _Pragma("unroll") for (int a = 0; a < 4; ++a) { G0[a] = (s0[4 * a] + s0[4 * a + 1]) + (s0[4 * a + 2] + s0[4 * a + 3]); G1[a] = (s1[4 * a] + s1[4 * a + 1]) + (s1[4 * a + 2] + s1[4 * a + 3]); }
          const float r01 = half_other(s0[7], hq), r03 = half_other(s0[15], hq), r11 = half_other(s1[7], hq), r13 = half_other(s1[15], hq);
          LAS float* irow = IMP + (r * 64 + tl) * 66 + 16 * j + 2 * hq;
          irow[0]  = G0[0] + (hq ? r01 : imp_carry);
          irow[1]  = G0[1] + s0[3];
          irow[4]  = G0[2] + (hq ? r03 : r01);
          irow[5]  = G0[3] + s0[11];
          irow[8]  = G1[0] + (hq ? r11 : r03);
          irow[9]  = G1[1] + s1[3];
          irow[12] = G1[2] + (hq ? r13 : r11);
          irow[13] = G1[3] + s1[11];
          imp_carry = r13; }
        { bf16x8 vf[8]; at_vload(vtl + AT_VT(buf), vf); at_pv(vf, s0, s1, st); } })
    {
        bf16_t* dst = p.OAB + tok * 1024 + 512 + h * 64;
#pragma unroll
        for (int dl = 0; dl < 2; ++dl)
#pragma unroll
            for (int sg = 0; sg < 2; ++sg) {
                const f32x16& O = dl ? st.O1 : st.O0;
                const u32x4 wv = owp[dl * 2 + sg];
                u32x4 w;
                w.x = cvt_pk_bf16(O[8 * sg + 0] * g0 + bf16lo(wv.x), O[8 * sg + 1] * g0 + bf16hi(wv.x)); w.y = cvt_pk_bf16(O[8 * sg + 2] * g0 + bf16lo(wv.y), O[8 * sg + 3] * g0 + bf16hi(wv.y));
                w.z = cvt_pk_bf16(O[8 * sg + 4] * g0 + bf16lo(wv.z), O[8 * sg + 5] * g0 + bf16hi(wv.z)); w.w = cvt_pk_bf16(O[8 * sg + 6] * g0 + bf16lo(wv.w), O[8 * sg + 7] * g0 + bf16hi(wv.w));
                *(u32x4*)(dst + 32 * dl + 16 * sg + 8 * hq) = w;
            }
    }
    unsigned long long mysel;
    if (c < 16) {
        mysel = (2ull << c) - 1ull;
    } else {
        const int js = lane, tb = c;
        const bool causal = js <= tb, forced = (js == 0) || (js == tb) || (js == tb - 1);
        const bool cand = causal && !forced;
        const unsigned long long mforced = __ballot(causal && forced), mcand = __ballot(cand);
        const int want = 16 - __builtin_popcountll(mforced);
#pragma unroll 1
        for (int k = 0; k < 8; k += 2) {
            const int t = 8 * wave + k;
            const unsigned va = __float_as_uint((IMP[t * 66 + js] + IMP[(64 + t) * 66 + js]) + (IMP[(128 + t) * 66 + js] + IMP[(192 + t) * 66 + js]));
            const unsigned vc = __float_as_uint((IMP[(t + 1) * 66 + js] + IMP[(65 + t) * 66 + js]) + (IMP[(129 + t) * 66 + js] + IMP[(193 + t) * 66 + js]));
            unsigned Ta = 0u, Tc = 0u; bool da = false, dc = false;
            unsigned long long msa = 0ull, msc = 0ull;
#pragma unroll 1
            for (int bit = 30; bit >= 0; --bit) {
                const unsigned tra = Ta | (1u << bit), trc = Tc | (1u << bit);
                const unsigned long long mga = __ballot(cand && va >= tra), mgc = __ballot(cand && vc >= trc);
                const int ca = __builtin_popcountll(mga), cc = __builtin_popcountll(mgc);
                if (!da) { if (ca == want) { msa = mga; da = true; } else Ta = (ca > want) ? tra : Ta; }
                if (!dc) { if (cc == want) { msc = mgc; dc = true; } else Tc = (cc > want) ? trc : Tc; }
                if (da && dc) break;
            }
            if (!da) {
                const unsigned long long mgt = __ballot(cand && va > Ta), meq = __ballot(cand && va == Ta);
                const int rq = want - __builtin_popcountll(mgt);
                const int below = __builtin_amdgcn_mbcnt_hi((unsigned)(meq >> 32), __builtin_amdgcn_mbcnt_lo((unsigned)meq, 0));
                msa = mgt | __ballot(cand && va == Ta && below < rq);
            }
            if (!dc) {
                const unsigned long long mgt = __ballot(cand && vc > Tc), meq = __ballot(cand && vc == Tc);
                const int rq = want - __builtin_popcountll(mgt);
                const int below = __builtin_amdgcn_mbcnt_hi((unsigned)(meq >> 32), __builtin_amdgcn_mbcnt_lo((unsigned)meq, 0));
                msc = mgt | __ballot(cand && vc == Tc && below < rq);
            }
            if (lane == 0) { SEL[t] = msa | mforced; SEL[t + 1] = msc | mforced; }
        }
        __syncthreads();
        mysel = SEL[tl];
    }
    {
        att_init(st, cbs);
        AT_LOOP_FROM(S1, 0, c, KSp, 4096, 64, VSp, 64, SEQ, {
            const bool mine = (mysel >> j) & 1ull;
            if (__ballot(mine) != 0ull) {
                f32x16 s0, s1;
                at_scores(ktl + AT_KT(buf), qf, s0, s1, st.CI);
                if (j >= c - 2) {
                    const int drel = 64 * (c - j) + tl;
                    at_bias_table(s0, s1, TR + (8 + h) * 256 + (191 - drel + 8 * hq));
                }
                at_softmax_pv<true>(vtl + AT_VT(buf), s0, s1, st, mine);
            } })
        const float lt = half_swap_sum(st.l);
        const float g1l = g1 / lt;
        bf16_t* dst = p.OAB + tok * 1024 + 512 + h * 64;
#pragma unroll
        for (int dl = 0; dl < 2; ++dl)
#pragma unroll
            for (int sg = 0; sg < 2; ++sg) {
                const f32x16& O = dl ? st.O1 : st.O0;
                const u32x4 wv = *(const u32x4*)(dst + 32 * dl + 16 * sg + 8 * hq);
                u32x4 w;
                w.x = cvt_pk_bf16(O[8 * sg + 0] * g1l + bf16lo(wv.x), O[8 * sg + 1] * g1l + bf16hi(wv.x)); w.y = cvt_pk_bf16(O[8 * sg + 2] * g1l + bf16lo(wv.y), O[8 * sg + 3] * g1l + bf16hi(wv.y));
                w.z = cvt_pk_bf16(O[8 * sg + 4] * g1l + bf16lo(wv.z), O[8 * sg + 5] * g1l + bf16hi(wv.z)); w.w = cvt_pk_bf16(O[8 * sg + 6] * g1l + bf16lo(wv.w), O[8 * sg + 7] * g1l + bf16hi(wv.w));
                *(u32x4*)(dst + 32 * dl + 16 * sg + 8 * hq) = w;
            }
    }
}
struct EpiGate {
    static constexpr bool PERM = true;
    const float* rs; bf16_t* DST;
    __device__ __forceinline__ void operator()(const AccT& acc, const pg8::Unit& u, int wr, int wc, int fr, int fq) const {
        const int row0 = u.pm * 256 + wr * 64 + fr;
        float rr[2][4];
#pragma unroll
        for (int ai = 0; ai < 2; ++ai)
#pragma unroll
            for (int m = 0; m < 4; ++m) rr[ai][m] = rs[row0 + ai * 128 + m * 16];
#pragma unroll
        for (int ai = 0; ai < 2; ++ai)
#pragma unroll
            for (int m = 0; m < 4; ++m) {
                const float r = rr[ai][m];
                bf16_t* dp = DST + (long)(row0 + ai * 128 + m * 16) * 1024 + u.pn * 256 + wc * 32 + fq * 8;
#pragma unroll
                for (int bj = 0; bj < 2; ++bj) {
                    const f32x4 v0 = acc[ai][bj][m][0], v1 = acc[ai][bj][m][1];
                    u32x4 w; w.x = cvt_pk_bf16(fast_sigmoid(v0[0] * r), fast_sigmoid(v0[1] * r)); w.y = cvt_pk_bf16(fast_sigmoid(v0[2] * r), fast_sigmoid(v0[3] * r));
                    w.z = cvt_pk_bf16(fast_sigmoid(v1[0] * r), fast_sigmoid(v1[1] * r)); w.w = cvt_pk_bf16(fast_sigmoid(v1[2] * r), fast_sigmoid(v1[3] * r));
                    *(u32x4*)(dp + bj * 128) = w;
                    __builtin_amdgcn_sched_barrier(0);
                }
            }
    }
};
struct EpiMerge2 {
    static constexpr bool PERM = true;
    bf16_t* MERGED; const bf16_t* GB;
    static __device__ __forceinline__ float gclamp(float g) { return fmaxf(g, 1e-30f); }
    __device__ __forceinline__ void mid(AccT& acc, const pg8::Unit& u, int wr, int wc, int fr, int fq) const {
        int row0 = u.pm * 256 + wr * 64 + fr;
        asm volatile("" : "+v"(row0));
        const long cbase = (long)u.pn * 256 + wc * 32 + fq * 8;
        u32x4 ac[2], bc[2], an[2], bn[2];
#pragma unroll
        for (int bj = 0; bj < 2; ++bj) {
            ac[bj] = *(const u32x4*)(MERGED + (long)row0 * 1024 + cbase + bj * 128); bc[bj] = *(const u32x4*)(GB + (long)row0 * 1024 + cbase + bj * 128);
            an[bj] = ac[bj]; bn[bj] = bc[bj];
        }
#pragma unroll
        for (int i = 0; i < 8; ++i) {
            const int ai = i >> 2, m = i & 3;
            if (i < 7) {
                const long on = (long)(row0 + ((i + 1) >> 2) * 128 + ((i + 1) & 3) * 16) * 1024 + cbase;
#pragma unroll
                for (int bj = 0; bj < 2; ++bj) { an[bj] = *(const u32x4*)(MERGED + on + bj * 128); bn[bj] = *(const u32x4*)(GB + on + bj * 128); }
            }
#pragma unroll
            for (int bj = 0; bj < 2; ++bj) {
                const u32x4 a = ac[bj], b = bc[bj];
                f32x4& v0 = acc[ai][bj][m][0]; f32x4& v1 = acc[ai][bj][m][1];
                v0[0] *= bf16lo(a.x) * __builtin_amdgcn_rcpf(gclamp(bf16lo(b.x))); v0[1] *= bf16hi(a.x) * __builtin_amdgcn_rcpf(gclamp(bf16hi(b.x)));
                v0[2] *= bf16lo(a.y) * __builtin_amdgcn_rcpf(gclamp(bf16lo(b.y))); v0[3] *= bf16hi(a.y) * __builtin_amdgcn_rcpf(gclamp(bf16hi(b.y)));
                v1[0] *= bf16lo(a.z) * __builtin_amdgcn_rcpf(gclamp(bf16lo(b.z))); v1[1] *= bf16hi(a.z) * __builtin_amdgcn_rcpf(gclamp(bf16hi(b.z)));
                v1[2] *= bf16lo(a.w) * __builtin_amdgcn_rcpf(gclamp(bf16lo(b.w))); v1[3] *= bf16hi(a.w) * __builtin_amdgcn_rcpf(gclamp(bf16hi(b.w)));
            }
#pragma unroll
            for (int bj = 0; bj < 2; ++bj) { ac[bj] = an[bj]; bc[bj] = bn[bj]; }
            __builtin_amdgcn_sched_barrier(0);
        }
    }
    __device__ __forceinline__ void operator()(const AccT& acc, const pg8::Unit& u, int wr, int wc, int fr, int fq) const {
        const int row0 = u.pm * 256 + wr * 64 + fr;
        const long cbase = (long)u.pn * 256 + wc * 32 + fq * 8;
        u32x4 gc[2], gn[2];
#pragma unroll
        for (int bj = 0; bj < 2; ++bj) { gc[bj] = *(const u32x4*)(GB + (long)row0 * 1024 + cbase + bj * 128); gn[bj] = gc[bj]; }
#pragma unroll
        for (int i = 0; i < 8; ++i) {
            const int ai = i >> 2, m = i & 3;
            const long o = (long)(row0 + ai * 128 + m * 16) * 1024 + cbase;
            if (i < 7) {
                const long on = (long)(row0 + ((i + 1) >> 2) * 128 + ((i + 1) & 3) * 16) * 1024 + cbase;
#pragma unroll
                for (int bj = 0; bj < 2; ++bj) gn[bj] = *(const u32x4*)(GB + on + bj * 128);
            }
#pragma unroll
            for (int bj = 0; bj < 2; ++bj) {
                const f32x4 v0 = acc[ai][bj][m][0], v1 = acc[ai][bj][m][1];
                const u32x4 gg = gc[bj];
                u32x4 w;
                w.x = cvt_pk_bf16(gclamp(bf16lo(gg.x)) * v0[0], gclamp(bf16hi(gg.x)) * v0[1]); w.y = cvt_pk_bf16(gclamp(bf16lo(gg.y)) * v0[2], gclamp(bf16hi(gg.y)) * v0[3]);
                w.z = cvt_pk_bf16(gclamp(bf16lo(gg.z)) * v1[0], gclamp(bf16hi(gg.z)) * v1[1]); w.w = cvt_pk_bf16(gclamp(bf16lo(gg.w)) * v1[2], gclamp(bf16hi(gg.w)) * v1[3]);
                *(u32x4*)(MERGED + o + bj * 128) = w;
            }
#pragma unroll
            for (int bj = 0; bj < 2; ++bj) gc[bj] = gn[bj];
            __builtin_amdgcn_sched_barrier(0);
        }
    }
};
struct EpiOut {
    static constexpr bool PERM = true;
    bf16_t* HB; float* ssq16;
    __device__ __forceinline__ void operator()(const AccT& acc, const pg8::Unit& u, int wr, int wc, int fr, int fq) const {
        const int row0 = u.pm * 256 + wr * 64 + fr;
        const long cbase = (long)u.pn * 256 + wc * 32 + fq * 8;
        u32x4 cur[2], nxt[2];
#pragma unroll
        for (int bj = 0; bj < 2; ++bj) cur[bj] = *(const u32x4*)(HB + (long)row0 * 1024 + cbase + bj * 128);
#pragma unroll
        for (int i = 0; i < 8; ++i) {
            const int ai = i >> 2, m = i & 3;
            const int row = row0 + ai * 128 + m * 16;
            if (i < 7) {
                const int rown = row0 + ((i + 1) >> 2) * 128 + ((i + 1) & 3) * 16;
#pragma unroll
                for (int bj = 0; bj < 2; ++bj) nxt[bj] = *(const u32x4*)(HB + (long)rown * 1024 + cbase + bj * 128);
            }
            float ss = 0.f;
#pragma unroll
            for (int bj = 0; bj < 2; ++bj) {
                const long oo = (long)row * 1024 + cbase + bj * 128;
                const u32x4 c = cur[bj];
                const f32x4 h0 = {bf16lo(c.x), bf16hi(c.x), bf16lo(c.y), bf16hi(c.y)}, h1 = {bf16lo(c.z), bf16hi(c.z), bf16lo(c.w), bf16hi(c.w)};
                const f32x4 v0 = h0 + acc[ai][bj][m][0], v1 = h1 + acc[ai][bj][m][1];
                u32x4 w; w.x = cvt_pk_bf16(v0[0], v0[1]); w.y = cvt_pk_bf16(v0[2], v0[3]); w.z = cvt_pk_bf16(v1[0], v1[1]); w.w = cvt_pk_bf16(v1[2], v1[3]);
                *(u32x4*)(HB + oo) = w;
                ss += ((v0[0] * v0[0] + v0[1] * v0[1]) + (v0[2] * v0[2] + v0[3] * v0[3])) + ((v1[0] * v1[0] + v1[1] * v1[1]) + (v1[2] * v1[2] + v1[3] * v1[3]));
            }
            ss += swz_xor<16>(ss); ss = half_swap_sum(ss);
            if (fq == 0) ssq16[(long)row * 16 + u.pn * 4 + wc] = ss;
#pragma unroll
            for (int bj = 0; bj < 2; ++bj) cur[bj] = nxt[bj];
            __builtin_amdgcn_sched_barrier(0);
        }
    }
};

__device__ __forceinline__ void gates24_phase(const Params& p, int l, LAS unsigned char* lds) {
    constexpr int WROW = 136;
    LAS bf16_t* WB = (LAS bf16_t*)lds;
    int tid = threadIdx.x; asm volatile("" : "+v"(tid));
    const int wave = tid >> 6, lane = tid & 63, fr = lane & 15, kq = lane >> 4;
    const bf16_t* W = p.WinT + ((long)l * 4352 + 2048) * 1024;
    for (int tile = blockIdx.x; tile < T_TOK / 128; tile += gridDim.x) {
        const long t0 = (long)tile * 128;
        const bf16_t* xrow = p.HB + (t0 + wave * 16 + fr) * DM + kq * 8;
        f32x4 acc[2];
#pragma unroll
        for (int ct = 0; ct < 2; ++ct) acc[ct] = (f32x4){0.f, 0.f, 0.f, 0.f};
        for (int kc = 0; kc < 1024; kc += 128) {
            bf16x8 xv[4];
#pragma unroll
            for (int ks = 0; ks < 4; ++ks) xv[ks] = *(const bf16x8*)(xrow + kc + ks * 32);
            __syncthreads();
            { const int row = tid >> 4, piece = tid & 15;
              const u32x4 v = *(const u32x4*)(W + (long)row * 1024 + kc + piece * 8);
              *(LAS u32x4*)(WB + row * WROW + piece * 8) = v; }
            __syncthreads();
#pragma unroll
            for (int ks = 0; ks < 4; ++ks)
#pragma unroll
                for (int ct = 0; ct < 2; ++ct) {
                    const bf16x8 bw = *(LAS const bf16x8*)(WB + (ct * 16 + fr) * WROW + ks * 32 + kq * 8);
                    acc[ct] = __builtin_amdgcn_mfma_f32_16x16x32_bf16(xv[ks], bw, acc[ct], 0, 0, 0);
                }
        }
#pragma unroll
        for (int j = 0; j < 4; ++j) {
            const long t = t0 + wave * 16 + 4 * kq + j;
            const float r = p.rsA[t];
            p.G24[t * 32 + fr] = fast_sigmoid(acc[0][j] * r);
            if (fr < 8) p.G24[t * 32 + 16 + fr] = fast_sigmoid(acc[1][j] * r);
        }
    }
    __syncthreads();
}
typedef __bf16 bf16x8n __attribute__((ext_vector_type(8)));
__device__ __forceinline__ void router_phase(const Params& p, int l, LAS unsigned char* lds) {
    constexpr int WROW = 136;
    LAS bf16_t* WB = (LAS bf16_t*)lds;
    LAS float* LG = (LAS float*)(lds + 2 * 48 * WROW * 2);
    LAS int* HIST = (LAS int*)(lds + 2 * 48 * WROW * 2 + 128 * 37 * 4);
    int tid = threadIdx.x; asm volatile("" : "+v"(tid));
    const int wave = tid >> 6, lane = tid & 63, fr = lane & 15, kq = lane >> 4;
    const bf16_t* WH = p.WRH + (long)l * 48 * 1024; const bf16_t* WL = p.WRL + (long)l * 48 * 1024;
    if (blockIdx.x == 0 && tid == 0) p.rsB[T_TOK] = 1.0f;
    for (int tile = blockIdx.x; tile < T_TOK / 128; tile += gridDim.x) {
        const long t0 = (long)tile * 128;
        const bf16_t* xrow = p.HB + (t0 + wave * 16 + fr) * DM + kq * 8;
        f32x4 acc[3];
#pragma unroll
        for (int ct = 0; ct < 3; ++ct) acc[ct] = (f32x4){0.f, 0.f, 0.f, 0.f};
        if (tid < 32) HIST[tid] = 0;
        for (int kc = 0; kc < 1024; kc += 128) {
            bf16x8 xv[4];
#pragma unroll
            for (int ks = 0; ks < 4; ++ks) xv[ks] = *(const bf16x8*)(xrow + kc + ks * 32);
            __syncthreads();
#pragma unroll
            for (int i = 0; i < 3; ++i) {
                const int idx = tid + 512 * i, part = idx / 768, rem = idx % 768, row = rem >> 4, piece = rem & 15;
                const u32x4 v = *(const u32x4*)((part ? WL : WH) + (long)row * 1024 + kc + piece * 8);
                *(LAS u32x4*)(WB + (part * 48 + row) * WROW + piece * 8) = v;
            }
            __syncthreads();
#pragma unroll
            for (int ks = 0; ks < 4; ++ks) {
#pragma unroll
                for (int ct = 0; ct < 3; ++ct) {
                    const bf16x8 bh = *(LAS const bf16x8*)(WB + (ct * 16 + fr) * WROW + ks * 32 + kq * 8);
                    const bf16x8 bl = *(LAS const bf16x8*)(WB + (48 + ct * 16 + fr) * WROW + ks * 32 + kq * 8);
                    acc[ct] = __builtin_amdgcn_mfma_f32_16x16x32_bf16(xv[ks], bh, acc[ct], 0, 0, 0);
                    acc[ct] = __builtin_amdgcn_mfma_f32_16x16x32_bf16(xv[ks], bl, acc[ct], 0, 0, 0);
                }
            }
        }
#pragma unroll
        for (int ct = 0; ct < 3; ++ct) {
            const int n = ct * 16 + fr;
            if (n < 36) {
#pragma unroll
                for (int j = 0; j < 4; ++j) LG[(wave * 16 + 4 * kq + j) * 37 + n] = acc[ct][j];
            }
        }
        __syncthreads();
        if (tid < 128) {
            const long t = t0 + tid;
            float ss = 0.f;
#pragma unroll
            for (int i = 0; i < 4; ++i) { const float4 q = *(const float4*)(p.ssq16 + t * 16 + i * 4); ss += (q.x + q.y) + (q.z + q.w); }
            const float r = rsqrtf(ss * (1.0f / DM) + 1e-5f);
            p.rsB[t] = r;
            float gl[4]; int gs = 0; float gmax;
#pragma unroll
            for (int j = 0; j < 4; ++j) gl[j] = LG[tid * 37 + j] * r + p.b_group[l * 4 + j];
            gmax = gl[0];
#pragma unroll
            for (int j = 1; j < 4; ++j) if (gl[j] > gmax) { gmax = gl[j]; gs = j; }
            float den = 0.f;
#pragma unroll
            for (int j = 0; j < 4; ++j) den += __expf(gl[j] - gmax);
            const float gw = 1.0f / den;
            float el[8];
#pragma unroll
            for (int j = 0; j < 8; ++j) el[j] = LG[tid * 37 + 4 + gs * 8 + j] * r + p.b_expert[l * 32 + gs * 8 + j];
            int i0 = 0; float v0 = el[0];
#pragma unroll
            for (int j = 1; j < 8; ++j) if (el[j] > v0) { v0 = el[j]; i0 = j; }
            int i1 = -1; float v1 = NEG_INF;
#pragma unroll
            for (int j = 0; j < 8; ++j) if (j != i0 && (i1 < 0 || el[j] > v1)) { v1 = el[j]; i1 = j; }
            const float ex = __expf(v1 - v0);
            const float w0 = 1.0f / (1.0f + ex), w1 = ex / (1.0f + ex);
            const int e0 = gs * 8 + i0, e1 = gs * 8 + i1;
            p.eid[t * 2] = e0; p.eid[t * 2 + 1] = e1;
            p.ew[t * 2] = w0 * gw; p.ew[t * 2 + 1] = w1 * gw;
            __hip_atomic_fetch_add(HIST + e0, 1, __ATOMIC_RELAXED, __HIP_MEMORY_SCOPE_WORKGROUP);
            __hip_atomic_fetch_add(HIST + e1, 1, __ATOMIC_RELAXED, __HIP_MEMORY_SCOPE_WORKGROUP);
        }
        __syncthreads();
        if (tid < 32) p.cnt_tile[tile * 32 + tid] = HIST[tid];
        __syncthreads();
    }
}
__device__ __forceinline__ void scatter_phase(const Params& p, LAS unsigned char* lds) {
    LAS int* PST = (LAS int*)lds;
    LAS int* CNT = PST + 64;
    LAS int* PRE = PST + 128;
    LAS int* LCN = PST + 192;
    int tid = threadIdx.x; asm volatile("" : "+v"(tid));
    for (int tile = blockIdx.x; tile < T_TOK / 128; tile += gridDim.x) {
        __syncthreads();
        {
            LAS int* RT = PST + 256;
            LAS int* RP = RT + 512;
            const int e = tid & 31, grp = tid >> 5;
            int tot = 0, pre = 0;
#pragma unroll 4
            for (int i = grp; i < T_TOK / 128; i += 16) { const int c = p.cnt_tile[i * 32 + e]; tot += c; pre += (i < tile) ? c : 0; }
            RT[grp * 32 + e] = tot; RP[grp * 32 + e] = pre;
        }
        __syncthreads();
        if (tid < 32) {
            int tot = 0, pre = 0;
#pragma unroll
            for (int gq = 0; gq < 16; ++gq) { tot += PST[256 + gq * 32 + tid]; pre += PST[256 + 512 + gq * 32 + tid]; }
            CNT[tid] = tot; PRE[tid] = pre; LCN[tid] = 0;
        }
        __syncthreads();
        if (tid == 0) { int acc = 0; for (int e = 0; e < 32; ++e) { PST[e] = acc; acc += (CNT[e] + 255) / 256 * 256; } PST[32] = acc; }
        __syncthreads();
        if (tile == 0 && tid == 0) p.ntiles[0] = PST[32] / 256;
        if (tile == 0 && tid < 32) { p.counts[tid] = PST[tid] / 256; p.counts[32 + tid] = (PST[tid + 1] - PST[tid]) / 256; }
        if (tile < 32) {
            const int e = tile, s0 = PST[e], s1 = PST[e + 1], c = CNT[e];
            for (int tI = s0 / 256 + tid; tI < s1 / 256; tI += NTHR) p.tile_e[tI] = e;
            for (int s = s0 + c + tid; s < s1; s += NTHR) { p.toks[s] = T_TOK; p.slotw[s] = 0.f; p.slotdst[s] = -1; }
        }
        if (tid < 256) {
            const int a = tile * 256 + tid;
            const int e = p.eid[a];
            const int lp = __hip_atomic_fetch_add(LCN + e, 1, __ATOMIC_RELAXED, __HIP_MEMORY_SCOPE_WORKGROUP);
            const int s = PST[e] + PRE[e] + lp;
            p.toks[s] = a >> 1; p.slotw[s] = p.ew[a]; p.slotdst[s] = a;
        }
    }
}
template <int WHICH>
__device__ __forceinline__ void moe_stage_units(const Params& p, LAS unsigned char* lds) {
    LAS int* ul = (LAS int*)(lds + LDS_META_OFF);
    LAS int* ia = ul + 64; LAS float* fa = (LAS float*)(ia + 6 * 256);
    int tid = threadIdx.x; asm volatile("" : "+v"(tid));
    const int nt = p.ntiles[0];
    const int W = (int)gridDim.x >> 3, x = (int)blockIdx.x & 7, r = (int)blockIdx.x >> 3;
    int mx = 0;
#pragma unroll
    for (int q = 0; q < 8; ++q) { const int s = p.counts[32 + q] + p.counts[40 + q] + p.counts[48 + q] + p.counts[56 + q]; mx = s > mx ? s : mx; }
    const int rounds_plain = (nt * 4 + (int)gridDim.x - 1) / (int)gridDim.x;
    const bool local = ((int)gridDim.x & 7) == 0 && W > 0 && (mx * 4 + W - 1) / W <= (rounds_plain < 6 ? rounds_plain : 6);
    if (local) {
        const int n0 = p.counts[32 + x], n1 = p.counts[40 + x], n2 = p.counts[48 + x], n3 = p.counts[56 + x], tot = 4 * (n0 + n1 + n2 + n3);
        if (tid < 6) {
            const int j = tid * W + r, jt = j >> 2;
            const bool ok = j < tot;
            int pm = 0;
            if (ok) {
                if (jt < n0) pm = p.counts[x] + jt;
                else if (jt < n0 + n1) pm = p.counts[8 + x] + (jt - n0);
                else if (jt < n0 + n1 + n2) pm = p.counts[16 + x] + (jt - n0 - n1);
                else pm = p.counts[24 + x] + (jt - n0 - n1 - n2);
            }
            ul[2 + 2 * tid] = pm; ul[3 + 2 * tid] = ok ? p.tile_e[pm] * 4 + (j & 3) : 0;
        }
        if (tid == 0) { const int n = tot > r ? (tot - r + W - 1) / W : 0; ul[0] = n > 6 ? 6 : n; }
    } else {
        if (tid < 6) {
            const long L = (long)tid * gridDim.x + blockIdx.x;
            const bool ok = L < (long)nt * 4;
            const int pm = ok ? (int)(L >> 2) : 0;
            ul[2 + 2 * tid] = pm; ul[3 + 2 * tid] = ok ? p.tile_e[pm] * 4 + (int)(L & 3) : 0;
        }
        if (tid == 0) { const long rem = (long)nt * 4 - blockIdx.x; int n = rem > 0 ? (int)((rem + gridDim.x - 1) / gridDim.x) : 0; ul[0] = n > 6 ? 6 : n; }
    }
    __syncthreads();
    const int nu = ul[0];
    for (int e = tid; e < nu * 256; e += NTHR) {
        const int li = e >> 8, r = e & 255, row = ul[2 + 2 * li] * 256 + r;
        if (WHICH == 0) { const int tk = p.toks[row]; ia[e] = tk; fa[e] = p.rsB[tk]; }
        else { ia[e] = p.slotdst[row]; fa[e] = p.slotw[row]; }
    }
    __syncthreads();
}
struct EpiMoe1 {
    static constexpr bool PERM = true;
    const LAS float* rsl; bf16_t* HMID;
    __device__ __forceinline__ void operator()(const AccT& acc, const pg8::Unit& u, int wr, int wc, int fr, int fq) const {
        const int row0 = u.pm * 256 + wr * 64 + fr;
        const int q = u.pn & 3;
        float rr[2][4];
#pragma unroll
        for (int ai = 0; ai < 2; ++ai)
#pragma unroll
            for (int m = 0; m < 4; ++m) rr[ai][m] = rsl[u.li * 256 + wr * 64 + fr + ai * 128 + m * 16];
#pragma unroll
        for (int ai = 0; ai < 2; ++ai)
#pragma unroll
            for (int m = 0; m < 4; ++m) {
                const float r = rr[ai][m];
                float y[8];
#pragma unroll
                for (int j = 0; j < 4; ++j) {
                    const float a0 = acc[ai][0][m][0][j] * r, b0 = acc[ai][1][m][0][j] * r, a1 = acc[ai][0][m][1][j] * r, b1 = acc[ai][1][m][1][j] * r;
                    y[j] = a0 * fast_sigmoid(a0) * b0; y[4 + j] = a1 * fast_sigmoid(a1) * b1;
                }
                u32x4 w; w.x = cvt_pk_bf16(y[0], y[1]); w.y = cvt_pk_bf16(y[2], y[3]); w.z = cvt_pk_bf16(y[4], y[5]); w.w = cvt_pk_bf16(y[6], y[7]);
                *(u32x4*)(HMID + (long)(row0 + ai * 128 + m * 16) * 512 + q * 128 + wc * 32 + fq * 8) = w;
                __builtin_amdgcn_sched_barrier(0);
            }
    }
};
struct EpiMoe2 {
    static constexpr bool PERM = true;
    const LAS int* dstl; const LAS float* wl; bf16_t* YS;
    __device__ __forceinline__ void operator()(const AccT& acc, const pg8::Unit& u, int wr, int wc, int fr, int fq) const {
        const int row0 = u.pm * 256 + wr * 64 + fr;
        const int q = u.pn & 3;
        int dd[2][4]; float ww[2][4];
#pragma unroll
        for (int ai = 0; ai < 2; ++ai)
#pragma unroll
            for (int m = 0; m < 4; ++m) { const int lr = u.li * 256 + wr * 64 + fr + ai * 128 + m * 16; dd[ai][m] = dstl[lr]; ww[ai][m] = wl[lr]; }
#pragma unroll
        for (int ai = 0; ai < 2; ++ai)
#pragma unroll
            for (int m = 0; m < 4; ++m) {
                if (dd[ai][m] >= 0) {
                    const float wv = ww[ai][m];
                    bf16_t* dp = YS + (long)dd[ai][m] * 1024 + q * 256 + wc * 32 + fq * 8;
#pragma unroll
                    for (int bj = 0; bj < 2; ++bj) {
                        const f32x4 v0 = acc[ai][bj][m][0], v1 = acc[ai][bj][m][1];
                        u32x4 w; w.x = cvt_pk_bf16(v0[0] * wv, v0[1] * wv); w.y = cvt_pk_bf16(v0[2] * wv, v0[3] * wv); w.z = cvt_pk_bf16(v1[0] * wv, v1[1] * wv); w.w = cvt_pk_bf16(v1[2] * wv, v1[3] * wv);
                        *(u32x4*)(dp + bj * 128) = w;
                    }
                }
                __builtin_amdgcn_sched_barrier(0);
            }
    }
};

#define FAST_PHASES_2_TO_10 \
        if (IN(2)) { \
            if ((int)blockIdx.x < 32) { \
                pg8::Gemm g{p.KVC, p.CW1T + (size_t)l * 512 * 2048, 2048, 1024, 2048, nullptr}; \
                pg8::CmpOrder S{(int)blockIdx.x}; \
                EpiCmp1 E{p.CB1 + l * 512, p.CHID}; \
                pg8::gemm_phase<EpiCmp1, pg8::CmpOrder, false>(lds, g, S, E); \
                cmp_gemm2(p, l, blockIdx.x); \
                if (l == 0) cvt_fill<0>(p, lds, NCH0, FILL_P2C); \
            } else { \
                  \
                const int nw = (int)gridDim.x - 32; \
                if (__builtin_amdgcn_readfirstlane((int)threadIdx.x) >= 256) __builtin_amdgcn_s_setprio(1);     \
                for (int u = (int)blockIdx.x - 32; u < 1024; u += nw) attn_aw_unit(p, l, (u & 15) >> 1, u & 1, 63 - (u >> 4), lds); \
                __builtin_amdgcn_s_setprio(0); \
                if (l == 0 && (1024 - ((int)blockIdx.x - 32) + nw - 1) / nw < (1024 + nw - 1) / nw) cvt_fill<0>(p, lds, NCH0, FILL_P2A); \
            } \
            GRID_BAR(); \
        } \
        if (IN(3)) { \
            if (__builtin_amdgcn_readfirstlane((int)threadIdx.x) >= 256) __builtin_amdgcn_s_setprio(1); \
            for (int k = blockIdx.x; k < 1024; k += gridDim.x) { \
                const int bgk = k & 15, cg = (k >> 4) & 15, i4 = k >> 8; \
                const int c = (i4 == 0) ? 63 - cg : (i4 == 1) ? 32 + cg : (i4 == 2) ? 31 - cg : cg; \
                attn_cs_unit(p, bgk >> 1, bgk & 1, c, lds); \
            } \
            __builtin_amdgcn_s_setprio(0); \
            GRID_BAR(); \
        } \
        if (IN(4)) { \
            pg8::StaticOrder S; S.init(T_TOK, 1024, gridDim.x, blockIdx.x); \
            { pg8::Gemm g{p.HB, p.WinT + ((size_t)l * 4352 + 2072) * 1024, 1024, 1024, 1024, nullptr}; EpiGate E{p.rsA, p.MERGED}; \
              pg8::gemm_phase<EpiGate, pg8::StaticOrder, false>(lds, g, S, E); } \
            { pg8::Gemm g{p.HB, p.WinT + ((size_t)l * 4352 + 3096) * 1024, 1024, 1024, 1024, nullptr}; EpiGate E{p.rsA, p.TMP2}; \
              pg8::gemm_phase<EpiGate, pg8::StaticOrder, false>(lds, g, S, E); } \
            { pg8::Gemm g{p.OAB, p.WabT + (size_t)l * 1024 * 1024, 1024, 1024, 1024, nullptr}; EpiMerge2 E{p.MERGED, p.TMP2}; \
              pg8::gemm_phase<EpiMerge2, pg8::StaticOrder, false, true>(lds, g, S, E); } \
            GRID_BAR(); \
        } \
        if (IN(5)) { \
            pg8::StaticOrder S; S.init(T_TOK, 1024, gridDim.x, blockIdx.x); \
            pg8::Gemm g{p.MERGED, p.WoutT + (size_t)l * 1024 * 1024, 1024, 1024, 1024, nullptr}; \
            EpiOut E{p.HB, p.ssq16}; \
            pg8::gemm_phase<EpiOut, pg8::StaticOrder, false>(lds, g, S, E); \
            GRID_BAR(); \
        } \
        if (IN(6)) { router_phase(p, l, lds); GRID_BAR(); } \
        if (IN(7)) { if (l == 0) cvt_fill<0>(p, lds, NCH0, 100000); scatter_phase(p, lds); GRID_BAR(); } \
        if (IN(8)) { \
            moe_stage_units<0>(p, lds); \
            LAS int* ul_ = (LAS int*)(lds + LDS_META_OFF); \
            pg8::MoeOrder S{ul_}; \
            pg8::Gemm g{p.HB, l ? p.W13T1 : p.W13T, 1024, 1024, 1024, ul_ + 64}; \
            EpiMoe1 E{(LAS float*)(ul_ + 64 + 6 * 256), p.HMID}; \
            pg8::gemm_phase<EpiMoe1, pg8::MoeOrder, true>(lds, g, S, E); \
            if (l == 0 && ul_[0] < (p.ntiles[0] * 4 + (int)gridDim.x - 1) / (int)gridDim.x) cvt_fill<1>(p, lds, 0, FILL_P8); \
            GRID_BAR(); \
        } \
        if (IN(9)) { \
            moe_stage_units<1>(p, lds); \
            LAS int* ul_ = (LAS int*)(lds + LDS_META_OFF); \
            pg8::MoeOrder S{ul_}; \
            pg8::Gemm g{p.HMID, l ? p.W2T1 : p.W2T, 512, 512, 512, nullptr}; \
            EpiMoe2 E{ul_ + 64, (LAS float*)(ul_ + 64 + 6 * 256), p.YS}; \
            pg8::gemm_phase<EpiMoe2, pg8::MoeOrder, false>(lds, g, S, E); \
            if (l == 0 && ul_[0] < (p.ntiles[0] * 4 + (int)gridDim.x - 1) / (int)gridDim.x) cvt_fill<1>(p, lds, 0, FILL_P9); \
            GRID_BAR(); \
        } \
        if (IN(10)) { \
            if (l == 1) fin_phase<true, true>(p, nullptr, p.norm_final); \
            else { fin_phase<true, false>(p, nullptr, nullptr); cvt_fill<1>(p, lds, 0, 100000); } \
            GRID_BAR(); \
        }
__global__ void __launch_bounds__(NTHR, 2) mega(Params p) {
    extern __shared__ __attribute__((aligned(16))) unsigned char lds_raw[];
    LAS unsigned char* lds = (LAS unsigned char*)lds_raw;
    volatile LAS unsigned* misc = (volatile LAS unsigned*)(lds + LDS_MISC_OFF);
    if (threadIdx.x < 64) misc[threadIdx.x] = 0u;
    build_tables(p, lds);
    const bool multi = (p.ph_hi - p.ph_lo > 1) || (p.l_hi - p.l_lo > 1);
    XcdBarrier bar; bar.bar = p.bar; bar.x = 0; bar.st = misc;
    if (multi) bar = xcd_barrier_post(p.bar, misc);
#define GRID_BAR() do { if (multi) xcd_barrier(bar); } while (0)
#define IN(k) (p.ph_lo <= (k) && (k) < p.ph_hi)

    if (IN(0) && p.l_lo == 0) {
        cvt_phase<0, 8>(p, lds);
        cvt_static<0>(p, lds, NCH0);
        prep_small(p);
        fin_phase<false, false>(p, p.x, nullptr);
        GRID_BAR();
    }
    for (int l = p.l_lo; l < p.l_hi; ++l) {
        if (IN(1)) {
            if (l == 0) cb1_reduce(p);
            pg8::Gemm g{p.HB, p.WinT + (size_t)l * 4352 * 1024, 1024, 1024, 1024, nullptr};
            pg8::StaticOrder S; S.init(T_TOK, 2048, gridDim.x, blockIdx.x);
            EpiProj E{p.rsA, p.QA, p.KA, p.G24};
            pg8::gemm_phase<EpiProj, pg8::StaticOrder, false>(lds, g, S, E);
            gates24_phase(p, l, lds);
            GRID_BAR();
        }
        FAST_PHASES_2_TO_10
    }
#undef IN
#undef GRID_BAR
}

struct HostState { int grid; bool ok; };
static void setup_params(Params& p, void* const* d_in, void* d_out, void* d_ws, size_t ws_size, size_t& used) {
    p.x = (const float*)d_in[0]; p.rel_bias = (const float*)d_in[1]; p.norm_mix = (const float*)d_in[2]; p.w_in = (const float*)d_in[3];
    p.a_sinks = (const float*)d_in[4]; p.cmp_pos_k = (const float*)d_in[5]; p.cmp_w1_k = (const float*)d_in[6]; p.cmp_w2_k = (const float*)d_in[7];
    p.cmp_pos_v = (const float*)d_in[8]; p.cmp_w1_v = (const float*)d_in[9]; p.cmp_w2_v = (const float*)d_in[10];
    p.w_br_a = (const float*)d_in[11]; p.w_br_b = (const float*)d_in[12]; p.w_out = (const float*)d_in[13]; p.norm_ffn = (const float*)d_in[14];
    p.w_group = (const float*)d_in[15]; p.b_group = (const float*)d_in[16]; p.w_expert = (const float*)d_in[17]; p.b_expert = (const float*)d_in[18];
    p.w1 = (const float*)d_in[19]; p.w3 = (const float*)d_in[20]; p.w2 = (const float*)d_in[21]; p.norm_final = (const float*)d_in[22];
    p.out = (float*)d_out;
    char* ws = (char*)d_ws; size_t off = 0;
    auto alloc = [&](size_t bytes) { void* q = ws + off; off += (bytes + 4095) & ~(size_t)4095; return q; };
    p.bar = (unsigned*)alloc(XCD_BAR_WORDS * 4);
    p.counts = (int*)alloc(256); p.cursor = (int*)alloc(256); p.ntiles = (int*)alloc(256); p.tile_e = (int*)alloc(NTILE_MAX * 4 + 256); p.cnt_tile = (int*)alloc((size_t)(T_TOK / 128) * 32 * 4);
    p.rsA = (float*)alloc(T_TOK * 4); p.rsB = (float*)alloc(T_TOK * 4); p.ssq16 = (float*)alloc((size_t)T_TOK * 16 * 4);
    p.HB = (bf16_t*)alloc((size_t)(T_TOK + 256) * DM * 2);
    p.WinT = (bf16_t*)alloc((size_t)2 * 4352 * 1024 * 2);
    p.WabT = (bf16_t*)alloc((size_t)2 * 1024 * 1024 * 2); p.WoutT = (bf16_t*)alloc((size_t)2 * 1024 * 1024 * 2);
    p.CW1T = (bf16_t*)alloc((size_t)2 * 512 * 2048 * 2); p.CW2T = (bf16_t*)alloc((size_t)2 * 2 * 64 * 256 * 2); p.CB1 = (float*)alloc(1024 * 4); p.CBP = (float*)alloc((size_t)512 * 256 * 4);
    p.W13T = (bf16_t*)alloc((size_t)32 * 1024 * 1024 * 2); p.W2T = (bf16_t*)alloc((size_t)32 * 1024 * 512 * 2);
    p.W13T1 = (bf16_t*)d_out; p.W2T1 = p.W13T1 + (size_t)32 * 1024 * 1024;
    p.cvtcur = (int*)(p.bar + 3584);
    p.WRH = (bf16_t*)alloc((size_t)2 * 48 * 1024 * 2); p.WRL = (bf16_t*)alloc((size_t)2 * 48 * 1024 * 2);
    p.eid = (int*)alloc((size_t)T_TOK * 2 * 4); p.ew = (float*)alloc((size_t)T_TOK * 2 * 4);
    p.toks = (int*)alloc((size_t)PMAXF * 4); p.slotw = (float*)alloc((size_t)PMAXF * 4); p.slotdst = (int*)alloc((size_t)PMAXF * 4);
    const size_t region0 = off;
    p.QA = (bf16_t*)alloc((size_t)T_TOK * 512 * 2); p.QB = (bf16_t*)alloc((size_t)T_TOK * 512 * 2);
    {
        const size_t slot = (size_t)16 * SEQ * 64;
        p.KA = (bf16_t*)alloc(8 * slot * 2); p.KVC = p.KA + slot; p.KS = p.KA + 3 * slot; p.KW = p.KA + 4 * slot; p.VAT = p.KA + 5 * slot; p.VST = p.KA + 6 * slot; p.VWT = p.KA + 7 * slot;
    }
    p.G24 = (float*)alloc((size_t)T_TOK * 32 * 4);
    p.CHID = (bf16_t*)alloc((size_t)8192 * 256 * 2); p.KCMP = (bf16_t*)alloc((size_t)16 * 256 * 64 * 2); p.VCMPT = (bf16_t*)alloc((size_t)16 * 64 * 256 * 2);
    p.OAB = (bf16_t*)alloc((size_t)T_TOK * 1024 * 2); p.OW = (bf16_t*)alloc((size_t)T_TOK * 512 * 2);
    p.MERGED = (bf16_t*)alloc((size_t)T_TOK * 1024 * 2);
    const size_t region1 = off;
    p.TMP2 = p.QA;
    p.HMID = (bf16_t*)(ws + region0);
    size_t moe_end = region0 + (((size_t)PMAXF * 512 * 2 + 4095) & ~(size_t)4095);
    p.YS = (bf16_t*)(ws + moe_end); moe_end += (size_t)T_TOK * 2 * 1024 * 2;
    used = (moe_end > region1) ? moe_end : region1;
    (void)ws_size;
    auto task = [&](int i, const float* src, bf16_t* dst, const float* scale, int scstride, int ld, int K, int N, int mapmode, int nb, long ss, long ds, int dld = 0) {
        CvtTask& t = p.cvt[i]; t.dld = dld ? dld : K; t.src = src; t.dst = dst; t.scale = scale; t.scstride = scstride; t.ld = ld; t.K = K; t.N = N; t.mapmode = mapmode; t.nb = nb; t.sstride = ss; t.dstride = ds; };
    task(0, p.w_in, p.WinT, p.norm_mix, 1024, INC, 1024, INC, 0, 2, (long)1024 * INC, (long)4352 * 1024);
    task(1, p.w_br_a, p.WabT, nullptr, 0, 1024, 512, 1024, 0, 2, (long)512 * 1024, (long)1024 * 1024, 1024);
    task(2, p.w_br_b, p.WabT + 512, nullptr, 0, 1024, 512, 1024, 0, 2, (long)512 * 1024, (long)1024 * 1024, 1024);
    task(3, p.w_out, p.WoutT, nullptr, 0, 1024, 1024, 1024, 0, 2, (long)1024 * 1024, (long)1024 * 1024);
    task(4, p.cmp_w1_k, p.CW1T, nullptr, 0, 256, 2048, 256, 0, 2, (long)2048 * 256, (long)512 * 2048);
    task(5, p.cmp_w1_v, p.CW1T + (size_t)256 * 2048, nullptr, 0, 256, 2048, 256, 0, 2, (long)2048 * 256, (long)512 * 2048);
    task(6, p.cmp_w2_k, p.CW2T, nullptr, 0, 64, 256, 64, 0, 2, (long)256 * 64, (long)2 * 64 * 256);
    task(7, p.cmp_w2_v, p.CW2T + (size_t)64 * 256, nullptr, 0, 64, 256, 64, 0, 2, (long)256 * 64, (long)2 * 64 * 256);
}
static HostState& host_state() {
    static HostState hs{0, false};
    if (hs.grid == 0) {
        int dev = 0, cus = 0, per_cu = 0;
        hs.grid = -1;
        if (hipGetDevice(&dev) != hipSuccess) return hs;
        if (hipDeviceGetAttribute(&cus, hipDeviceAttributeMultiprocessorCount, dev) != hipSuccess) return hs;
        if (hipFuncSetAttribute((const void*)mega, hipFuncAttributeMaxDynamicSharedMemorySize, LDS_TOTAL) != hipSuccess) return hs;
        if (hipOccupancyMaxActiveBlocksPerMultiprocessor(&per_cu, (const void*)mega, NTHR, LDS_TOTAL) != hipSuccess || per_cu < 1) { (void)hipGetLastError(); return hs; }
        hs.grid = cus;
        hs.ok = true;
    }
    return hs;
}
static void launch_mega(const Params& base, int ph_lo, int ph_hi, int l_lo, int l_hi, hipStream_t stream) {
    Params p = base; p.ph_lo = ph_lo; p.ph_hi = ph_hi; p.l_lo = l_lo; p.l_hi = l_hi;
    hipLaunchKernelGGL(mega, dim3(host_state().grid), dim3(NTHR), LDS_TOTAL, stream, p);
}
extern "C" void kernel_launch(void* const* d_in, const int* in_sizes, int n_in, void* d_out, int out_size, void* d_ws, size_t ws_size,
                              hipStream_t stream) {
    HostState& hs = host_state();
    if (!hs.ok) return;
    Params P; memset(&P, 0, sizeof(P));
    size_t used = 0;
    setup_params(P, d_in, d_out, d_ws, ws_size, used);
    if (used > ws_size) return;
    (void)in_sizes; (void)n_in; (void)out_size;
    hipMemsetAsync(P.bar, 0, 16384, stream);
    launch_mega(P, 0, 11, 0, 2, stream);
}
```

```cpp
#include <string.h>
#include <hip/hip_runtime.h>
#include <stdint.h>

#define T_TOK 32768
#define SEQ 4096
#define DM 1024
#define INC 4120

__device__ const unsigned char kBucket[128] = {0, 1, 2, 3, 4, 5, 6, 7, 8, 9, 10, 11, 12, 13, 14, 15, 16, 16, 16, 17, 17, 18, 18, 18, 19, 19, 19, 20, 20, 20, 20, 21, 21, 21, 21, 22, 22, 22, 22, 22, 23, 23, 23, 23, 23, 23, 24, 24, 24, 24, 24, 24, 25, 25, 25, 25, 25, 25, 25, 26, 26, 26, 26, 26, 26, 26, 26, 27, 27, 27, 27, 27, 27, 27, 27, 27, 27, 28, 28, 28, 28, 28, 28, 28, 28, 28, 28, 29, 29, 29, 29, 29, 29, 29, 29, 29, 29, 29, 29, 30, 30, 30, 30, 30, 30, 30, 30, 30, 30, 30, 30, 30, 30, 31, 31, 31, 31, 31, 31, 31, 31, 31, 31, 31, 31, 31, 31, 31};

#define LAS __attribute__((address_space(3)))
typedef unsigned short bf16_t;
typedef short bf16x8 __attribute__((ext_vector_type(8)));
typedef float f32x4 __attribute__((ext_vector_type(4)));
typedef float f32x16 __attribute__((ext_vector_type(16)));
typedef unsigned u32x4 __attribute__((ext_vector_type(4)));
typedef unsigned u32x2 __attribute__((ext_vector_type(2)));


typedef unsigned u32x2s __attribute__((ext_vector_type(2)));
__device__ __forceinline__ float half_swap_max(float v) { const u32x2s r = __builtin_amdgcn_permlane32_swap(__float_as_uint(v), __float_as_uint(v), false, false); return fmaxf(__uint_as_float(r.x), __uint_as_float(r.y)); }
__device__ __forceinline__ float half_swap_sum(float v) { const u32x2s r = __builtin_amdgcn_permlane32_swap(__float_as_uint(v), __float_as_uint(v), false, false); return __uint_as_float(r.x) + __uint_as_float(r.y); }
__device__ __forceinline__ float half_other(float v, int hq) { const u32x2s r = __builtin_amdgcn_permlane32_swap(__float_as_uint(v), __float_as_uint(v), false, false); return __uint_as_float(hq ? r.x : r.y); }
template <int M> __device__ __forceinline__ float swz_xor(float v) { return __int_as_float(__builtin_amdgcn_ds_swizzle(__float_as_int(v), (M << 10) | 0x1f)); }
__device__ __forceinline__ float wave_sum_f(float v) {
    v += swz_xor<1>(v); v += swz_xor<2>(v); v += swz_xor<4>(v); v += swz_xor<8>(v); v += swz_xor<16>(v);
    return half_swap_sum(v);
}

#define NTHR 512
#define LDS_STAGE 131072
#define LDS_TAB_OFF 131072
#define LDS_MISC_OFF (131072 + 16384)
#define LDS_META_OFF (131072 + 16384 + 1024)
#define LDS_TOTAL (131072 + 16384 + 1024 + 12544)

#define QSCALE 0.18033688011112042f
#define LOG2E 1.4426950408889634f

__device__ __forceinline__ unsigned cvt_pk_bf16(float lo, float hi) { unsigned r; asm volatile("v_cvt_pk_bf16_f32 %0, %1, %2" : "=v"(r) : "v"(lo), "v"(hi)); return r; }
__device__ __forceinline__ float bf16_to_f(unsigned short b) { return __uint_as_float(((unsigned)b) << 16); }
__device__ __forceinline__ float bf16lo(unsigned w) { return __uint_as_float(w << 16); }
__device__ __forceinline__ float bf16hi(unsigned w) { return __uint_as_float(w & 0xffff0000u); }
__device__ __forceinline__ float fast_sigmoid(float x) { return __builtin_amdgcn_rcpf(1.0f + __builtin_amdgcn_exp2f(-1.4426950408889634f * x)); }

#define XB_TMO      128
#define XB_XCNT(j)  (256  + 64 * (j))
#define XB_XSUB(j)  (1280 + 64 * (j))
#define XB_XGEN(j)  (2304 + 64 * (j))
#define XB_TOP      3328
#define XB_TOPGEN   3392
#define XCD_BAR_WORDS 3456
#define XB_SPIN_CAP (1u << 18)

__device__ __forceinline__ unsigned xb_ld(unsigned* p)              { return __hip_atomic_load(p, __ATOMIC_RELAXED, __HIP_MEMORY_SCOPE_AGENT); }
__device__ __forceinline__ unsigned xb_add(unsigned* p, unsigned v) { return __hip_atomic_fetch_add(p, v, __ATOMIC_RELAXED, __HIP_MEMORY_SCOPE_AGENT); }
__device__ __forceinline__ unsigned xb_xcc_id() { return (unsigned)__builtin_amdgcn_s_getreg((3 << 11) | 20) & 0xFu; }
#define XB_SPIN(cond, bar) do { unsigned _sp = 0; while (cond) { __builtin_amdgcn_s_sleep(1); \
    if ((++_sp & 255u) == 0u) { if (xb_ld(&(bar)[XB_TMO])) break; if (_sp > XB_SPIN_CAP) { atomicAdd(&(bar)[XB_TMO], 1u); break; } } } } while (0)

struct XcdBarrier { unsigned* bar; unsigned x; volatile LAS unsigned* st; };

__device__ __forceinline__ XcdBarrier xcd_barrier_post(unsigned* bar, volatile LAS unsigned* st) {
    XcdBarrier b; b.bar = bar; b.x = xb_xcc_id(); b.st = st;
    if (threadIdx.x == 0) (void)xb_add(&bar[XB_XCNT(b.x)], 1u);
    return b;
}
__device__ __forceinline__ void xcd_barrier_complete(unsigned* bar, unsigned x, unsigned& nloc, unsigned& nx) {
    const unsigned G = gridDim.x * gridDim.y * gridDim.z;
    unsigned sum, cnt, mine, sp = 0u;
    for (;;) {
        sum = 0u; cnt = 0u; mine = 0u;
#pragma unroll
        for (unsigned j = 0; j < 16; ++j) { const unsigned c = xb_ld(&bar[XB_XCNT(j)]); sum += c; cnt += (c > 0u) ? 1u : 0u; mine = (j == x) ? c : mine; }
        if (sum == G) break;
        __builtin_amdgcn_s_sleep(1);
        if ((++sp & 255u) == 0u) { if (xb_ld(&bar[XB_TMO])) break; if (sp > XB_SPIN_CAP) { atomicAdd(&bar[XB_TMO], 1u); break; } }
    }
    nloc = mine > 0u ? mine : 1u; nx = cnt > 0u ? cnt : 1u;
}
__device__ __forceinline__ void xcd_barrier(const XcdBarrier& b) {
    asm volatile("s_waitcnt vmcnt(0)" ::: "memory");
    __syncthreads();
    if (threadIdx.x == 0) {
        unsigned* bar = b.bar;
        __builtin_amdgcn_s_waitcnt(0);
        unsigned nloc = b.st[0], nx = b.st[1];
        if (nloc == 0u) { xcd_barrier_complete(bar, b.x, nloc, nx); b.st[0] = nloc; b.st[1] = nx; }
        const unsigned old = xb_add(&bar[XB_XSUB(b.x)], 1u);
        const unsigned gen = old / nloc;
        if (old + 1u == (gen + 1u) * nloc) {
            __builtin_amdgcn_fence(__ATOMIC_RELEASE, "agent");
            asm volatile("s_waitcnt vmcnt(0)" ::: "memory");
            const unsigned og = xb_add(&bar[XB_TOP], 1u);
            const unsigned tg = og / nx;
            if (og + 1u == (tg + 1u) * nx) xb_add(&bar[XB_TOPGEN], 1u);
            else XB_SPIN(xb_ld(&bar[XB_TOPGEN]) == tg, bar);
            __builtin_amdgcn_fence(__ATOMIC_ACQUIRE, "agent");
            xb_add(&bar[XB_XGEN(b.x)], 1u);
            asm volatile("s_waitcnt vmcnt(0)" ::: "memory");
        } else {
            XB_SPIN(xb_ld(&bar[XB_XGEN(b.x)]) == gen, bar);
            __builtin_amdgcn_fence(__ATOMIC_ACQUIRE, "agent");
            asm volatile("s_waitcnt vmcnt(0)" ::: "memory");
        }
    }
    __syncthreads();
}

struct CvtTask {
    const float* src; bf16_t* dst; const float* scale;
    int ld, K, N, mapmode;
    int dld;
    int nb; int scstride;
    long sstride, dstride;
};
#define NCVT 16
struct Params {
    const float* x; const float* rel_bias; const float* norm_mix; const float* w_in; const float* a_sinks;
    const float* cmp_pos_k; const float* cmp_w1_k; const float* cmp_w2_k; const float* cmp_pos_v; const float* cmp_w1_v; const float* cmp_w2_v;
    const float* w_br_a; const float* w_br_b; const float* w_out; const float* norm_ffn; const float* w_group; const float* b_group;
    const float* w_expert; const float* b_expert; const float* w1; const float* w3; const float* w2; const float* norm_final;
    float* out;
    unsigned* bar;
    int* counts; int* cursor; int* ntiles; int* tile_e; int* cnt_tile;
    float* rsA; float* rsB; float* ssq16;
    bf16_t* HB;
    bf16_t* WinT;
    bf16_t* WabT; bf16_t* WoutT;
    bf16_t* CW1T; bf16_t* CW2T; float* CB1; float* CBP;
    bf16_t* W13T; bf16_t* W2T;
    bf16_t* W13T1; bf16_t* W2T1;
    int* cvtcur;
    bf16_t* WRH; bf16_t* WRL;
    bf16_t* QA; bf16_t* QB;
    bf16_t* KA; bf16_t* KVC; bf16_t* KS; bf16_t* KW;
    bf16_t* VAT; bf16_t* VST; bf16_t* VWT;
    float* G24;
    bf16_t* CHID; bf16_t* KCMP; bf16_t* VCMPT;
    bf16_t* OAB; bf16_t* OW;
    bf16_t* MERGED; bf16_t* TMP2;
    int* eid; float* ew; int* toks; float* slotw; int* slotdst;
    bf16_t* HMID; bf16_t* YS;
    CvtTask cvt[NCVT];
    int ph_lo, ph_hi, l_lo, l_hi;
};
#define PMAXF (65536 + 32 * 256)
#define NTILE_MAX (PMAXF / 256)

__device__ __forceinline__ int cvt_units(const CvtTask& t) { return t.nb * (t.K / 128) * ((t.N + 63) / 64); }
struct CvtRegs { float4 v[2][4]; };
__device__ __forceinline__ void cvt_decode(const CvtTask& t, int u, int& e, int& kt, int& nt) {
    int nkt = t.K / 128, nnt = (t.N + 63) / 64;
    asm volatile("" : "+s"(nkt), "+s"(nnt));
    e = u / (nkt * nnt); const int r = u % (nkt * nnt); kt = r / nnt; nt = r % nnt;
}
__device__ __forceinline__ void cvt_load2(const CvtTask& t, int tid, int ub, int G, int nu, CvtRegs& R) {
#pragma unroll
    for (int q = 0; q < 2; ++q) {
        const int uu = ub + q * G;
#pragma unroll
        for (int i = 0; i < 4; ++i) R.v[q][i] = make_float4(0.f, 0.f, 0.f, 0.f);
        if (uu < nu) {
            int e, kt, nt; cvt_decode(t, uu, e, kt, nt);
            const float* src = t.src + (long)e * t.sstride;
#pragma unroll
            for (int i = 0; i < 4; ++i) {
                const int k = (tid >> 4) + 32 * i, n4 = (tid & 15) * 4;
                const int gk = kt * 128 + k, gn = nt * 64 + n4;
                if (gn < t.N) {
                    float4 v = *(const float4*)(src + (long)gk * t.ld + gn);
                    if (t.scale) { const float s = t.scale[(long)e * t.scstride + gk]; v.x *= s; v.y *= s; v.z *= s; v.w *= s; }
                    R.v[q][i] = v;
                }
            }
        }
    }
}
__device__ __forceinline__ void cvt_store2(const CvtTask& t, int tid, int ub, int G, int nu, const CvtRegs& R, LAS float* tiles  ) {
    __syncthreads();
#pragma unroll
    for (int q = 0; q < 2; ++q)
#pragma unroll
        for (int i = 0; i < 4; ++i) {
            const int k = (tid >> 4) + 32 * i, n4 = (tid & 15) * 4;
            LAS float* tl = tiles + q * (128 * 65) + k * 65 + n4;
            tl[0] = R.v[q][i].x; tl[1] = R.v[q][i].y; tl[2] = R.v[q][i].z; tl[3] = R.v[q][i].w;
        }
    __syncthreads();
    const int n = tid >> 3, ks = (tid & 7) * 16;
#pragma unroll
    for (int q = 0; q < 2; ++q) {
        const int uu = ub + q * G;
        if (uu < nu) {
            int e, kt, nt; cvt_decode(t, uu, e, kt, nt);
            bf16_t* dst = t.dst + (long)e * t.dstride;
            const int gn = nt * 64 + n;
            if (gn < t.N) {
                int drow = gn;
                if (t.mapmode == 1) drow = (gn >> 7) * 256 + (gn & 127);
                else if (t.mapmode == 2) drow = (gn >> 7) * 256 + 128 + (gn & 127);
                const LAS float* tl = tiles + q * (128 * 65) + ks * 65 + n;
                u32x4 w0, w1;
                w0.x = cvt_pk_bf16(tl[0 * 65], tl[1 * 65]); w0.y = cvt_pk_bf16(tl[2 * 65], tl[3 * 65]);
                w0.z = cvt_pk_bf16(tl[4 * 65], tl[5 * 65]); w0.w = cvt_pk_bf16(tl[6 * 65], tl[7 * 65]);
                w1.x = cvt_pk_bf16(tl[8 * 65], tl[9 * 65]); w1.y = cvt_pk_bf16(tl[10 * 65], tl[11 * 65]);
                w1.z = cvt_pk_bf16(tl[12 * 65], tl[13 * 65]); w1.w = cvt_pk_bf16(tl[14 * 65], tl[15 * 65]);
                bf16_t* dp = dst + (long)drow * t.dld + kt * 128 + ks;
                *(u32x4*)dp = w0; *(u32x4*)(dp + 8) = w1;
            }
        }
    }
}
template <int t0, int t1>
__device__ __forceinline__ void cvt_phase(const Params& p, LAS unsigned char* lds) {
    LAS float* tiles = (LAS float*)lds;
    int tid = threadIdx.x; asm volatile("" : "+v"(tid));
    const int G = gridDim.x;
    int base = 0;
#pragma unroll
    for (int ti = t0; ti < t1; ++ti) {
        const CvtTask& t = p.cvt[ti];
        const int nu = cvt_units(t);
        int first = (int)blockIdx.x - (base % G); if (first < 0) first += G;
        CvtRegs A, B;
        if (first < nu) cvt_load2(t, tid, first, G, nu, A);
        for (int ub = first; ub < nu; ub += 2 * G) {
            const int un = ub + 2 * G;
            if (un < nu) cvt_load2(t, tid, un, G, nu, B);
            cvt_store2(t, tid, ub, G, nu, A, tiles);
            A = B;
        }
        base += nu;
    }
    __syncthreads();
}
#define JOB_CHUNKS 768
#define FILL_P1 0
#define FILL_P2C 0
#define FILL_P2A 0
#define FILL_P8 0
#define FILL_P9 0
#define NCH0 (JOB_CHUNKS - (128 * FILL_P1 + 32 * FILL_P2C + 96 * FILL_P2A))
template <int JOB>
__device__ __forceinline__ void cvt_job_chunk(const Params& p, int c, LAS float* tiles, int tid) {
    const int which = c >> 8, u0 = (c & 255) * 8;
    CvtTask t;
    const long eo = (long)JOB * 32 * 1024 * 512;
    const float* src = p.w1; if (which == 1) src = p.w3; if (which == 2) src = p.w2;
    t.src = src + eo;
    t.dst = (which == 2) ? (JOB ? p.W2T1 : p.W2T) : (JOB ? p.W13T1 : p.W13T);
    t.scale = (which == 2) ? nullptr : p.norm_ffn + JOB * 1024; t.scstride = 0;
    t.ld = (which == 2) ? 1024 : 512; t.K = (which == 2) ? 512 : 1024; t.N = (which == 2) ? 1024 : 512;
    t.dld = t.K; t.mapmode = (which == 2) ? 0 : 1 + which; t.nb = 32; t.sstride = (long)1024 * 512; t.dstride = (which == 2) ? (long)1024 * 512 : (long)1024 * 1024;
    CvtRegs A, B;
    cvt_load2(t, tid, u0, 1, 2048, A);
#pragma unroll 1
    for (int s2 = 0; s2 < 4; ++s2) {
        if (s2 < 3) cvt_load2(t, tid, u0 + 2 * (s2 + 1), 1, 2048, B);
        cvt_store2(t, tid, u0 + 2 * s2, 1, 2048, A, tiles);
        A = B;
    }
}
template <int JOB>
__device__ __forceinline__ void cvt_fill(const Params& p, LAS unsigned char* lds, int base, int max_chunks) {
    int tid = threadIdx.x; asm volatile("" : "+v"(tid));
    volatile LAS unsigned* slot = (volatile LAS unsigned*)(lds + LDS_MISC_OFF) + 32;
#pragma unroll 1
    for (int n = 0; n < max_chunks; ++n) {
        __syncthreads();
        if (tid == 0) *slot = (unsigned)__hip_atomic_fetch_add(p.cvtcur + JOB, 1, __ATOMIC_RELAXED, __HIP_MEMORY_SCOPE_AGENT);
        __syncthreads();
        const int c = base + __builtin_amdgcn_readfirstlane((int)*slot);
        if (c >= JOB_CHUNKS) break;
        cvt_job_chunk<JOB>(p, c, (LAS float*)lds, tid);
    }
    __syncthreads();
}
template <int JOB>
__device__ __forceinline__ void cvt_static(const Params& p, LAS unsigned char* lds, int n) {
    int tid = threadIdx.x; asm volatile("" : "+v"(tid));
#pragma unroll 1
    for (int c = blockIdx.x; c < n; c += gridDim.x) cvt_job_chunk<JOB>(p, c, (LAS float*)lds, tid);
    __syncthreads();
}
__device__ __forceinline__ void prep_small(const Params& p) {
    const int gtid = blockIdx.x * NTHR + threadIdx.x, gn = gridDim.x * NTHR;
    for (int i = gtid; i < 2 * 48 * 1024; i += gn) {
        const int l = i / (48 * 1024), r = i % (48 * 1024), n = r >> 10, k = r & 1023;
        float w = 0.f;
        if (n < 36) {
            const float g = p.norm_ffn[l * 1024 + k];
            w = g * ((n < 4) ? p.w_group[((long)l * 1024 + k) * 4 + n] : p.w_expert[((long)l * 1024 + k) * 32 + (n - 4)]);
        }
        const __bf16 hi = (__bf16)w; const __bf16 lo = (__bf16)(w - (float)hi);
        p.WRH[i] = __builtin_bit_cast(unsigned short, hi); p.WRL[i] = __builtin_bit_cast(unsigned short, lo);
    }
    for (int w = blockIdx.x; w < 256; w += gridDim.x) {
        const int cmb = w >> 6, sl = w & 63, l = cmb >> 1, kv = cmb & 1, n = threadIdx.x & 255, kh = threadIdx.x >> 8;
        const float* pos = (kv ? p.cmp_pos_v : p.cmp_pos_k) + (long)l * 2048 + sl * 32 + kh * 16;
        const float* wt = (kv ? p.cmp_w1_v : p.cmp_w1_k) + ((long)l * 2048 + sl * 32 + kh * 16) * 256 + n;
        float sacc = 0.f;
#pragma unroll
        for (int i = 0; i < 16; ++i) sacc = fmaf(pos[i], wt[(long)i * 256], sacc);
        p.CBP[((long)w * 2 + kh) * 256 + n] = sacc;
    }
    for (int i = gtid; i < 256 * 1024 / 8; i += gn) ((u32x4*)(p.HB + (long)T_TOK * DM))[i] = (u32x4){0u, 0u, 0u, 0u};
}

__device__ __forceinline__ void cb1_reduce(const Params& p) {
    const int wave = threadIdx.x >> 6, lane = threadIdx.x & 63;
    if (wave < 4) {
        for (int o = blockIdx.x * 4 + wave; o < 1024; o += gridDim.x * 4) {
            const int cmb = o >> 8, n = o & 255;
            const float* pp = p.CBP + ((long)cmb * 128) * 256 + n;
            float v = pp[(long)lane * 256] + pp[(long)(lane + 64) * 256];
            v = wave_sum_f(v);
            if (lane == 0) p.CB1[o] = v;
        }
    }
}
template <bool ADD_YS, bool LAST>
__device__ __forceinline__ void fin_phase(const Params& p, const float* hin, const float* gfinal) {
    int tid = threadIdx.x; asm volatile("" : "+v"(tid));
    const int wave = tid >> 6, lane = tid & 63;
    for (int row0 = (blockIdx.x * 8 + wave) * 2; row0 < T_TOK; row0 += gridDim.x * 16) {
        float v[2][2][8]; u32x4 ya[2][2], yb[2][2], hb[2][2];
#pragma unroll
        for (int q = 0; q < 2; ++q)
#pragma unroll
            for (int i = 0; i < 2; ++i) {
                if (ADD_YS) {
                    hb[q][i] = *(const u32x4*)(p.HB + (long)(row0 + q) * DM + i * 512 + lane * 8);
                    ya[q][i] = *(const u32x4*)(p.YS + ((long)(row0 + q) * 2) * DM + i * 512 + lane * 8);
                    yb[q][i] = *(const u32x4*)(p.YS + ((long)(row0 + q) * 2 + 1) * DM + i * 512 + lane * 8);
                } else {
                    const float4 a = *(const float4*)(hin + (long)(row0 + q) * DM + i * 512 + lane * 8), c = *(const float4*)(hin + (long)(row0 + q) * DM + i * 512 + lane * 8 + 4);
                    v[q][i][0] = a.x; v[q][i][1] = a.y; v[q][i][2] = a.z; v[q][i][3] = a.w; v[q][i][4] = c.x; v[q][i][5] = c.y; v[q][i][6] = c.z; v[q][i][7] = c.w;
                }
            }
#pragma unroll
        for (int q = 0; q < 2; ++q) {
            const int row = row0 + q;
            if (ADD_YS) {
#pragma unroll
                for (int i = 0; i < 2; ++i) {
                    const unsigned hw[4] = {hb[q][i].x, hb[q][i].y, hb[q][i].z, hb[q][i].w}, aw[4] = {ya[q][i].x, ya[q][i].y, ya[q][i].z, ya[q][i].w}, bw[4] = {yb[q][i].x, yb[q][i].y, yb[q][i].z, yb[q][i].w};
#pragma unroll
                    for (int j = 0; j < 4; ++j) {
                        v[q][i][2 * j] = bf16lo(hw[j]) + (bf16lo(aw[j]) + bf16lo(bw[j]));
                        v[q][i][2 * j + 1] = bf16hi(hw[j]) + (bf16hi(aw[j]) + bf16hi(bw[j]));
                    }
                }
            }
            float s = 0.f;
#pragma unroll
            for (int i = 0; i < 2; ++i)
#pragma unroll
                for (int j = 0; j < 8; ++j) s += v[q][i][j] * v[q][i][j];
            s = wave_sum_f(s);
            const float r = rsqrtf(s * (1.0f / DM) + 1e-5f);
            if (LAST) {
#pragma unroll
                for (int i = 0; i < 2; ++i) {
                    const float4 g0 = *(const float4*)(gfinal + i * 512 + lane * 8), g1 = *(const float4*)(gfinal + i * 512 + lane * 8 + 4);
                    float4 o0, o1;
                    o0.x = v[q][i][0] * r * g0.x; o0.y = v[q][i][1] * r * g0.y; o0.z = v[q][i][2] * r * g0.z; o0.w = v[q][i][3] * r * g0.w;
                    o1.x = v[q][i][4] * r * g1.x; o1.y = v[q][i][5] * r * g1.y; o1.z = v[q][i][6] * r * g1.z; o1.w = v[q][i][7] * r * g1.w;
                    *(float4*)(p.out + (long)row * DM + i * 512 + lane * 8) = o0; *(float4*)(p.out + (long)row * DM + i * 512 + lane * 8 + 4) = o1;
                }
            } else {
#pragma unroll
                for (int i = 0; i < 2; ++i) {
                    u32x4 w; w.x = cvt_pk_bf16(v[q][i][0], v[q][i][1]); w.y = cvt_pk_bf16(v[q][i][2], v[q][i][3]); w.z = cvt_pk_bf16(v[q][i][4], v[q][i][5]); w.w = cvt_pk_bf16(v[q][i][6], v[q][i][7]);
                    *(u32x4*)(p.HB + (long)row * DM + i * 512 + lane * 8) = w;
                }
                if (lane == 0) p.rsA[row] = r;
            }
        }
    }
}

namespace pg8 {
constexpr int BM = 256, BK = 64, HALF = 128, HTB = HALF * BK * 2, STAGE_BYTES = 8 * HTB, NXCD = 8, WGM = 8;
__host__ __device__ __forceinline__ int lds_byte(int r, int c) { const int st = (r >> 4) * 2 + (c >> 5), rr = r & 15, cc = c & 31, ob = rr * 64 + cc * 2; return st * 1024 + (ob ^ (((ob >> 9) & 1) << 5)); }
__host__ __device__ __forceinline__ void stage_rc(int b, int& R, int& C) { const int st = b / 1024, sb = b % 1024, swz = sb ^ (((sb >> 9) & 1) << 5); R = (st >> 1) * 16 + swz / 64; C = (st & 1) * 32 + (swz % 64) / 2; }
__host__ __device__ __forceinline__ int perm32(int rho) { const int n = rho >> 4, i = rho & 15; return 8 * (i >> 2) + 4 * n + (i & 3); }

struct Unit { int pm, pn, li; };
struct Gemm { const bf16_t* A; const bf16_t* Bt; int K, lda, ldb; const LAS int* gather; };

struct StaticOrder {
    int nM, nN, nwg, G, c;
    __device__ void init(int M, int N, int G_, int c_) { nM = M / BM; nN = N / BM; nwg = nM * nN; G = G_; c = c_; }
    __device__ bool next(int i, Unit& u) const {
        const long L = (long)i * G + c; if (L >= nwg) return false;
        int wgid = (int)L; { const int q = nwg / NXCD, r = nwg % NXCD, xcd = wgid % NXCD, off = wgid / NXCD; wgid = (xcd < r ? xcd * (q + 1) : r * (q + 1) + (xcd - r) * q) + off; }
        const int nig = WGM * nN, gid = wgid / nig, fm = gid * WGM, gsz = (nM - fm) < WGM ? (nM - fm) : WGM;
        u.pm = fm + ((wgid % nig) % gsz); u.pn = (wgid % nig) / gsz; u.li = 0; return true;
    }
};
struct CmpOrder {
    int c;
    __device__ bool next(int i, Unit& u) const { if (i > 0 || c >= 32) return false; u.pm = c; u.pn = c >> 4; u.li = 0; return true; }
};
struct MoeOrder {
    const LAS int* ul;
    __device__ bool next(int i, Unit& u) const {
        if (i >= ul[0]) return false;
        u.pm = ul[2 + 2 * i]; u.pn = ul[3 + 2 * i]; u.li = i; return true;
    }
};

template <class Epi, class Sched, bool GATHER, bool MID = false>
__device__ __forceinline__ void gemm_phase(LAS unsigned char* lds, const Gemm g, const Sched& S, const Epi& E) {
    int tid = threadIdx.x;
    asm volatile("" : "+v"(tid));
    const int wid = __builtin_amdgcn_readfirstlane(tid >> 6), lane = tid & 63, wr = wid >> 2, wc = wid & 3, fr = lane & 15, fq = lane >> 4;
    const int K = g.K, nt = K / BK;
    unsigned voffA[2], voffB[2];
#pragma unroll
    for (int i = 0; i < 2; ++i) { int R, C; stage_rc(tid * 16 + i * 8192, R, C); const int Rb = Epi::PERM ? ((R & ~31) + perm32(R & 31)) : R;
        voffA[i] = (unsigned)(R * g.lda + C) * 2u; voffB[i] = (unsigned)(Rb * g.ldb + C) * 2u; }
    const size_t kstep = (size_t)(BK * 2);
    const size_t hstepA = (size_t)HALF * g.lda * 2, tstepA = 2 * hstepA;
    const size_t hstepB = (size_t)HALF * g.ldb * 2, tstepB = 2 * hstepB;
    const unsigned ldsw = (unsigned)wid * 1024u;
    const int aoff = lds_byte(wr * 64 + fr, fq * 8), boff = lds_byte(wc * 32 + fr, fq * 8);
#define PG8_SA(b, h) (((b) * 2 + (h)) * HTB)
#define PG8_SB(b, h) ((4 + (b) * 2 + (h)) * HTB)
#define PG8_STAGE(bufoff, gbase, voff) do { _Pragma("unroll") for (int _i = 0; _i < 2; ++_i) \
        __builtin_amdgcn_global_load_lds((const unsigned*)((const char*)(gbase) + (voff)[_i]), (LAS unsigned*)(lds + (bufoff) + ldsw + _i * 8192), 16, 0, 0); } while (0)
#define PG8_STAGEG(bufoff, kb, o0, o1) do { \
        __builtin_amdgcn_global_load_lds((const unsigned*)((const char*)g.A + (kb) + (o0)), (LAS unsigned*)(lds + (bufoff) + ldsw), 16, 0, 0); \
        __builtin_amdgcn_global_load_lds((const unsigned*)((const char*)g.A + (kb) + (o1)), (LAS unsigned*)(lds + (bufoff) + ldsw + 8192), 16, 0, 0); } while (0)
#define PG8_STAGEA_CUR(bufoff, kb, h) do { if constexpr (GATHER) { PG8_STAGEG(bufoff, kb, oc[h][0], oc[h][1]); } else { PG8_STAGE(bufoff, cA + (kb) + (h) * hstepA, voffA); } } while (0)
#define PG8_STAGEA_SEL(bufoff, kb, h) do { if constexpr (GATHER) { PG8_STAGEG(bufoff, kb, (last ? on[h][0] : oc[h][0]), (last ? on[h][1] : oc[h][1])); } else { PG8_STAGE(bufoff, a2b + (kb) + (h) * hstepA, voffA); } } while (0)
#define PG8_LDA(dst, b, h) do { _Pragma("unroll") for (int m = 0; m < 4; ++m) _Pragma("unroll") for (int k = 0; k < 2; ++k) dst[m][k] = *(const LAS bf16x8*)(lds + PG8_SA(b, h) + aoff + m * 2048 + k * 1024); } while (0)
#define PG8_LDB(dst, b, h) do { _Pragma("unroll") for (int n = 0; n < 2; ++n) _Pragma("unroll") for (int k = 0; k < 2; ++k) dst[n][k] = *(const LAS bf16x8*)(lds + PG8_SB(b, h) + boff + n * 2048 + k * 1024); } while (0)
#define PG8_MMA(ai, bj, At, Bt) do { __builtin_amdgcn_s_setprio(1); _Pragma("unroll") for (int m = 0; m < 4; ++m) _Pragma("unroll") for (int n = 0; n < 2; ++n) _Pragma("unroll") for (int k = 0; k < 2; ++k) \
        acc[ai][bj][m][n] = __builtin_amdgcn_mfma_f32_16x16x32_bf16(Bt[n][k], At[m][k], acc[ai][bj][m][n], 0, 0, 0); __builtin_amdgcn_s_setprio(0); } while (0)
#define PG8_WAIT_V(n) asm volatile("s_waitcnt vmcnt(" #n ")" ::: "memory")
#define PG8_WAIT_L(n) asm volatile("s_waitcnt lgkmcnt(" #n ")" ::: "memory")
#define PG8_BAR __builtin_amdgcn_s_barrier()
#define PG8_SCHED __builtin_amdgcn_sched_barrier(0)
#define PG8_AOFF(dst, U) do { _Pragma("unroll") for (int _h = 0; _h < 2; ++_h) _Pragma("unroll") for (int _i = 0; _i < 2; ++_i) { \
        int _R, _C; stage_rc(tid * 16 + _i * 8192, _R, _C); const int _gr = g.gather[(U).li * BM + _h * HALF + _R]; \
        dst[_h][_i] = (unsigned)((_gr * g.lda + _C) * 2); } } while (0)
    Unit cur, nxt; int ui = 0;
    if (!S.next(0, cur)) return;
    f32x4 acc[2][2][4][2];
#pragma unroll
    for (int a = 0; a < 2; ++a)
#pragma unroll
        for (int b = 0; b < 2; ++b)
#pragma unroll
            for (int m = 0; m < 4; ++m)
#pragma unroll
                for (int n = 0; n < 2; ++n) acc[a][b][m][n] = (f32x4){0.f, 0.f, 0.f, 0.f};
    bf16x8 At[4][2], B0[2][2], B1[2][2];
    unsigned oc[2][2] = {{0u, 0u}, {0u, 0u}}, on[2][2] = {{0u, 0u}, {0u, 0u}};
    if constexpr (GATHER) { PG8_AOFF(oc, cur); }
    const char* cA = (const char*)g.A + (GATHER ? (size_t)0 : (size_t)cur.pm * tstepA);
    const char* cB = (const char*)g.Bt + (size_t)cur.pn * tstepB;
    PG8_STAGE(PG8_SB(0, 0), cB, voffB); PG8_STAGEA_CUR(PG8_SA(0, 0), 0, 0); PG8_STAGE(PG8_SB(0, 1), cB + hstepB, voffB); PG8_STAGEA_CUR(PG8_SA(0, 1), 0, 1);
    if (wr == 1) PG8_BAR;
    PG8_WAIT_V(4); PG8_BAR;
    PG8_STAGE(PG8_SB(1, 0), cB + kstep, voffB); PG8_STAGEA_CUR(PG8_SA(1, 0), kstep, 0); PG8_STAGE(PG8_SB(1, 1), cB + hstepB + kstep, voffB);
    PG8_WAIT_V(6); PG8_BAR;
    for (;;) {
        const bool has_next = S.next(ui + 1, nxt);
        if constexpr (GATHER) { if (has_next) { PG8_AOFF(on, nxt); } else { on[0][0] = oc[0][0]; on[0][1] = oc[0][1]; on[1][0] = oc[1][0]; on[1][1] = oc[1][1]; } }
        const char* nA = (has_next && !GATHER) ? (const char*)g.A + (size_t)nxt.pm * tstepA : cA;
        const char* nB = has_next ? (const char*)g.Bt + (size_t)nxt.pn * tstepB : cB;
        for (int t = 0; t < nt; t += 2) {
            if constexpr (MID) { if (t == nt / 2) E.mid(acc, cur, wr, wc, fr, fq); }
            const bool last = (t == nt - 2);
            const size_t k1 = (size_t)(t + 1) * kstep;
            const size_t k2 = last ? 0 : (size_t)(t + 2) * kstep, k3 = k2 + kstep;
            const char* a2b = last ? nA : cA;
            const char* b2 = last ? nB : cB + (size_t)(t + 2) * kstep; const char* b3 = b2 + kstep;
            PG8_LDB(B0, 0, 0); PG8_SCHED; PG8_LDA(At, 0, 0); PG8_STAGEA_CUR(PG8_SA(1, 1), k1, 1);
            PG8_WAIT_L(8); PG8_BAR; PG8_WAIT_L(0); PG8_MMA(0, 0, At, B0); PG8_BAR; PG8_SCHED;
            PG8_LDB(B1, 0, 1); PG8_STAGE(PG8_SB(0, 0), b2, voffB);
            PG8_BAR; PG8_WAIT_L(0); PG8_MMA(0, 1, At, B1); PG8_BAR;
            PG8_LDA(At, 0, 1); PG8_STAGEA_SEL(PG8_SA(0, 0), k2, 0);
            PG8_BAR; PG8_WAIT_L(0); PG8_MMA(1, 0, At, B0); PG8_BAR; PG8_SCHED;
            PG8_STAGE(PG8_SB(0, 1), b2 + hstepB, voffB);
            PG8_WAIT_V(6); PG8_BAR; PG8_MMA(1, 1, At, B1); PG8_BAR;
            PG8_LDB(B0, 1, 0); PG8_SCHED; PG8_LDA(At, 1, 0); PG8_STAGEA_SEL(PG8_SA(0, 1), k2, 1);
            PG8_WAIT_L(8); PG8_BAR; PG8_WAIT_L(0); PG8_MMA(0, 0, At, B0); PG8_BAR; PG8_SCHED;
            PG8_LDB(B1, 1, 1); PG8_STAGE(PG8_SB(1, 0), b3, voffB);
            PG8_BAR; PG8_WAIT_L(0); PG8_MMA(0, 1, At, B1); PG8_BAR;
            PG8_LDA(At, 1, 1); PG8_STAGEA_SEL(PG8_SA(1, 0), k3, 0);
            PG8_BAR; PG8_WAIT_L(0); PG8_MMA(1, 0, At, B0); PG8_BAR; PG8_SCHED;
            PG8_STAGE(PG8_SB(1, 1), b3 + hstepB, voffB);
            PG8_WAIT_V(6); PG8_BAR; PG8_MMA(1, 1, At, B1); PG8_BAR;
        }
        E(acc, cur, wr, wc, fr, fq);
        if (!has_next) break;
#pragma unroll
        for (int a = 0; a < 2; ++a)
#pragma unroll
            for (int b = 0; b < 2; ++b)
#pragma unroll
                for (int m = 0; m < 4; ++m)
#pragma unroll
                    for (int n = 0; n < 2; ++n) acc[a][b][m][n] = (f32x4){0.f, 0.f, 0.f, 0.f};
        cur = nxt; cA = nA; cB = nB; ++ui;
        if constexpr (GATHER) { oc[0][0] = on[0][0]; oc[0][1] = on[0][1]; oc[1][0] = on[1][0]; oc[1][1] = on[1][1]; }
    }
    PG8_WAIT_V(0);
    if (wr == 0) PG8_BAR;
    PG8_BAR;
#undef PG8_SA
#undef PG8_SB
#undef PG8_STAGE
#undef PG8_STAGEG
#undef PG8_STAGEA_CUR
#undef PG8_STAGEA_SEL
#undef PG8_LDA
#undef PG8_LDB
#undef PG8_MMA
#undef PG8_WAIT_V
#undef PG8_WAIT_L
#undef PG8_BAR
#undef PG8_SCHED
#undef PG8_AOFF
}
}

typedef f32x4 AccT[2][2][4][2];

struct EpiProj {
    static constexpr bool PERM = true;
    const float* rs; bf16_t* QA; bf16_t* KA; float* G24;
    __device__ __forceinline__ void operator()(const AccT& acc, const pg8::Unit& u, int wr, int wc, int fr, int fq) const {
        const int row0 = u.pm * 256 + wr * 64 + fr;
        const int pn = u.pn;
        float rr[2][4];
#pragma unroll
        for (int ai = 0; ai < 2; ++ai)
#pragma unroll
            for (int m = 0; m < 4; ++m) rr[ai][m] = rs[row0 + ai * 128 + m * 16];
        if (pn == 0 || pn == 1 || pn == 3 || pn == 4) {
            bf16_t* Q = QA + (long)((pn >= 3) ? 1 : 0) * T_TOK * 512 + ((pn == 1 || pn == 4) ? 256 : 0) + wc * 32 + fq * 8;
#pragma unroll
            for (int ai = 0; ai < 2; ++ai)
#pragma unroll
                for (int m = 0; m < 4; ++m) {
                    const int row = row0 + ai * 128 + m * 16;
                    const float sc = rr[ai][m] * QSCALE;
#pragma unroll
                    for (int bj = 0; bj < 2; ++bj) {
                        const f32x4 v0 = acc[ai][bj][m][0], v1 = acc[ai][bj][m][1];
                        u32x4 w; w.x = cvt_pk_bf16(v0[0] * sc, v0[1] * sc); w.y = cvt_pk_bf16(v0[2] * sc, v0[3] * sc); w.z = cvt_pk_bf16(v1[0] * sc, v1[1] * sc); w.w = cvt_pk_bf16(v1[2] * sc, v1[3] * sc);
                        *(u32x4*)(Q + (long)row * 512 + bj * 128) = w;
                    }
                    __builtin_amdgcn_sched_barrier(0);
                }
        } else if (pn == 8) {
            if (wc == 0 && fq < 3) {
#pragma unroll
                for (int ai = 0; ai < 2; ++ai)
#pragma unroll
                    for (int m = 0; m < 4; ++m) {
                        const int row = row0 + ai * 128 + m * 16;
                        const float r = rr[ai][m];
                        const f32x4 v0 = acc[ai][0][m][0], v1 = acc[ai][0][m][1];
                        float* gp = G24 + (long)row * 32 + fq * 8;
                        *(f32x4*)gp = (f32x4){fast_sigmoid(v0[0] * r), fast_sigmoid(v0[1] * r), fast_sigmoid(v0[2] * r), fast_sigmoid(v0[3] * r)};
                        *(f32x4*)(gp + 4) = (f32x4){fast_sigmoid(v1[0] * r), fast_sigmoid(v1[1] * r), fast_sigmoid(v1[2] * r), fast_sigmoid(v1[3] * r)};
                        __builtin_amdgcn_sched_barrier(0);
                    }
            }
        } else {
            const int g = wc >> 1, d0 = (wc & 1) * 32 + fq * 8;
            const int kslot = (pn == 2) ? 0 : (pn == 5) ? 1 : (pn - 3), vslot = (pn == 2) ? 5 : (pn == 5) ? 2 : pn;
            bf16_t* Kd = KA + (long)kslot * (16 * SEQ * 64) + (long)g * SEQ * 64 + d0;
            bf16_t* Vd = KA + (long)vslot * (16 * SEQ * 64);
            Vd += (pn == 5) ? ((long)g * SEQ * 64 + d0) : ((long)(g * 64 + d0) * SEQ);
#pragma unroll
            for (int ai = 0; ai < 2; ++ai)
#pragma unroll
                for (int m = 0; m < 4; ++m) {
                    const int row = row0 + ai * 128 + m * 16;
                    const float r = rr[ai][m];
                    const int b = row >> 12, s = row & 4095;
                    {
                        const f32x4 v0 = acc[ai][0][m][0], v1 = acc[ai][0][m][1];
                        u32x4 w; w.x = cvt_pk_bf16(v0[0] * r, v0[1] * r); w.y = cvt_pk_bf16(v0[2] * r, v0[3] * r); w.z = cvt_pk_bf16(v1[0] * r, v1[1] * r); w.w = cvt_pk_bf16(v1[2] * r, v1[3] * r);
                        *(u32x4*)(Kd + ((long)b * 2 * SEQ + s) * 64) = w;
                    }
                    const f32x4 v0 = acc[ai][1][m][0], v1 = acc[ai][1][m][1];
                    if (pn == 5) {
                        u32x4 w; w.x = cvt_pk_bf16(v0[0] * r, v0[1] * r); w.y = cvt_pk_bf16(v0[2] * r, v0[3] * r); w.z = cvt_pk_bf16(v1[0] * r, v1[1] * r); w.w = cvt_pk_bf16(v1[2] * r, v1[3] * r);
                        *(u32x4*)(Vd + ((long)b * 2 * SEQ + s) * 64) = w;
                    } else {
                        bf16_t* vp = Vd + (long)b * 2 * 64 * SEQ + s;
#pragma unroll
                        for (int j = 0; j < 4; ++j) {
                            vp[(long)j * SEQ] = (bf16_t)(cvt_pk_bf16(v0[j] * r, 0.f) & 0xffffu);
                            vp[(long)(4 + j) * SEQ] = (bf16_t)(cvt_pk_bf16(v1[j] * r, 0.f) & 0xffffu);
                        }
                    }
                    __builtin_amdgcn_sched_barrier(0);
                }
        }
    }
};
struct EpiCmp1 {
    static constexpr bool PERM = true;
    const float* cb1; bf16_t* CHID;
    __device__ __forceinline__ void operator()(const AccT& acc, const pg8::Unit& u, int wr, int wc, int fr, int fq) const {
        const int row0 = u.pm * 256 + wr * 64 + fr;
        const float* cb = cb1 + u.pn * 256 + wc * 32 + fq * 8;
#pragma unroll
        for (int bj = 0; bj < 2; ++bj) {
            const f32x4 b0 = *(const f32x4*)(cb + bj * 128), b1 = *(const f32x4*)(cb + bj * 128 + 4);
#pragma unroll
            for (int ai = 0; ai < 2; ++ai)
#pragma unroll
                for (int m = 0; m < 4; ++m) {
                    const int row = row0 + ai * 128 + m * 16;
                    float y[8];
#pragma unroll
                    for (int j = 0; j < 4; ++j) { y[j] = acc[ai][bj][m][0][j] + b0[j]; y[4 + j] = acc[ai][bj][m][1][j] + b1[j]; }
#pragma unroll
                    for (int j = 0; j < 8; ++j) { const float x = y[j]; const float uu = 0.7978845608028654f * (x + 0.044715f * x * x * x); y[j] = x * fast_sigmoid(2.0f * uu); }
                    u32x4 w; w.x = cvt_pk_bf16(y[0], y[1]); w.y = cvt_pk_bf16(y[2], y[3]); w.z = cvt_pk_bf16(y[4], y[5]); w.w = cvt_pk_bf16(y[6], y[7]);
                    *(u32x4*)(CHID + (long)row * 256 + bj * 128 + wc * 32 + fq * 8) = w;
                    __builtin_amdgcn_sched_barrier(0);
                }
        }
    }
};
__device__ __forceinline__ void cmp_gemm2(const Params& p, int l, int pm) {
    asm volatile("s_waitcnt vmcnt(0)" ::: "memory");
    __syncthreads();
    __builtin_amdgcn_fence(__ATOMIC_ACQUIRE, "agent");
    asm volatile("s_waitcnt vmcnt(0)" ::: "memory");
    int tid = threadIdx.x; asm volatile("" : "+v"(tid));
    const int wave = tid >> 6, lane = tid & 63, fr = lane & 15, fq = lane >> 4;
    const int kv = pm >> 4, bg = pm & 15;
    const bf16_t* A = p.CHID + ((long)pm * 256 + wave * 32) * 256;
    const bf16_t* Bt = p.CW2T + ((long)(l * 2 + kv) * 64) * 256;
    f32x4 acc[2][4];
#pragma unroll
    for (int rt = 0; rt < 2; ++rt)
#pragma unroll
        for (int ct = 0; ct < 4; ++ct) acc[rt][ct] = (f32x4){0.f, 0.f, 0.f, 0.f};
#pragma unroll
    for (int ks = 0; ks < 8; ++ks) {
        bf16x8 af[2], bf[4];
#pragma unroll
        for (int rt = 0; rt < 2; ++rt) af[rt] = *(const bf16x8*)(A + (long)(rt * 16 + fr) * 256 + ks * 32 + fq * 8);
#pragma unroll
        for (int ct = 0; ct < 4; ++ct) bf[ct] = *(const bf16x8*)(Bt + (long)(ct * 16 + fr) * 256 + ks * 32 + fq * 8);
#pragma unroll
        for (int rt = 0; rt < 2; ++rt)
#pragma unroll
            for (int ct = 0; ct < 4; ++ct) acc[rt][ct] = __builtin_amdgcn_mfma_f32_16x16x32_bf16(af[rt], bf[ct], acc[rt][ct], 0, 0, 0);
    }
#pragma unroll
    for (int rt = 0; rt < 2; ++rt)
#pragma unroll
        for (int ct = 0; ct < 4; ++ct) {
            const int n = ct * 16 + fr, i0 = wave * 32 + rt * 16 + 4 * fq;
            f32x4 v = acc[rt][ct];
            if (i0 + 3 == 255) v[3] = 0.f;
            if (kv == 0) {
#pragma unroll
                for (int j = 0; j < 4; ++j) p.KCMP[((long)bg * 256 + i0 + j) * 64 + n] = (bf16_t)(cvt_pk_bf16(v[j], 0.f) & 0xffffu);
            } else {
                u32x2 w; w.x = cvt_pk_bf16(v[0], v[1]); w.y = cvt_pk_bf16(v[2], v[3]);
                *(u32x2*)(p.VCMPT + ((long)bg * 64 + n) * 256 + i0) = w;
            }
        }
}

#define AT_ROWB 144
#define AT_KT(b) ((b) * 9216)
#define AT_VT(b) (18432 + (b) * 9216)
#define AT_IMP 36864
#define AT_SEL (36864 + 4 * 64 * 66 * 4)
#define NEG_INF (-INFINITY)

struct AttSt { f32x16 O0, O1, CI; float m, l; };
__device__ __forceinline__ void att_init(AttSt& s, float cb = 0.f) {
#pragma unroll
    for (int i = 0; i < 16; ++i) { s.O0[i] = 0.f; s.O1[i] = 0.f; s.CI[i] = cb; }
    s.m = NEG_INF; s.l = 0.f;
}
__device__ __forceinline__ u32x4 at_gload(int tid, const bf16_t* base, long rstride) {
    const int row = tid >> 3, piece = tid & 7;
    return *(const u32x4*)(base + (long)row * rstride + piece * 8);
}
__device__ __forceinline__ void at_lwrite(int tid, LAS unsigned char* dst, u32x4 v) {
    const int row = tid >> 3, piece = tid & 7;
    *(LAS u32x4*)(dst + row * AT_ROWB + piece * 16) = v;
}
typedef __bf16 bf16x2n __attribute__((ext_vector_type(2)));
__device__ __forceinline__ unsigned pk_bf16_native(float lo, float hi) { bf16x2n v = {(__bf16)lo, (__bf16)hi}; return __builtin_bit_cast(unsigned, v); }
__device__ __forceinline__ float max3f(float a, float b, float c) { float r; asm("v_max3_f32 %0, %1, %2, %3" : "=v"(r) : "v"(a), "v"(b), "v"(c)); return r; }
__device__ __forceinline__ void at_scores(LAS const unsigned char* ktl, const bf16x8 (&qf)[4], f32x16& s0, f32x16& s1, const f32x16& ci) {
    bf16x8 kf[8];
#pragma unroll
    for (int s = 0; s < 4; ++s) { kf[2 * s] = *(LAS const bf16x8*)(ktl + s * 32); kf[2 * s + 1] = *(LAS const bf16x8*)(ktl + 32 * AT_ROWB + s * 32); }
    __builtin_amdgcn_sched_barrier(0);
    s0 = __builtin_amdgcn_mfma_f32_32x32x16_bf16(kf[0], qf[0], ci, 0, 0, 0);
    s1 = __builtin_amdgcn_mfma_f32_32x32x16_bf16(kf[1], qf[0], ci, 0, 0, 0);
#pragma unroll
    for (int s = 1; s < 4; ++s) {
        s0 = __builtin_amdgcn_mfma_f32_32x32x16_bf16(kf[2 * s], qf[s], s0, 0, 0, 0);
        s1 = __builtin_amdgcn_mfma_f32_32x32x16_bf16(kf[2 * s + 1], qf[s], s1, 0, 0, 0);
    }
}
__device__ __forceinline__ void at_scores0(LAS const unsigned char* ktl, const bf16x8 (&qf)[4], f32x16& s0, f32x16& s1) {
    f32x16 z;
#pragma unroll
    for (int i = 0; i < 16; ++i) z[i] = 0.f;
    at_scores(ktl, qf, s0, s1, z);
}
__device__ __forceinline__ void at_vload(LAS const unsigned char* vtl, bf16x8 (&vf)[8]) {
#pragma unroll
    for (int ks = 0; ks < 4; ++ks) { vf[2 * ks] = *(LAS const bf16x8*)(vtl + ks * 32); vf[2 * ks + 1] = *(LAS const bf16x8*)(vtl + 32 * AT_ROWB + ks * 32); }
}
template <bool MASKQ = false>
__device__ __forceinline__ void at_pv(const bf16x8 (&vf)[8], const f32x16& p0, const f32x16& p1, AttSt& st, bool mine = true) {
    bf16x8 pf[4];
#pragma unroll
    for (int sg = 0; sg < 2; ++sg) {
        u32x4 a, b;
        a.x = pk_bf16_native(p0[8 * sg + 0], p0[8 * sg + 1]); a.y = pk_bf16_native(p0[8 * sg + 2], p0[8 * sg + 3]); a.z = pk_bf16_native(p0[8 * sg + 4], p0[8 * sg + 5]); a.w = pk_bf16_native(p0[8 * sg + 6], p0[8 * sg + 7]);
        b.x = pk_bf16_native(p1[8 * sg + 0], p1[8 * sg + 1]); b.y = pk_bf16_native(p1[8 * sg + 2], p1[8 * sg + 3]); b.z = pk_bf16_native(p1[8 * sg + 4], p1[8 * sg + 5]); b.w = pk_bf16_native(p1[8 * sg + 6], p1[8 * sg + 7]);
        if (MASKQ) { a.x = mine ? a.x : 0u; a.y = mine ? a.y : 0u; a.z = mine ? a.z : 0u; a.w = mine ? a.w : 0u; b.x = mine ? b.x : 0u; b.y = mine ? b.y : 0u; b.z = mine ? b.z : 0u; b.w = mine ? b.w : 0u; }
        pf[sg] = __builtin_bit_cast(bf16x8, a); pf[2 + sg] = __builtin_bit_cast(bf16x8, b);
    }
#pragma unroll
    for (int ks = 0; ks < 4; ++ks) {
        st.O0 = __builtin_amdgcn_mfma_f32_32x32x16_bf16(vf[2 * ks], pf[ks], st.O0, 0, 0, 0);
        st.O1 = __builtin_amdgcn_mfma_f32_32x32x16_bf16(vf[2 * ks + 1], pf[ks], st.O1, 0, 0, 0);
    }
}
#define AT_THR 20.0f
template <bool MASKQ = false>
__device__ __forceinline__ void at_softmax_pv(LAS const unsigned char* vtl, f32x16& s0, f32x16& s1, AttSt& st, bool mine = true) {
    bf16x8 vf[8];
    at_vload(vtl, vf);
    __builtin_amdgcn_sched_barrier(0);
    float tm = fmaxf(s0[15], s1[15]);
#pragma unroll
    for (int i = 0; i < 15; ++i) tm = max3f(tm, s0[i], s1[i]);
    tm = half_swap_max(tm);
    if (MASKQ) tm = mine ? tm : NEG_INF;
    const bool unset = (st.m == NEG_INF);
    const bool need = unset ? (tm > NEG_INF) : (tm > AT_THR);
    if (__any(need)) {
        const float delta = need ? tm : 0.f;
        const float al = __builtin_amdgcn_exp2f(-delta);
#pragma unroll
        for (int i = 0; i < 16; ++i) { s0[i] -= delta; s1[i] -= delta; st.O0[i] *= al; st.O1[i] *= al; st.CI[i] -= delta; }
        st.l *= al;
        st.m = need ? ((unset ? 0.f : st.m) + delta) : st.m;
    }
    typedef float f32x2v __attribute__((ext_vector_type(2)));
    f32x2v ls = (f32x2v){0.f, 0.f};
#pragma unroll
    for (int i = 0; i < 16; ++i) { s0[i] = __builtin_amdgcn_exp2f(s0[i]); s1[i] = __builtin_amdgcn_exp2f(s1[i]); }
#pragma unroll
    for (int i = 0; i < 16; i += 2) { ls += (f32x2v){s0[i], s0[i + 1]}; ls += (f32x2v){s1[i], s1[i + 1]}; }
    const float lsum = ls.x + ls.y;
    st.l += MASKQ ? (mine ? lsum : 0.f) : lsum;
    at_pv<MASKQ>(vf, s0, s1, st, mine);
}
__device__ __forceinline__ void at_softmax_abs(f32x16& s0, f32x16& s1, AttSt& st) {
    float tm = fmaxf(s0[15], s1[15]);
#pragma unroll
    for (int i = 0; i < 15; ++i) tm = max3f(tm, s0[i], s1[i]);
    tm = half_swap_max(tm);
    const float mn = fmaxf(st.m, tm);
    const float al = (st.m == NEG_INF) ? 0.f : __builtin_amdgcn_exp2f(st.m - mn);
    const float mu = (mn == NEG_INF) ? 0.f : mn;
#pragma unroll
    for (int i = 0; i < 16; ++i) { st.O0[i] *= al; st.O1[i] *= al; }
    st.l *= al; st.m = mn;
    typedef float f32x2v __attribute__((ext_vector_type(2)));
    f32x2v ls = (f32x2v){0.f, 0.f};
#pragma unroll
    for (int i = 0; i < 16; ++i) { s0[i] = __builtin_amdgcn_exp2f(s0[i] - mu); s1[i] = __builtin_amdgcn_exp2f(s1[i] - mu); }
#pragma unroll
    for (int i = 0; i < 16; i += 2) { ls += (f32x2v){s0[i], s0[i + 1]}; ls += (f32x2v){s1[i], s1[i + 1]}; }
    st.l += ls.x + ls.y;
}
#define AT_KO(tau, reg) (32 * (tau) + 16 * ((reg) >> 3) + ((reg) & 7))

__device__ __forceinline__ void at_bias_table(f32x16& s0, f32x16& s1, LAS const float* tabl) {
#pragma unroll
    for (int i = 0; i < 16; ++i) { s0[i] += tabl[AT_KO(0, i)]; s1[i] += tabl[AT_KO(1, i)]; }
}
__device__ __forceinline__ void at_mask_gt(f32x16& s0, f32x16& s1, int thrl) {
#pragma unroll
    for (int i = 0; i < 16; ++i) { s0[i] = (AT_KO(0, i) > thrl) ? s0[i] : NEG_INF; s1[i] = (AT_KO(1, i) > thrl) ? s1[i] : NEG_INF; }
}
__device__ __forceinline__ void at_mask_lt(f32x16& s0, f32x16& s1, int thrl) {
#pragma unroll
    for (int i = 0; i < 16; ++i) { s0[i] = (AT_KO(0, i) < thrl) ? s0[i] : NEG_INF; s1[i] = (AT_KO(1, i) < thrl) ? s1[i] : NEG_INF; }
}
__device__ __forceinline__ void at_store(bf16_t* dst  , const AttSt& st, float scale, int hq) {
#pragma unroll
    for (int dl = 0; dl < 2; ++dl)
#pragma unroll
        for (int sg = 0; sg < 2; ++sg) {
            const f32x16& O = dl ? st.O1 : st.O0;
            u32x4 w;
            w.x = cvt_pk_bf16(O[8 * sg + 0] * scale, O[8 * sg + 1] * scale); w.y = cvt_pk_bf16(O[8 * sg + 2] * scale, O[8 * sg + 3] * scale);
            w.z = cvt_pk_bf16(O[8 * sg + 4] * scale, O[8 * sg + 5] * scale); w.w = cvt_pk_bf16(O[8 * sg + 6] * scale, O[8 * sg + 7] * scale);
            *(u32x4*)(dst + 32 * dl + 16 * sg + 8 * hq) = w;
        }
}
__device__ __forceinline__ int at_pi(int rho) { return (rho & 0x13) | ((rho & 4) << 1) | ((rho & 8) >> 1); }

__device__ __forceinline__ void build_tables(const Params& p, LAS unsigned char* lds) {
    LAS float* TR = (LAS float*)(lds + LDS_TAB_OFF);
    for (int e = threadIdx.x; e < 16 * 256; e += NTHR) {
        const int h = e >> 8, x = e & 255, dist = 191 - x;
        float v;
        if (dist < 0) v = NEG_INF;
        else if (dist < 128) v = (p.rel_bias[kBucket[dist] * 16 + h] - ((h < 8) ? 0.f : p.rel_bias[31 * 16 + h])) * LOG2E;
        else v = (h < 8) ? NEG_INF : 0.f;
        TR[e] = v;
    }
    __syncthreads();
}

#define AT_STEP(RKL, RVL, RKW, RVW, KB, KST, KRS, VB, VST, VRS, ...) { \
        { const int jl_ = (j + 3 < je_) ? j + 3 : je_; RKL = at_gload(tid, (KB) + (long)jl_ * (KST), (KRS)); RVL = at_gload(tid, (VB) + (long)jl_ * (VST), (VRS)); } \
        { const int buf = (j - j0_) & 1; __VA_ARGS__ \
          if (j < je_) { at_lwrite(tid, lds + AT_KT(buf ^ 1), RKW); at_lwrite(tid, lds + AT_VT(buf ^ 1), RVW); } } \
        __syncthreads(); \
        if (j == je_) break; \
        ++j; }
struct TileSets { u32x4 k0, v0, k1, v1, k2, v2; };
#define AT_PRELOAD(S, J0, JE, KB, KST, KRS, VB, VST, VRS) { \
        const int a_ = (J0), e_ = (JE); const int b_ = (a_ + 1 < e_) ? a_ + 1 : e_, c_ = (a_ + 2 < e_) ? a_ + 2 : e_; \
        S.k0 = at_gload(tid, (KB) + (long)a_ * (KST), (KRS)); S.v0 = at_gload(tid, (VB) + (long)a_ * (VST), (VRS)); \
        S.k1 = at_gload(tid, (KB) + (long)b_ * (KST), (KRS)); S.v1 = at_gload(tid, (VB) + (long)b_ * (VST), (VRS)); \
        S.k2 = at_gload(tid, (KB) + (long)c_ * (KST), (KRS)); S.v2 = at_gload(tid, (VB) + (long)c_ * (VST), (VRS)); }
#define AT_LOOP_FROM(S, J0, JE, KB, KST, KRS, VB, VST, VRS, ...) { \
        const int j0_ = (J0), je_ = (JE); \
        at_lwrite(tid, lds + AT_KT(0), S.k0); at_lwrite(tid, lds + AT_VT(0), S.v0); \
        __syncthreads(); \
        for (int j = j0_;;) { \
            AT_STEP(S.k0, S.v0, S.k1, S.v1, KB, KST, KRS, VB, VST, VRS, __VA_ARGS__) \
            AT_STEP(S.k1, S.v1, S.k2, S.v2, KB, KST, KRS, VB, VST, VRS, __VA_ARGS__) \
            AT_STEP(S.k2, S.v2, S.k0, S.v0, KB, KST, KRS, VB, VST, VRS, __VA_ARGS__) \
        } }

__device__ __forceinline__ void attn_aw_unit(const Params& p, int l, int b, int g, int c, LAS unsigned char* lds) {
    int tid = threadIdx.x; asm volatile("" : "+v"(tid));
    const int wave = tid >> 6, lane = tid & 63, r = wave & 3, th = wave >> 2, hq = lane >> 5, ql = lane & 31;
    const int h = g * 4 + r, bg = b * 2 + g;
    const int tl = 32 * th + ql;
    const long tok = (long)b * SEQ + 64 * c + tl;
    LAS const unsigned char* ktl = lds + at_pi(ql) * AT_ROWB + 16 * hq;
    LAS const unsigned char* vtl = lds + at_pi(ql) * AT_ROWB + 16 * hq;
    LAS const float* TR = (LAS const float*)(lds + LDS_TAB_OFF);
    bf16x8 qf[4], qfb[4];
    AttSt st;
    const bf16_t* KAp = p.KA + (long)bg * SEQ * 64; const bf16_t* VAp = p.VAT + (long)bg * 64 * SEQ;
    const bf16_t* KWp = p.KW + (long)bg * SEQ * 64; const bf16_t* VWp = p.VWT + (long)bg * 64 * SEQ;
    const int ja0 = (c - 2 < 0) ? 0 : c - 2, jw0 = (c - 8 < 0) ? 0 : c - 8;
    TileSets SA, SW;
#pragma unroll
    for (int s = 0; s < 4; ++s) qf[s] = *(const bf16x8*)(p.QA + tok * 512 + h * 64 + 16 * s + 8 * hq);
    AT_PRELOAD(SA, ja0, c, KAp, 4096, 64, VAp, 64, SEQ)
#pragma unroll
    for (int s = 0; s < 4; ++s) qfb[s] = *(const bf16x8*)(p.QB + tok * 512 + h * 64 + 16 * s + 8 * hq);
    AT_PRELOAD(SW, jw0, c, KWp, 4096, 64, VWp, 64, SEQ)
    const float gwin = p.G24[tok * 32 + h * 3 + 2];
    const float sinkv = p.a_sinks[l * 8 + h] * LOG2E;
    const float cbw = p.rel_bias[31 * 16 + 8 + h] * LOG2E;
    {
        att_init(st);
        AT_LOOP_FROM(SA, ja0, c, KAp, 4096, 64, VAp, 64, SEQ, {
            f32x16 s0, s1;
            at_scores(ktl + AT_KT(buf), qf, s0, s1, st.CI);
            const int drel = 64 * (c - j) + tl;
            at_bias_table(s0, s1, TR + h * 256 + (191 - drel + 8 * hq));
            at_softmax_pv(vtl + AT_VT(buf), s0, s1, st); })
        float lt = half_swap_sum(st.l);
        lt += __builtin_amdgcn_exp2f(sinkv - st.m);
        at_store(p.OAB + tok * 1024 + h * 64, st, 1.0f / lt, hq);
    }
    {
        att_init(st, cbw);
        AT_LOOP_FROM(SW, jw0, c, KWp, 4096, 64, VWp, 64, SEQ, {
            f32x16 s0, s1;
            at_scores(ktl + AT_KT(buf), qfb, s0, s1, st.CI);
            if (j >= c - 2) {
                const int drel = 64 * (c - j) + tl;
                at_bias_table(s0, s1, TR + (8 + h) * 256 + (191 - drel + 8 * hq));
            } else if (j == c - 8) at_mask_gt(s0, s1, tl - 8 * hq);
            at_softmax_pv(vtl + AT_VT(buf), s0, s1, st); })
        const float lt = half_swap_sum(st.l);
        at_store(p.OW + tok * 512 + h * 64, st, gwin / lt, hq);
    }
}

__device__ __forceinline__ void attn_cs_unit(const Params& p, int b, int g, int c, LAS unsigned char* lds) {
    int tid = threadIdx.x; asm volatile("" : "+v"(tid));
    const int wave = tid >> 6, lane = tid & 63, r = wave & 3, th = wave >> 2, hq = lane >> 5, ql = lane & 31;
    const int h = g * 4 + r, bg = b * 2 + g;
    const int tl = 32 * th + ql, tq = 64 * c + tl;
    const long tok = (long)b * SEQ + tq;
    LAS const unsigned char* ktl = lds + at_pi(ql) * AT_ROWB + 16 * hq;
    LAS const unsigned char* vtl = lds + at_pi(ql) * AT_ROWB + 16 * hq;
    LAS const float* TR = (LAS const float*)(lds + LDS_TAB_OFF);
    LAS float* IMP = (LAS float*)(lds + AT_IMP);
    LAS unsigned long long* SEL = (LAS unsigned long long*)(lds + AT_SEL);
    bf16x8 qf[4];
#pragma unroll
    for (int s = 0; s < 4; ++s) qf[s] = *(const bf16x8*)(p.QB + tok * 512 + h * 64 + 16 * s + 8 * hq);
    const int nv = (tq >= 31) ? ((tq - 31) / 16 + 1) : 0;
    const int nv_hi = (64 * c + 63 - 31) / 16 + 1;
    const int ntile = (nv_hi + 63) / 64;
    const bf16_t* KC = p.KCMP + (long)bg * 256 * 64; const bf16_t* VCT = p.VCMPT + (long)bg * 64 * 256;
    const bf16_t* KSp = p.KS + (long)bg * SEQ * 64; const bf16_t* VSp = p.VST + (long)bg * 64 * SEQ;
    TileSets S1, S2;
    AT_PRELOAD(S2, 0, ntile - 1, KC, 4096, 64, VCT, 64, 256)
    AttSt st; att_init(st);
    float imp_carry = 0.f, rf0 = NEG_INF, rf1 = NEG_INF, rf2 = NEG_INF, rf3 = NEG_INF;
    LAS float* IMF = (LAS float*)(lds + AT_SEL + 512);
    AT_LOOP_FROM(S2, 0, ntile - 1, KC, 4096, 64, VCT, 64, 256, {
        f32x16 s0, s1;
        at_scores0(ktl + AT_KT(buf), qf, s0, s1);
        at_mask_lt(s0, s1, nv - 64 * j - 8 * hq);
        const float mb = st.m;
        at_softmax_abs(s0, s1, st);
        if (j == 0) rf0 = st.m; else if (j == 1) rf1 = st.m; else if (j == 2) rf2 = st.m; else rf3 = st.m;
        imp_carry *= (mb == NEG_INF) ? 0.f : __builtin_amdgcn_exp2f(mb - st.m);
        if (c >= 16) { float G0[4], G1[4];
          _Pragma("unroll") for (int a = 0; a < 4; ++a) { G0[a] = (s0[4 * a] + s0[4 * a + 1]) + (s0[4 * a + 2] + s0[4 * a + 3]); G1[a] = (s1[4 * a] + s1[4 * a + 1]) + (s1[4 * a + 2] + s1[4 * a + 3]); }
          const float r01 = half_other(s0[7], hq), r03 = half_other(s0[15], hq), r11 = half_other(s1[7], hq), r13 = half_other(s1[15], hq);
          LAS float* irow = IMP + (r * 64 + tl) * 66 + 16 * j + 2 * hq;
          irow[0]  = G0[0] + (hq ? r01 : imp_carry);
          irow[1]  = G0[1] + s0[3];
          irow[4]  = G0[2] + (hq ? r03 : r01);
          irow[5]  = G0[3] + s0[11];
          irow[8]  = G1[0] + (hq ? r11 : r03);
          irow[9]  = G1[1] + s1[3];
          irow[12] = G1[2] + (hq ? r13 : r11);
          irow[13] = G1[3] + s1[11];
          imp_carry = r13; }
        { bf16x8 vf[8]; at_vload(vtl + AT_VT(buf), vf); at_pv(vf, s0, s1, st); } })
    AT_PRELOAD(S1, 0, c, KSp, 4096, 64, VSp, 64, SEQ)
    const float g0 = p.G24[tok * 32 + h * 3 + 0], g1 = p.G24[tok * 32 + h * 3 + 1];
    const float cbs = p.rel_bias[31 * 16 + 8 + h] * LOG2E;
    u32x4 owp[4];
#pragma unroll
    for (int q4 = 0; q4 < 4; ++q4) owp[q4] = *(const u32x4*)(p.OW + tok * 512 + h * 64 + 32 * (q4 >> 1) + 16 * (q4 & 1) + 8 * hq);
    const float l1 = half_swap_sum(st.l);
    const float inv1 = (l1 > 0.f) ? 1.0f / l1 : 0.f;
    if (c >= 16) {
        if (hq == 0) {
            LAS float* fr = IMF + (r * 64 + tl) * 4;
            fr[0] = (rf0 == NEG_INF) ? 0.f : __builtin_amdgcn_exp2f(rf0 - st.m) * inv1; fr[1] = (rf1 == NEG_INF) ? 0.f : __builtin_amdgcn_exp2f(rf1 - st.m) * inv1;
            fr[2] = (rf2 == NEG_INF) ? 0.f : __builtin_amdgcn_exp2f(rf2 - st.m) * inv1; fr[3] = (rf3 == NEG_INF) ? 0.f : __builtin_amdgcn_exp2f(rf3 - st.m) * inv1;
        }
        __syncthreads();
    }
    const float g0n = g0 * inv1;
    unsigned long long mysel;
    if (c < 16) {
        mysel = (2ull << c) - 1ull;
    } else {
        const int js = lane, tb = c;
        const bool causal = js <= tb, forced = (js == 0) || (js == tb) || (js == tb - 1);
        const bool cand = causal && !forced;
        const unsigned long long mforced = __ballot(causal && forced), mcand = __ballot(cand);
        const int want = 16 - __builtin_popcountll(mforced);
#pragma unroll 1
        for (int k = 0; k < 8; k += 2) {
            const int t = 8 * wave + k;
            const int jt = js >> 4;
            const unsigned va = __float_as_uint((IMP[t * 66 + js] * IMF[t * 4 + jt] + IMP[(64 + t) * 66 + js] * IMF[(64 + t) * 4 + jt]) + (IMP[(128 + t) * 66 + js] * IMF[(128 + t) * 4 + jt] + IMP[(192 + t) * 66 + js] * IMF[(192 + t) * 4 + jt]));
            const unsigned vc = __float_as_uint((IMP[(t + 1) * 66 + js] * IMF[(t + 1) * 4 + jt] + IMP[(65 + t) * 66 + js] * IMF[(65 + t) * 4 + jt]) + (IMP[(129 + t) * 66 + js] * IMF[(129 + t) * 4 + jt] + IMP[(193 + t) * 66 + js] * IMF[(193 + t) * 4 + jt]));
            unsigned Ta = 0u, Tc = 0u; bool da = false, dc = false;
            unsigned long long msa = 0ull, msc = 0ull;
#pragma unroll 1
            for (int bit = 30; bit >= 0; --bit) {
                const unsigned tra = Ta | (1u << bit), trc = Tc | (1u << bit);
                const unsigned long long mga = __ballot(cand && va >= tra), mgc = __ballot(cand && vc >= trc);
                const int ca = __builtin_popcountll(mga), cc = __builtin_popcountll(mgc);
                if (!da) { if (ca == want) { msa = mga; da = true; } else Ta = (ca > want) ? tra : Ta; }
                if (!dc) { if (cc == want) { msc = mgc; dc = true; } else Tc = (cc > want) ? trc : Tc; }
                if (da && dc) break;
            }
            if (!da) {
                const unsigned long long mgt = __ballot(cand && va > Ta), meq = __ballot(cand && va == Ta);
                const int rq = want - __builtin_popcountll(mgt);
                const int below = __builtin_amdgcn_mbcnt_hi((unsigned)(meq >> 32), __builtin_amdgcn_mbcnt_lo((unsigned)meq, 0));
                msa = mgt | __ballot(cand && va == Ta && below < rq);
            }
            if (!dc) {
                const unsigned long long mgt = __ballot(cand && vc > Tc), meq = __ballot(cand && vc == Tc);
                const int rq = want - __builtin_popcountll(mgt);
                const int below = __builtin_amdgcn_mbcnt_hi((unsigned)(meq >> 32), __builtin_amdgcn_mbcnt_lo((unsigned)meq, 0));
                msc = mgt | __ballot(cand && vc == Tc && below < rq);
            }
            if (lane == 0) { SEL[t] = msa | mforced; SEL[t + 1] = msc | mforced; }
        }
        __syncthreads();
        mysel = SEL[tl];
    }
    {
        bf16_t* dst = p.OAB + tok * 1024 + 512 + h * 64;
#pragma unroll
        for (int dl = 0; dl < 2; ++dl)
#pragma unroll
            for (int sg = 0; sg < 2; ++sg) {
                const f32x16& O = dl ? st.O1 : st.O0;
                const u32x4 wv = owp[dl * 2 + sg];
                u32x4 w;
                w.x = cvt_pk_bf16(O[8 * sg + 0] * g0n + bf16lo(wv.x), O[8 * sg + 1] * g0n + bf16hi(wv.x)); w.y = cvt_pk_bf16(O[8 * sg + 2] * g0n + bf16lo(wv.y), O[8 * sg + 3] * g0n + bf16hi(wv.y));
                w.z = cvt_pk_bf16(O[8 * sg + 4] * g0n + bf16lo(wv.z), O[8 * sg + 5] * g0n + bf16hi(wv.z)); w.w = cvt_pk_bf16(O[8 * sg + 6] * g0n + bf16lo(wv.w), O[8 * sg + 7] * g0n + bf16hi(wv.w));
                *(u32x4*)(dst + 32 * dl + 16 * sg + 8 * hq) = w;
            }
    }
    {
        att_init(st, cbs);
        AT_LOOP_FROM(S1, 0, c, KSp, 4096, 64, VSp, 64, SEQ, {
            const bool mine = (mysel >> j) & 1ull;
            if (__ballot(mine) != 0ull) {
                f32x16 s0, s1;
                at_scores(ktl + AT_KT(buf), qf, s0, s1, st.CI);
                if (j >= c - 2) {
                    const int drel = 64 * (c - j) + tl;
                    at_bias_table(s0, s1, TR + (8 + h) * 256 + (191 - drel + 8 * hq));
                }
                at_softmax_pv<true>(vtl + AT_VT(buf), s0, s1, st, mine);
            } })
        const float lt = half_swap_sum(st.l);
        const float g1l = g1 / lt;
        bf16_t* dst = p.OAB + tok * 1024 + 512 + h * 64;
#pragma unroll
        for (int dl = 0; dl < 2; ++dl)
#pragma unroll
            for (int sg = 0; sg < 2; ++sg) {
                const f32x16& O = dl ? st.O1 : st.O0;
                const u32x4 wv = *(const u32x4*)(dst + 32 * dl + 16 * sg + 8 * hq);
                u32x4 w;
                w.x = cvt_pk_bf16(O[8 * sg + 0] * g1l + bf16lo(wv.x), O[8 * sg + 1] * g1l + bf16hi(wv.x)); w.y = cvt_pk_bf16(O[8 * sg + 2] * g1l + bf16lo(wv.y), O[8 * sg + 3] * g1l + bf16hi(wv.y));
                w.z = cvt_pk_bf16(O[8 * sg + 4] * g1l + bf16lo(wv.z), O[8 * sg + 5] * g1l + bf16hi(wv.z)); w.w = cvt_pk_bf16(O[8 * sg + 6] * g1l + bf16lo(wv.w), O[8 * sg + 7] * g1l + bf16hi(wv.w));
                *(u32x4*)(dst + 32 * dl + 16 * sg + 8 * hq) = w;
            }
    }
}
struct EpiGate {
    static constexpr bool PERM = true;
    const float* rs; bf16_t* DST;
    __device__ __forceinline__ void operator()(const AccT& acc, const pg8::Unit& u, int wr, int wc, int fr, int fq) const {
        const int row0 = u.pm * 256 + wr * 64 + fr;
        float rr[2][4];
#pragma unroll
        for (int ai = 0; ai < 2; ++ai)
#pragma unroll
            for (int m = 0; m < 4; ++m) rr[ai][m] = rs[row0 + ai * 128 + m * 16];
#pragma unroll
        for (int ai = 0; ai < 2; ++ai)
#pragma unroll
            for (int m = 0; m < 4; ++m) {
                const float r = rr[ai][m];
                bf16_t* dp = DST + (long)(row0 + ai * 128 + m * 16) * 1024 + u.pn * 256 + wc * 32 + fq * 8;
#pragma unroll
                for (int bj = 0; bj < 2; ++bj) {
                    const f32x4 v0 = acc[ai][bj][m][0], v1 = acc[ai][bj][m][1];
                    u32x4 w; w.x = cvt_pk_bf16(fast_sigmoid(v0[0] * r), fast_sigmoid(v0[1] * r)); w.y = cvt_pk_bf16(fast_sigmoid(v0[2] * r), fast_sigmoid(v0[3] * r));
                    w.z = cvt_pk_bf16(fast_sigmoid(v1[0] * r), fast_sigmoid(v1[1] * r)); w.w = cvt_pk_bf16(fast_sigmoid(v1[2] * r), fast_sigmoid(v1[3] * r));
                    *(u32x4*)(dp + bj * 128) = w;
                    __builtin_amdgcn_sched_barrier(0);
                }
            }
    }
};
struct EpiMerge2 {
    static constexpr bool PERM = true;
    bf16_t* MERGED; const bf16_t* GB;
    static __device__ __forceinline__ float gclamp(float g) { return fmaxf(g, 1e-30f); }
    __device__ __forceinline__ void mid(AccT& acc, const pg8::Unit& u, int wr, int wc, int fr, int fq) const {
        int row0 = u.pm * 256 + wr * 64 + fr;
        asm volatile("" : "+v"(row0));
        const long cbase = (long)u.pn * 256 + wc * 32 + fq * 8;
        u32x4 ac[2], bc[2], an[2], bn[2];
#pragma unroll
        for (int bj = 0; bj < 2; ++bj) {
            ac[bj] = *(const u32x4*)(MERGED + (long)row0 * 1024 + cbase + bj * 128); bc[bj] = *(const u32x4*)(GB + (long)row0 * 1024 + cbase + bj * 128);
            an[bj] = ac[bj]; bn[bj] = bc[bj];
        }
#pragma unroll
        for (int i = 0; i < 8; ++i) {
            const int ai = i >> 2, m = i & 3;
            if (i < 7) {
                const long on = (long)(row0 + ((i + 1) >> 2) * 128 + ((i + 1) & 3) * 16) * 1024 + cbase;
#pragma unroll
                for (int bj = 0; bj < 2; ++bj) { an[bj] = *(const u32x4*)(MERGED + on + bj * 128); bn[bj] = *(const u32x4*)(GB + on + bj * 128); }
            }
#pragma unroll
            for (int bj = 0; bj < 2; ++bj) {
                const u32x4 a = ac[bj], b = bc[bj];
                f32x4& v0 = acc[ai][bj][m][0]; f32x4& v1 = acc[ai][bj][m][1];
                v0[0] *= bf16lo(a.x) * __builtin_amdgcn_rcpf(gclamp(bf16lo(b.x))); v0[1] *= bf16hi(a.x) * __builtin_amdgcn_rcpf(gclamp(bf16hi(b.x)));
                v0[2] *= bf16lo(a.y) * __builtin_amdgcn_rcpf(gclamp(bf16lo(b.y))); v0[3] *= bf16hi(a.y) * __builtin_amdgcn_rcpf(gclamp(bf16hi(b.y)));
                v1[0] *= bf16lo(a.z) * __builtin_amdgcn_rcpf(gclamp(bf16lo(b.z))); v1[1] *= bf16hi(a.z) * __builtin_amdgcn_rcpf(gclamp(bf16hi(b.z)));
                v1[2] *= bf16lo(a.w) * __builtin_amdgcn_rcpf(gclamp(bf16lo(b.w))); v1[3] *= bf16hi(a.w) * __builtin_amdgcn_rcpf(gclamp(bf16hi(b.w)));
            }
#pragma unroll
            for (int bj = 0; bj < 2; ++bj) { ac[bj] = an[bj]; bc[bj] = bn[bj]; }
            __builtin_amdgcn_sched_barrier(0);
        }
    }
    __device__ __forceinline__ void operator()(const AccT& acc, const pg8::Unit& u, int wr, int wc, int fr, int fq) const {
        const int row0 = u.pm * 256 + wr * 64 + fr;
        const long cbase = (long)u.pn * 256 + wc * 32 + fq * 8;
        u32x4 gc[2], gn[2];
#pragma unroll
        for (int bj = 0; bj < 2; ++bj) { gc[bj] = *(const u32x4*)(GB + (long)row0 * 1024 + cbase + bj * 128); gn[bj] = gc[bj]; }
#pragma unroll
        for (int i = 0; i < 8; ++i) {
            const int ai = i >> 2, m = i & 3;
            const long o = (long)(row0 + ai * 128 + m * 16) * 1024 + cbase;
            if (i < 7) {
                const long on = (long)(row0 + ((i + 1) >> 2) * 128 + ((i + 1) & 3) * 16) * 1024 + cbase;
#pragma unroll
                for (int bj = 0; bj < 2; ++bj) gn[bj] = *(const u32x4*)(GB + on + bj * 128);
            }
#pragma unroll
            for (int bj = 0; bj < 2; ++bj) {
                const f32x4 v0 = acc[ai][bj][m][0], v1 = acc[ai][bj][m][1];
                const u32x4 gg = gc[bj];
                u32x4 w;
                w.x = cvt_pk_bf16(gclamp(bf16lo(gg.x)) * v0[0], gclamp(bf16hi(gg.x)) * v0[1]); w.y = cvt_pk_bf16(gclamp(bf16lo(gg.y)) * v0[2], gclamp(bf16hi(gg.y)) * v0[3]);
                w.z = cvt_pk_bf16(gclamp(bf16lo(gg.z)) * v1[0], gclamp(bf16hi(gg.z)) * v1[1]); w.w = cvt_pk_bf16(gclamp(bf16lo(gg.w)) * v1[2], gclamp(bf16hi(gg.w)) * v1[3]);
                *(u32x4*)(MERGED + o + bj * 128) = w;
            }
#pragma unroll
            for (int bj = 0; bj < 2; ++bj) gc[bj] = gn[bj];
            __builtin_amdgcn_sched_barrier(0);
        }
    }
};
struct EpiOut {
    static constexpr bool PERM = true;
    bf16_t* HB; float* ssq16;
    __device__ __forceinline__ void operator()(const AccT& acc, const pg8::Unit& u, int wr, int wc, int fr, int fq) const {
        const int row0 = u.pm * 256 + wr * 64 + fr;
        const long cbase = (long)u.pn * 256 + wc * 32 + fq * 8;
        u32x4 cur[2], nxt[2];
#pragma unroll
        for (int bj = 0; bj < 2; ++bj) cur[bj] = *(const u32x4*)(HB + (long)row0 * 1024 + cbase + bj * 128);
#pragma unroll
        for (int i = 0; i < 8; ++i) {
            const int ai = i >> 2, m = i & 3;
            const int row = row0 + ai * 128 + m * 16;
            if (i < 7) {
                const int rown = row0 + ((i + 1) >> 2) * 128 + ((i + 1) & 3) * 16;
#pragma unroll
                for (int bj = 0; bj < 2; ++bj) nxt[bj] = *(const u32x4*)(HB + (long)rown * 1024 + cbase + bj * 128);
            }
            float ss = 0.f;
#pragma unroll
            for (int bj = 0; bj < 2; ++bj) {
                const long oo = (long)row * 1024 + cbase + bj * 128;
                const u32x4 c = cur[bj];
                const f32x4 h0 = {bf16lo(c.x), bf16hi(c.x), bf16lo(c.y), bf16hi(c.y)}, h1 = {bf16lo(c.z), bf16hi(c.z), bf16lo(c.w), bf16hi(c.w)};
                const f32x4 v0 = h0 + acc[ai][bj][m][0], v1 = h1 + acc[ai][bj][m][1];
                u32x4 w; w.x = cvt_pk_bf16(v0[0], v0[1]); w.y = cvt_pk_bf16(v0[2], v0[3]); w.z = cvt_pk_bf16(v1[0], v1[1]); w.w = cvt_pk_bf16(v1[2], v1[3]);
                *(u32x4*)(HB + oo) = w;
                ss += ((v0[0] * v0[0] + v0[1] * v0[1]) + (v0[2] * v0[2] + v0[3] * v0[3])) + ((v1[0] * v1[0] + v1[1] * v1[1]) + (v1[2] * v1[2] + v1[3] * v1[3]));
            }
            ss += swz_xor<16>(ss); ss = half_swap_sum(ss);
            if (fq == 0) ssq16[(long)row * 16 + u.pn * 4 + wc] = ss;
#pragma unroll
            for (int bj = 0; bj < 2; ++bj) cur[bj] = nxt[bj];
            __builtin_amdgcn_sched_barrier(0);
        }
    }
};

__device__ __forceinline__ void gates24_phase(const Params& p, int l, LAS unsigned char* lds) {
    constexpr int WROW = 136;
    LAS bf16_t* WB = (LAS bf16_t*)lds;
    int tid = threadIdx.x; asm volatile("" : "+v"(tid));
    const int wave = tid >> 6, lane = tid & 63, fr = lane & 15, kq = lane >> 4;
    const bf16_t* W = p.WinT + ((long)l * 4352 + 2048) * 1024;
    for (int tile = blockIdx.x; tile < T_TOK / 128; tile += gridDim.x) {
        const long t0 = (long)tile * 128;
        const bf16_t* xrow = p.HB + (t0 + wave * 16 + fr) * DM + kq * 8;
        f32x4 acc[2];
#pragma unroll
        for (int ct = 0; ct < 2; ++ct) acc[ct] = (f32x4){0.f, 0.f, 0.f, 0.f};
        for (int kc = 0; kc < 1024; kc += 128) {
            bf16x8 xv[4];
#pragma unroll
            for (int ks = 0; ks < 4; ++ks) xv[ks] = *(const bf16x8*)(xrow + kc + ks * 32);
            __syncthreads();
            { const int row = tid >> 4, piece = tid & 15;
              const u32x4 v = *(const u32x4*)(W + (long)row * 1024 + kc + piece * 8);
              *(LAS u32x4*)(WB + row * WROW + piece * 8) = v; }
            __syncthreads();
#pragma unroll
            for (int ks = 0; ks < 4; ++ks)
#pragma unroll
                for (int ct = 0; ct < 2; ++ct) {
                    const bf16x8 bw = *(LAS const bf16x8*)(WB + (ct * 16 + fr) * WROW + ks * 32 + kq * 8);
                    acc[ct] = __builtin_amdgcn_mfma_f32_16x16x32_bf16(xv[ks], bw, acc[ct], 0, 0, 0);
                }
        }
#pragma unroll
        for (int j = 0; j < 4; ++j) {
            const long t = t0 + wave * 16 + 4 * kq + j;
            const float r = p.rsA[t];
            p.G24[t * 32 + fr] = fast_sigmoid(acc[0][j] * r);
            if (fr < 8) p.G24[t * 32 + 16 + fr] = fast_sigmoid(acc[1][j] * r);
        }
    }
    __syncthreads();
}
typedef __bf16 bf16x8n __attribute__((ext_vector_type(8)));
__device__ __forceinline__ void router_phase(const Params& p, int l, LAS unsigned char* lds) {
    constexpr int WROW = 136;
    LAS bf16_t* WB = (LAS bf16_t*)lds;
    LAS float* LG = (LAS float*)(lds + 2 * 48 * WROW * 2);
    LAS int* HIST = (LAS int*)(lds + 2 * 48 * WROW * 2 + 128 * 37 * 4);
    int tid = threadIdx.x; asm volatile("" : "+v"(tid));
    const int wave = tid >> 6, lane = tid & 63, fr = lane & 15, kq = lane >> 4;
    const bf16_t* WH = p.WRH + (long)l * 48 * 1024; const bf16_t* WL = p.WRL + (long)l * 48 * 1024;
    if (blockIdx.x == 0 && tid == 0) p.rsB[T_TOK] = 1.0f;
    for (int tile = blockIdx.x; tile < T_TOK / 128; tile += gridDim.x) {
        const long t0 = (long)tile * 128;
        const bf16_t* xrow = p.HB + (t0 + wave * 16 + fr) * DM + kq * 8;
        f32x4 acc[3];
#pragma unroll
        for (int ct = 0; ct < 3; ++ct) acc[ct] = (f32x4){0.f, 0.f, 0.f, 0.f};
        if (tid < 32) HIST[tid] = 0;
        for (int kc = 0; kc < 1024; kc += 128) {
            bf16x8 xv[4];
#pragma unroll
            for (int ks = 0; ks < 4; ++ks) xv[ks] = *(const bf16x8*)(xrow + kc + ks * 32);
            __syncthreads();
#pragma unroll
            for (int i = 0; i < 3; ++i) {
                const int idx = tid + 512 * i, part = idx / 768, rem = idx % 768, row = rem >> 4, piece = rem & 15;
                const u32x4 v = *(const u32x4*)((part ? WL : WH) + (long)row * 1024 + kc + piece * 8);
                *(LAS u32x4*)(WB + (part * 48 + row) * WROW + piece * 8) = v;
            }
            __syncthreads();
#pragma unroll
            for (int ks = 0; ks < 4; ++ks) {
#pragma unroll
                for (int ct = 0; ct < 3; ++ct) {
                    const bf16x8 bh = *(LAS const bf16x8*)(WB + (ct * 16 + fr) * WROW + ks * 32 + kq * 8);
                    const bf16x8 bl = *(LAS const bf16x8*)(WB + (48 + ct * 16 + fr) * WROW + ks * 32 + kq * 8);
                    acc[ct] = __builtin_amdgcn_mfma_f32_16x16x32_bf16(xv[ks], bh, acc[ct], 0, 0, 0);
                    acc[ct] = __builtin_amdgcn_mfma_f32_16x16x32_bf16(xv[ks], bl, acc[ct], 0, 0, 0);
                }
            }
        }
#pragma unroll
        for (int ct = 0; ct < 3; ++ct) {
            const int n = ct * 16 + fr;
            if (n < 36) {
#pragma unroll
                for (int j = 0; j < 4; ++j) LG[(wave * 16 + 4 * kq + j) * 37 + n] = acc[ct][j];
            }
        }
        __syncthreads();
        if (tid < 128) {
            const long t = t0 + tid;
            float ss = 0.f;
#pragma unroll
            for (int i = 0; i < 4; ++i) { const float4 q = *(const float4*)(p.ssq16 + t * 16 + i * 4); ss += (q.x + q.y) + (q.z + q.w); }
            const float r = rsqrtf(ss * (1.0f / DM) + 1e-5f);
            p.rsB[t] = r;
            float gl[4]; int gs = 0; float gmax;
#pragma unroll
            for (int j = 0; j < 4; ++j) gl[j] = LG[tid * 37 + j] * r + p.b_group[l * 4 + j];
            gmax = gl[0];
#pragma unroll
            for (int j = 1; j < 4; ++j) if (gl[j] > gmax) { gmax = gl[j]; gs = j; }
            float den = 0.f;
#pragma unroll
            for (int j = 0; j < 4; ++j) den += __expf(gl[j] - gmax);
            const float gw = 1.0f / den;
            float el[8];
#pragma unroll
            for (int j = 0; j < 8; ++j) el[j] = LG[tid * 37 + 4 + gs * 8 + j] * r + p.b_expert[l * 32 + gs * 8 + j];
            int i0 = 0; float v0 = el[0];
#pragma unroll
            for (int j = 1; j < 8; ++j) if (el[j] > v0) { v0 = el[j]; i0 = j; }
            int i1 = -1; float v1 = NEG_INF;
#pragma unroll
            for (int j = 0; j < 8; ++j) if (j != i0 && (i1 < 0 || el[j] > v1)) { v1 = el[j]; i1 = j; }
            const float ex = __expf(v1 - v0);
            const float w0 = 1.0f / (1.0f + ex), w1 = ex / (1.0f + ex);
            const int e0 = gs * 8 + i0, e1 = gs * 8 + i1;
            p.eid[t * 2] = e0; p.eid[t * 2 + 1] = e1;
            p.ew[t * 2] = w0 * gw; p.ew[t * 2 + 1] = w1 * gw;
            __hip_atomic_fetch_add(HIST + e0, 1, __ATOMIC_RELAXED, __HIP_MEMORY_SCOPE_WORKGROUP);
            __hip_atomic_fetch_add(HIST + e1, 1, __ATOMIC_RELAXED, __HIP_MEMORY_SCOPE_WORKGROUP);
        }
        __syncthreads();
        if (tid < 32) p.cnt_tile[tile * 32 + tid] = HIST[tid];
        __syncthreads();
    }
}
__device__ __forceinline__ void scatter_phase(const Params& p, LAS unsigned char* lds) {
    LAS int* PST = (LAS int*)lds;
    LAS int* CNT = PST + 64;
    LAS int* PRE = PST + 128;
    LAS int* LCN = PST + 192;
    int tid = threadIdx.x; asm volatile("" : "+v"(tid));
    for (int tile = blockIdx.x; tile < T_TOK / 128; tile += gridDim.x) {
        __syncthreads();
        {
            LAS int* RT = PST + 256;
            LAS int* RP = RT + 512;
            const int e = tid & 31, grp = tid >> 5;
            int tot = 0, pre = 0;
#pragma unroll 4
            for (int i = grp; i < T_TOK / 128; i += 16) { const int c = p.cnt_tile[i * 32 + e]; tot += c; pre += (i < tile) ? c : 0; }
            RT[grp * 32 + e] = tot; RP[grp * 32 + e] = pre;
        }
        __syncthreads();
        if (tid < 32) {
            int tot = 0, pre = 0;
#pragma unroll
            for (int gq = 0; gq < 16; ++gq) { tot += PST[256 + gq * 32 + tid]; pre += PST[256 + 512 + gq * 32 + tid]; }
            CNT[tid] = tot; PRE[tid] = pre; LCN[tid] = 0;
        }
        __syncthreads();
        if (tid == 0) { int acc = 0; for (int e = 0; e < 32; ++e) { PST[e] = acc; acc += (CNT[e] + 255) / 256 * 256; } PST[32] = acc; }
        __syncthreads();
        if (tile == 0 && tid == 0) p.ntiles[0] = PST[32] / 256;
        if (tile == 0 && tid < 32) { p.counts[tid] = PST[tid] / 256; p.counts[32 + tid] = (PST[tid + 1] - PST[tid]) / 256; }
        if (tile < 32) {
            const int e = tile, s0 = PST[e], s1 = PST[e + 1], c = CNT[e];
            for (int tI = s0 / 256 + tid; tI < s1 / 256; tI += NTHR) p.tile_e[tI] = e;
            for (int s = s0 + c + tid; s < s1; s += NTHR) { p.toks[s] = T_TOK; p.slotw[s] = 0.f; p.slotdst[s] = -1; }
        }
        if (tid < 256) {
            const int a = tile * 256 + tid;
            const int e = p.eid[a];
            const int lp = __hip_atomic_fetch_add(LCN + e, 1, __ATOMIC_RELAXED, __HIP_MEMORY_SCOPE_WORKGROUP);
            const int s = PST[e] + PRE[e] + lp;
            p.toks[s] = a >> 1; p.slotw[s] = p.ew[a]; p.slotdst[s] = a;
        }
    }
}
template <int WHICH>
__device__ __forceinline__ void moe_stage_units(const Params& p, LAS unsigned char* lds) {
    LAS int* ul = (LAS int*)(lds + LDS_META_OFF);
    LAS int* ia = ul + 64; LAS float* fa = (LAS float*)(ia + 6 * 256);
    int tid = threadIdx.x; asm volatile("" : "+v"(tid));
    const int nt = p.ntiles[0];
    const int W = (int)gridDim.x >> 3, x = (int)blockIdx.x & 7, r = (int)blockIdx.x >> 3;
    int mx = 0;
#pragma unroll
    for (int q = 0; q < 8; ++q) { const int s = p.counts[32 + q] + p.counts[40 + q] + p.counts[48 + q] + p.counts[56 + q]; mx = s > mx ? s : mx; }
    const int rounds_plain = (nt * 4 + (int)gridDim.x - 1) / (int)gridDim.x;
    const bool local = ((int)gridDim.x & 7) == 0 && W > 0 && (mx * 4 + W - 1) / W <= (rounds_plain < 6 ? rounds_plain : 6);
    if (local) {
        const int n0 = p.counts[32 + x], n1 = p.counts[40 + x], n2 = p.counts[48 + x], n3 = p.counts[56 + x], tot = 4 * (n0 + n1 + n2 + n3);
        if (tid < 6) {
            const int j = tid * W + r, jt = j >> 2;
            const bool ok = j < tot;
            int pm = 0;
            if (ok) {
                if (jt < n0) pm = p.counts[x] + jt;
                else if (jt < n0 + n1) pm = p.counts[8 + x] + (jt - n0);
                else if (jt < n0 + n1 + n2) pm = p.counts[16 + x] + (jt - n0 - n1);
                else pm = p.counts[24 + x] + (jt - n0 - n1 - n2);
            }
            ul[2 + 2 * tid] = pm; ul[3 + 2 * tid] = ok ? p.tile_e[pm] * 4 + (j & 3) : 0;
        }
        if (tid == 0) { const int n = tot > r ? (tot - r + W - 1) / W : 0; ul[0] = n > 6 ? 6 : n; }
    } else {
        if (tid < 6) {
            const long L = (long)tid * gridDim.x + blockIdx.x;
            const bool ok = L < (long)nt * 4;
            const int pm = ok ? (int)(L >> 2) : 0;
            ul[2 + 2 * tid] = pm; ul[3 + 2 * tid] = ok ? p.tile_e[pm] * 4 + (int)(L & 3) : 0;
        }
        if (tid == 0) { const long rem = (long)nt * 4 - blockIdx.x; int n = rem > 0 ? (int)((rem + gridDim.x - 1) / gridDim.x) : 0; ul[0] = n > 6 ? 6 : n; }
    }
    __syncthreads();
    const int nu = ul[0];
    for (int e = tid; e < nu * 256; e += NTHR) {
        const int li = e >> 8, r = e & 255, row = ul[2 + 2 * li] * 256 + r;
        if (WHICH == 0) { const int tk = p.toks[row]; ia[e] = tk; fa[e] = p.rsB[tk]; }
        else { ia[e] = p.slotdst[row]; fa[e] = p.slotw[row]; }
    }
    __syncthreads();
}
struct EpiMoe1 {
    static constexpr bool PERM = true;
    const LAS float* rsl; bf16_t* HMID;
    __device__ __forceinline__ void operator()(const AccT& acc, const pg8::Unit& u, int wr, int wc, int fr, int fq) const {
        const int row0 = u.pm * 256 + wr * 64 + fr;
        const int q = u.pn & 3;
        float rr[2][4];
#pragma unroll
        for (int ai = 0; ai < 2; ++ai)
#pragma unroll
            for (int m = 0; m < 4; ++m) rr[ai][m] = rsl[u.li * 256 + wr * 64 + fr + ai * 128 + m * 16];
#pragma unroll
        for (int ai = 0; ai < 2; ++ai)
#pragma unroll
            for (int m = 0; m < 4; ++m) {
                const float r = rr[ai][m];
                float y[8];
#pragma unroll
                for (int j = 0; j < 4; ++j) {
                    const float a0 = acc[ai][0][m][0][j] * r, b0 = acc[ai][1][m][0][j] * r, a1 = acc[ai][0][m][1][j] * r, b1 = acc[ai][1][m][1][j] * r;
                    y[j] = a0 * fast_sigmoid(a0) * b0; y[4 + j] = a1 * fast_sigmoid(a1) * b1;
                }
                u32x4 w; w.x = cvt_pk_bf16(y[0], y[1]); w.y = cvt_pk_bf16(y[2], y[3]); w.z = cvt_pk_bf16(y[4], y[5]); w.w = cvt_pk_bf16(y[6], y[7]);
                *(u32x4*)(HMID + (long)(row0 + ai * 128 + m * 16) * 512 + q * 128 + wc * 32 + fq * 8) = w;
                __builtin_amdgcn_sched_barrier(0);
            }
    }
};
struct EpiMoe2 {
    static constexpr bool PERM = true;
    const LAS int* dstl; const LAS float* wl; bf16_t* YS;
    __device__ __forceinline__ void operator()(const AccT& acc, const pg8::Unit& u, int wr, int wc, int fr, int fq) const {
        const int row0 = u.pm * 256 + wr * 64 + fr;
        const int q = u.pn & 3;
        int dd[2][4]; float ww[2][4];
#pragma unroll
        for (int ai = 0; ai < 2; ++ai)
#pragma unroll
            for (int m = 0; m < 4; ++m) { const int lr = u.li * 256 + wr * 64 + fr + ai * 128 + m * 16; dd[ai][m] = dstl[lr]; ww[ai][m] = wl[lr]; }
#pragma unroll
        for (int ai = 0; ai < 2; ++ai)
#pragma unroll
            for (int m = 0; m < 4; ++m) {
                if (dd[ai][m] >= 0) {
                    const float wv = ww[ai][m];
                    bf16_t* dp = YS + (long)dd[ai][m] * 1024 + q * 256 + wc * 32 + fq * 8;
#pragma unroll
                    for (int bj = 0; bj < 2; ++bj) {
                        const f32x4 v0 = acc[ai][bj][m][0], v1 = acc[ai][bj][m][1];
                        u32x4 w; w.x = cvt_pk_bf16(v0[0] * wv, v0[1] * wv); w.y = cvt_pk_bf16(v0[2] * wv, v0[3] * wv); w.z = cvt_pk_bf16(v1[0] * wv, v1[1] * wv); w.w = cvt_pk_bf16(v1[2] * wv, v1[3] * wv);
                        *(u32x4*)(dp + bj * 128) = w;
                    }
                }
                __builtin_amdgcn_sched_barrier(0);
            }
    }
};

#define FAST_PHASES_2_TO_10 \
        if (IN(2)) { \
            if ((int)blockIdx.x < 32) { \
                pg8::Gemm g{p.KVC, p.CW1T + (size_t)l * 512 * 2048, 2048, 1024, 2048, nullptr}; \
                pg8::CmpOrder S{(int)blockIdx.x}; \
                EpiCmp1 E{p.CB1 + l * 512, p.CHID}; \
                pg8::gemm_phase<EpiCmp1, pg8::CmpOrder, false>(lds, g, S, E); \
                cmp_gemm2(p, l, blockIdx.x); \
                if (l == 0) cvt_fill<0>(p, lds, NCH0, FILL_P2C); \
            } else { \
                  \
                const int nw = (int)gridDim.x - 32; \
                if (__builtin_amdgcn_readfirstlane((int)threadIdx.x) >= 256) __builtin_amdgcn_s_setprio(1);     \
                for (int u = (int)blockIdx.x - 32; u < 1024; u += nw) attn_aw_unit(p, l, (u & 15) >> 1, u & 1, 63 - (u >> 4), lds); \
                __builtin_amdgcn_s_setprio(0); \
                if (l == 0 && (1024 - ((int)blockIdx.x - 32) + nw - 1) / nw < (1024 + nw - 1) / nw) cvt_fill<0>(p, lds, NCH0, FILL_P2A); \
            } \
            GRID_BAR(); \
        } \
        if (IN(3)) { \
            if (__builtin_amdgcn_readfirstlane((int)threadIdx.x) >= 256) __builtin_amdgcn_s_setprio(1); \
            for (int k = blockIdx.x; k < 1024; k += gridDim.x) { \
                const int bgk = k & 15, cg = (k >> 4) & 15, i4 = k >> 8; \
                const int c = (i4 == 0) ? 63 - cg : (i4 == 1) ? 32 + cg : (i4 == 2) ? 31 - cg : cg; \
                attn_cs_unit(p, bgk >> 1, bgk & 1, c, lds); \
            } \
            __builtin_amdgcn_s_setprio(0); \
            GRID_BAR(); \
        } \
        if (IN(4)) { \
            pg8::StaticOrder S; S.init(T_TOK, 1024, gridDim.x, blockIdx.x); \
            { pg8::Gemm g{p.HB, p.WinT + ((size_t)l * 4352 + 2072) * 1024, 1024, 1024, 1024, nullptr}; EpiGate E{p.rsA, p.MERGED}; \
              pg8::gemm_phase<EpiGate, pg8::StaticOrder, false>(lds, g, S, E); } \
            { pg8::Gemm g{p.HB, p.WinT + ((size_t)l * 4352 + 3096) * 1024, 1024, 1024, 1024, nullptr}; EpiGate E{p.rsA, p.TMP2}; \
              pg8::gemm_phase<EpiGate, pg8::StaticOrder, false>(lds, g, S, E); } \
            { pg8::Gemm g{p.OAB, p.WabT + (size_t)l * 1024 * 1024, 1024, 1024, 1024, nullptr}; EpiMerge2 E{p.MERGED, p.TMP2}; \
              pg8::gemm_phase<EpiMerge2, pg8::StaticOrder, false, true>(lds, g, S, E); } \
            GRID_BAR(); \
        } \
        if (IN(5)) { \
            pg8::StaticOrder S; S.init(T_TOK, 1024, gridDim.x, blockIdx.x); \
            pg8::Gemm g{p.MERGED, p.WoutT + (size_t)l * 1024 * 1024, 1024, 1024, 1024, nullptr}; \
            EpiOut E{p.HB, p.ssq16}; \
            pg8::gemm_phase<EpiOut, pg8::StaticOrder, false>(lds, g, S, E); \
            GRID_BAR(); \
        } \
        if (IN(6)) { router_phase(p, l, lds); GRID_BAR(); } \
        if (IN(7)) { if (l == 0) cvt_fill<0>(p, lds, NCH0, 100000); scatter_phase(p, lds); GRID_BAR(); } \
        if (IN(8)) { \
            moe_stage_units<0>(p, lds); \
            LAS int* ul_ = (LAS int*)(lds + LDS_META_OFF); \
            pg8::MoeOrder S{ul_}; \
            pg8::Gemm g{p.HB, l ? p.W13T1 : p.W13T, 1024, 1024, 1024, ul_ + 64}; \
            EpiMoe1 E{(LAS float*)(ul_ + 64 + 6 * 256), p.HMID}; \
            pg8::gemm_phase<EpiMoe1, pg8::MoeOrder, true>(lds, g, S, E); \
            if (l == 0 && ul_[0] < (p.ntiles[0] * 4 + (int)gridDim.x - 1) / (int)gridDim.x) cvt_fill<1>(p, lds, 0, FILL_P8); \
            GRID_BAR(); \
        } \
        if (IN(9)) { \
            moe_stage_units<1>(p, lds); \
            LAS int* ul_ = (LAS int*)(lds + LDS_META_OFF); \
            pg8::MoeOrder S{ul_}; \
            pg8::Gemm g{p.HMID, l ? p.W2T1 : p.W2T, 512, 512, 512, nullptr}; \
            EpiMoe2 E{ul_ + 64, (LAS float*)(ul_ + 64 + 6 * 256), p.YS}; \
            pg8::gemm_phase<EpiMoe2, pg8::MoeOrder, false>(lds, g, S, E); \
            if (l == 0 && ul_[0] < (p.ntiles[0] * 4 + (int)gridDim.x - 1) / (int)gridDim.x) cvt_fill<1>(p, lds, 0, FILL_P9); \
            GRID_BAR(); \
        } \
        if (IN(10)) { \
            if (l == 1) fin_phase<true, true>(p, nullptr, p.norm_final); \
            else { fin_phase<true, false>(p, nullptr, nullptr); cvt_fill<1>(p, lds, 0, 100000); } \
            GRID_BAR(); \
        }
__global__ void __launch_bounds__(NTHR, 2) mega(Params p) {
    extern __shared__ __attribute__((aligned(16))) unsigned char lds_raw[];
    LAS unsigned char* lds = (LAS unsigned char*)lds_raw;
    volatile LAS unsigned* misc = (volatile LAS unsigned*)(lds + LDS_MISC_OFF);
    if (threadIdx.x < 64) misc[threadIdx.x] = 0u;
    build_tables(p, lds);
    const bool multi = (p.ph_hi - p.ph_lo > 1) || (p.l_hi - p.l_lo > 1);
    XcdBarrier bar; bar.bar = p.bar; bar.x = 0; bar.st = misc;
    if (multi) bar = xcd_barrier_post(p.bar, misc);
#define GRID_BAR() do { if (multi) xcd_barrier(bar); } while (0)
#define IN(k) (p.ph_lo <= (k) && (k) < p.ph_hi)

    if (IN(0) && p.l_lo == 0) {
        cvt_phase<0, 8>(p, lds);
        cvt_static<0>(p, lds, NCH0);
        prep_small(p);
        fin_phase<false, false>(p, p.x, nullptr);
        GRID_BAR();
    }
    for (int l = p.l_lo; l < p.l_hi; ++l) {
        if (IN(1)) {
            if (l == 0) cb1_reduce(p);
            pg8::Gemm g{p.HB, p.WinT + (size_t)l * 4352 * 1024, 1024, 1024, 1024, nullptr};
            pg8::StaticOrder S; S.init(T_TOK, 2048, gridDim.x, blockIdx.x);
            EpiProj E{p.rsA, p.QA, p.KA, p.G24};
            pg8::gemm_phase<EpiProj, pg8::StaticOrder, false>(lds, g, S, E);
            gates24_phase(p, l, lds);
            GRID_BAR();
        }
        FAST_PHASES_2_TO_10
    }
#undef IN
#undef GRID_BAR
}

struct HostState { int grid; bool ok; };
static void setup_params(Params& p, void* const* d_in, void* d_out, void* d_ws, size_t ws_size, size_t& used) {
    p.x = (const float*)d_in[0]; p.rel_bias = (const float*)d_in[1]; p.norm_mix = (const float*)d_in[2]; p.w_in = (const float*)d_in[3];
    p.a_sinks = (const float*)d_in[4]; p.cmp_pos_k = (const float*)d_in[5]; p.cmp_w1_k = (const float*)d_in[6]; p.cmp_w2_k = (const float*)d_in[7];
    p.cmp_pos_v = (const float*)d_in[8]; p.cmp_w1_v = (const float*)d_in[9]; p.cmp_w2_v = (const float*)d_in[10];
    p.w_br_a = (const float*)d_in[11]; p.w_br_b = (const float*)d_in[12]; p.w_out = (const float*)d_in[13]; p.norm_ffn = (const float*)d_in[14];
    p.w_group = (const float*)d_in[15]; p.b_group = (const float*)d_in[16]; p.w_expert = (const float*)d_in[17]; p.b_expert = (const float*)d_in[18];
    p.w1 = (const float*)d_in[19]; p.w3 = (const float*)d_in[20]; p.w2 = (const float*)d_in[21]; p.norm_final = (const float*)d_in[22];
    p.out = (float*)d_out;
    char* ws = (char*)d_ws; size_t off = 0;
    auto alloc = [&](size_t bytes) { void* q = ws + off; off += (bytes + 4095) & ~(size_t)4095; return q; };
    p.bar = (unsigned*)alloc(XCD_BAR_WORDS * 4);
    p.counts = (int*)alloc(256); p.cursor = (int*)alloc(256); p.ntiles = (int*)alloc(256); p.tile_e = (int*)alloc(NTILE_MAX * 4 + 256); p.cnt_tile = (int*)alloc((size_t)(T_TOK / 128) * 32 * 4);
    p.rsA = (float*)alloc(T_TOK * 4); p.rsB = (float*)alloc(T_TOK * 4); p.ssq16 = (float*)alloc((size_t)T_TOK * 16 * 4);
    p.HB = (bf16_t*)alloc((size_t)(T_TOK + 256) * DM * 2);
    p.WinT = (bf16_t*)alloc((size_t)2 * 4352 * 1024 * 2);
    p.WabT = (bf16_t*)alloc((size_t)2 * 1024 * 1024 * 2); p.WoutT = (bf16_t*)alloc((size_t)2 * 1024 * 1024 * 2);
    p.CW1T = (bf16_t*)alloc((size_t)2 * 512 * 2048 * 2); p.CW2T = (bf16_t*)alloc((size_t)2 * 2 * 64 * 256 * 2); p.CB1 = (float*)alloc(1024 * 4); p.CBP = (float*)alloc((size_t)512 * 256 * 4);
    p.W13T = (bf16_t*)alloc((size_t)32 * 1024 * 1024 * 2); p.W2T = (bf16_t*)alloc((size_t)32 * 1024 * 512 * 2);
    p.W13T1 = (bf16_t*)d_out; p.W2T1 = p.W13T1 + (size_t)32 * 1024 * 1024;
    p.cvtcur = (int*)(p.bar + 3584);
    p.WRH = (bf16_t*)alloc((size_t)2 * 48 * 1024 * 2); p.WRL = (bf16_t*)alloc((size_t)2 * 48 * 1024 * 2);
    p.eid = (int*)alloc((size_t)T_TOK * 2 * 4); p.ew = (float*)alloc((size_t)T_TOK * 2 * 4);
    p.toks = (int*)alloc((size_t)PMAXF * 4); p.slotw = (float*)alloc((size_t)PMAXF * 4); p.slotdst = (int*)alloc((size_t)PMAXF * 4);
    const size_t region0 = off;
    p.QA = (bf16_t*)alloc((size_t)T_TOK * 512 * 2); p.QB = (bf16_t*)alloc((size_t)T_TOK * 512 * 2);
    {
        const size_t slot = (size_t)16 * SEQ * 64;
        p.KA = (bf16_t*)alloc(8 * slot * 2); p.KVC = p.KA + slot; p.KS = p.KA + 3 * slot; p.KW = p.KA + 4 * slot; p.VAT = p.KA + 5 * slot; p.VST = p.KA + 6 * slot; p.VWT = p.KA + 7 * slot;
    }
    p.G24 = (float*)alloc((size_t)T_TOK * 32 * 4);
    p.CHID = (bf16_t*)alloc((size_t)8192 * 256 * 2); p.KCMP = (bf16_t*)alloc((size_t)16 * 256 * 64 * 2); p.VCMPT = (bf16_t*)alloc((size_t)16 * 64 * 256 * 2);
    p.OAB = (bf16_t*)alloc((size_t)T_TOK * 1024 * 2); p.OW = (bf16_t*)alloc((size_t)T_TOK * 512 * 2);
    p.MERGED = (bf16_t*)alloc((size_t)T_TOK * 1024 * 2);
    const size_t region1 = off;
    p.TMP2 = p.QA;
    p.HMID = (bf16_t*)(ws + region0);
    size_t moe_end = region0 + (((size_t)PMAXF * 512 * 2 + 4095) & ~(size_t)4095);
    p.YS = (bf16_t*)(ws + moe_end); moe_end += (size_t)T_TOK * 2 * 1024 * 2;
    used = (moe_end > region1) ? moe_end : region1;
    (void)ws_size;
    auto task = [&](int i, const float* src, bf16_t* dst, const float* scale, int scstride, int ld, int K, int N, int mapmode, int nb, long ss, long ds, int dld = 0) {
        CvtTask& t = p.cvt[i]; t.dld = dld ? dld : K; t.src = src; t.dst = dst; t.scale = scale; t.scstride = scstride; t.ld = ld; t.K = K; t.N = N; t.mapmode = mapmode; t.nb = nb; t.sstride = ss; t.dstride = ds; };
    task(0, p.w_in, p.WinT, p.norm_mix, 1024, INC, 1024, INC, 0, 2, (long)1024 * INC, (long)4352 * 1024);
    task(1, p.w_br_a, p.WabT, nullptr, 0, 1024, 512, 1024, 0, 2, (long)512 * 1024, (long)1024 * 1024, 1024);
    task(2, p.w_br_b, p.WabT + 512, nullptr, 0, 1024, 512, 1024, 0, 2, (long)512 * 1024, (long)1024 * 1024, 1024);
    task(3, p.w_out, p.WoutT, nullptr, 0, 1024, 1024, 1024, 0, 2, (long)1024 * 1024, (long)1024 * 1024);
    task(4, p.cmp_w1_k, p.CW1T, nullptr, 0, 256, 2048, 256, 0, 2, (long)2048 * 256, (long)512 * 2048);
    task(5, p.cmp_w1_v, p.CW1T + (size_t)256 * 2048, nullptr, 0, 256, 2048, 256, 0, 2, (long)2048 * 256, (long)512 * 2048);
    task(6, p.cmp_w2_k, p.CW2T, nullptr, 0, 64, 256, 64, 0, 2, (long)256 * 64, (long)2 * 64 * 256);
    task(7, p.cmp_w2_v, p.CW2T + (size_t)64 * 256, nullptr, 0, 64, 256, 64, 0, 2, (long)256 * 64, (long)2 * 64 * 256);
}
static HostState& host_state() {
    static HostState hs{0, false};
    if (hs.grid == 0) {
        int dev = 0, cus = 0, per_cu = 0;
        hs.grid = -1;
        if (hipGetDevice(&dev) != hipSuccess) return hs;
        if (hipDeviceGetAttribute(&cus, hipDeviceAttributeMultiprocessorCount, dev) != hipSuccess) return hs;
        if (hipFuncSetAttribute((const void*)mega, hipFuncAttributeMaxDynamicSharedMemorySize, LDS_TOTAL) != hipSuccess) return hs;
        if (hipOccupancyMaxActiveBlocksPerMultiprocessor(&per_cu, (const void*)mega, NTHR, LDS_TOTAL) != hipSuccess || per_cu < 1) { (void)hipGetLastError(); return hs; }
        hs.grid = cus;
        hs.ok = true;
    }
    return hs;
}
static void launch_mega(const Params& base, int ph_lo, int ph_hi, int l_lo, int l_hi, hipStream_t stream) {
    Params p = base; p.ph_lo = ph_lo; p.ph_hi = ph_hi; p.l_lo = l_lo; p.l_hi = l_hi;
    hipLaunchKernelGGL(mega, dim3(host_state().grid), dim3(NTHR), LDS_TOTAL, stream, p);
}
extern "C" void kernel_launch(void* const* d_in, const int* in_sizes, int n_in, void* d_out, int out_size, void* d_ws, size_t ws_size,
                              hipStream_t stream) {
    HostState& hs = host_state();
    if (!hs.ok) return;
    Params P; memset(&P, 0, sizeof(P));
    size_t used = 0;
    setup_params(P, d_in, d_out, d_ws, ws_size, used);
    if (used > ws_size) return;
    (void)in_sizes; (void)n_in; (void)out_size;
    hipMemsetAsync(P.bar, 0, 16384, stream);
    launch_mega(P, 0, 11, 0, 2, stream);
}
```

```cpp
#include <string.h>
#include <hip/hip_runtime.h>
#include <stdint.h>

#define T_TOK 32768
#define SEQ 4096
#define DM 1024
#define INC 4120

__device__ const unsigned char kBucket[128] = {0, 1, 2, 3, 4, 5, 6, 7, 8, 9, 10, 11, 12, 13, 14, 15, 16, 16, 16, 17, 17, 18, 18, 18, 19, 19, 19, 20, 20, 20, 20, 21, 21, 21, 21, 22, 22, 22, 22, 22, 23, 23, 23, 23, 23, 23, 24, 24, 24, 24, 24, 24, 25, 25, 25, 25, 25, 25, 25, 26, 26, 26, 26, 26, 26, 26, 26, 27, 27, 27, 27, 27, 27, 27, 27, 27, 27, 28, 28, 28, 28, 28, 28, 28, 28, 28, 28, 29, 29, 29, 29, 29, 29, 29, 29, 29, 29, 29, 29, 30, 30, 30, 30, 30, 30, 30, 30, 30, 30, 30, 30, 30, 30, 31, 31, 31, 31, 31, 31, 31, 31, 31, 31, 31, 31, 31, 31, 31};

#define LAS __attribute__((address_space(3)))
typedef unsigned short bf16_t;
typedef short bf16x8 __attribute__((ext_vector_type(8)));
typedef float f32x4 __attribute__((ext_vector_type(4)));
typedef float f32x16 __attribute__((ext_vector_type(16)));
typedef unsigned u32x4 __attribute__((ext_vector_type(4)));
typedef unsigned u32x2 __attribute__((ext_vector_type(2)));


typedef unsigned u32x2s __attribute__((ext_vector_type(2)));
__device__ __forceinline__ float half_swap_max(float v) { const u32x2s r = __builtin_amdgcn_permlane32_swap(__float_as_uint(v), __float_as_uint(v), false, false); return fmaxf(__uint_as_float(r.x), __uint_as_float(r.y)); }
__device__ __forceinline__ float half_swap_sum(float v) { const u32x2s r = __builtin_amdgcn_permlane32_swap(__float_as_uint(v), __float_as_uint(v), false, false); return __uint_as_float(r.x) + __uint_as_float(r.y); }
__device__ __forceinline__ float half_other(float v, int hq) { const u32x2s r = __builtin_amdgcn_permlane32_swap(__float_as_uint(v), __float_as_uint(v), false, false); return __uint_as_float(hq ? r.x : r.y); }
template <int M> __device__ __forceinline__ float swz_xor(float v) { return __int_as_float(__builtin_amdgcn_ds_swizzle(__float_as_int(v), (M << 10) | 0x1f)); }
__device__ __forceinline__ float wave_sum_f(float v) {
    v += swz_xor<1>(v); v += swz_xor<2>(v); v += swz_xor<4>(v); v += swz_xor<8>(v); v += swz_xor<16>(v);
    return half_swap_sum(v);
}

#define NTHR 512
#define LDS_STAGE 131072
#define LDS_TAB_OFF 131072
#define LDS_MISC_OFF (131072 + 16384)
#define LDS_META_OFF (131072 + 16384 + 1024)
#define LDS_TOTAL (131072 + 16384 + 1024 + 12544)

#define QSCALE 0.18033688011112042f
#define LOG2E 1.4426950408889634f

__device__ __forceinline__ unsigned cvt_pk_bf16(float lo, float hi) { unsigned r; asm volatile("v_cvt_pk_bf16_f32 %0, %1, %2" : "=v"(r) : "v"(lo), "v"(hi)); return r; }
__device__ __forceinline__ float bf16_to_f(unsigned short b) { return __uint_as_float(((unsigned)b) << 16); }
__device__ __forceinline__ float bf16lo(unsigned w) { return __uint_as_float(w << 16); }
__device__ __forceinline__ float bf16hi(unsigned w) { return __uint_as_float(w & 0xffff0000u); }
__device__ __forceinline__ float fast_sigmoid(float x) { return __builtin_amdgcn_rcpf(1.0f + __builtin_amdgcn_exp2f(-1.4426950408889634f * x)); }

#define XB_TMO      128
#define XB_XCNT(j)  (256  + 64 * (j))
#define XB_XSUB(j)  (1280 + 64 * (j))
#define XB_XGEN(j)  (2304 + 64 * (j))
#define XB_TOP      3328
#define XB_TOPGEN   3392
#define XCD_BAR_WORDS 3456
#define XB_SPIN_CAP (1u << 18)

__device__ __forceinline__ unsigned xb_ld(unsigned* p)              { return __hip_atomic_load(p, __ATOMIC_RELAXED, __HIP_MEMORY_SCOPE_AGENT); }
__device__ __forceinline__ unsigned xb_add(unsigned* p, unsigned v) { return __hip_atomic_fetch_add(p, v, __ATOMIC_RELAXED, __HIP_MEMORY_SCOPE_AGENT); }
__device__ __forceinline__ unsigned xb_xcc_id() { return (unsigned)__builtin_amdgcn_s_getreg((3 << 11) | 20) & 0xFu; }
#define XB_SPIN(cond, bar) do { unsigned _sp = 0; while (cond) { __builtin_amdgcn_s_sleep(1); \
    if ((++_sp & 255u) == 0u) { if (xb_ld(&(bar)[XB_TMO])) break; if (_sp > XB_SPIN_CAP) { atomicAdd(&(bar)[XB_TMO], 1u); break; } } } } while (0)

struct XcdBarrier { unsigned* bar; unsigned x; volatile LAS unsigned* st; };

__device__ __forceinline__ XcdBarrier xcd_barrier_post(unsigned* bar, volatile LAS unsigned* st) {
    XcdBarrier b; b.bar = bar; b.x = xb_xcc_id(); b.st = st;
    if (threadIdx.x == 0) (void)xb_add(&bar[XB_XCNT(b.x)], 1u);
    return b;
}
__device__ __forceinline__ void xcd_barrier_complete(unsigned* bar, unsigned x, unsigned& nloc, unsigned& nx) {
    const unsigned G = gridDim.x * gridDim.y * gridDim.z;
    unsigned sum, cnt, mine, sp = 0u;
    for (;;) {
        sum = 0u; cnt = 0u; mine = 0u;
#pragma unroll
        for (unsigned j = 0; j < 16; ++j) { const unsigned c = xb_ld(&bar[XB_XCNT(j)]); sum += c; cnt += (c > 0u) ? 1u : 0u; mine = (j == x) ? c : mine; }
        if (sum == G) break;
        __builtin_amdgcn_s_sleep(1);
        if ((++sp & 255u) == 0u) { if (xb_ld(&bar[XB_TMO])) break; if (sp > XB_SPIN_CAP) { atomicAdd(&bar[XB_TMO], 1u); break; } }
    }
    nloc = mine > 0u ? mine : 1u; nx = cnt > 0u ? cnt : 1u;
}
__device__ __forceinline__ void xcd_barrier(const XcdBarrier& b) {
    asm volatile("s_waitcnt vmcnt(0)" ::: "memory");
    __syncthreads();
    if (threadIdx.x == 0) {
        unsigned* bar = b.bar;
        __builtin_amdgcn_s_waitcnt(0);
        unsigned nloc = b.st[0], nx = b.st[1];
        if (nloc == 0u) { xcd_barrier_complete(bar, b.x, nloc, nx); b.st[0] = nloc; b.st[1] = nx; }
        const unsigned old = xb_add(&bar[XB_XSUB(b.x)], 1u);
        const unsigned gen = old / nloc;
        if (old + 1u == (gen + 1u) * nloc) {
            __builtin_amdgcn_fence(__ATOMIC_RELEASE, "agent");
            asm volatile("s_waitcnt vmcnt(0)" ::: "memory");
            const unsigned og = xb_add(&bar[XB_TOP], 1u);
            const unsigned tg = og / nx;
            if (og + 1u == (tg + 1u) * nx) xb_add(&bar[XB_TOPGEN], 1u);
            else XB_SPIN(xb_ld(&bar[XB_TOPGEN]) == tg, bar);
            __builtin_amdgcn_fence(__ATOMIC_ACQUIRE, "agent");
            xb_add(&bar[XB_XGEN(b.x)], 1u);
            asm volatile("s_waitcnt vmcnt(0)" ::: "memory");
        } else {
            XB_SPIN(xb_ld(&bar[XB_XGEN(b.x)]) == gen, bar);
            __builtin_amdgcn_fence(__ATOMIC_ACQUIRE, "agent");
            asm volatile("s_waitcnt vmcnt(0)" ::: "memory");
        }
    }
    __syncthreads();
}

struct CvtTask {
    const float* src; bf16_t* dst; const float* scale;
    int ld, K, N, mapmode;
    int dld;
    int nb; int scstride;
    long sstride, dstride;
};
#define NCVT 16
struct Params {
    const float* x; const float* rel_bias; const float* norm_mix; const float* w_in; const float* a_sinks;
    const float* cmp_pos_k; const float* cmp_w1_k; const float* cmp_w2_k; const float* cmp_pos_v; const float* cmp_w1_v; const float* cmp_w2_v;
    const float* w_br_a; const float* w_br_b; const float* w_out; const float* norm_ffn; const float* w_group; const float* b_group;
    const float* w_expert; const float* b_expert; const float* w1; const float* w3; const float* w2; const float* norm_final;
    float* out;
    unsigned* bar;
    int* counts; int* cursor; int* ntiles; int* tile_e; int* cnt_tile;
    float* rsA; float* rsB; float* ssq16;
    bf16_t* HB;
    bf16_t* WinT;
    bf16_t* WabT; bf16_t* WoutT;
    bf16_t* CW1T; bf16_t* CW2T; float* CB1; float* CBP;
    bf16_t* W13T; bf16_t* W2T;
    bf16_t* W13T1; bf16_t* W2T1;
    int* cvtcur;
    bf16_t* WRH; bf16_t* WRL;
    bf16_t* QA; bf16_t* QB;
    bf16_t* KA; bf16_t* KVC; bf16_t* KS; bf16_t* KW;
    bf16_t* VAT; bf16_t* VST; bf16_t* VWT;
    float* G24;
    bf16_t* CHID; bf16_t* KCMP; bf16_t* VCMPT;
    bf16_t* OAB; bf16_t* OW;
    bf16_t* MERGED; bf16_t* TMP2;
    int* eid; float* ew; int* toks; float* slotw; int* slotdst;
    bf16_t* HMID; bf16_t* YS;
    CvtTask cvt[NCVT];
    int ph_lo, ph_hi, l_lo, l_hi;
};
#define PMAXF (65536 + 32 * 256)
#define NTILE_MAX (PMAXF / 256)

__device__ __forceinline__ int cvt_units(const CvtTask& t) { return t.nb * (t.K / 128) * ((t.N + 63) / 64); }
struct CvtRegs { float4 v[2][4]; };
__device__ __forceinline__ void cvt_decode(const CvtTask& t, int u, int& e, int& kt, int& nt) {
    int nkt = t.K / 128, nnt = (t.N + 63) / 64;
    asm volatile("" : "+s"(nkt), "+s"(nnt));
    e = u / (nkt * nnt); const int r = u % (nkt * nnt); kt = r / nnt; nt = r % nnt;
}
__device__ __forceinline__ void cvt_load2(const CvtTask& t, int tid, int ub, int G, int nu, CvtRegs& R) {
#pragma unroll
    for (int q = 0; q < 2; ++q) {
        const int uu = ub + q * G;
#pragma unroll
        for (int i = 0; i < 4; ++i) R.v[q][i] = make_float4(0.f, 0.f, 0.f, 0.f);
        if (uu < nu) {
            int e, kt, nt; cvt_decode(t, uu, e, kt, nt);
            const float* src = t.src + (long)e * t.sstride;
#pragma unroll
            for (int i = 0; i < 4; ++i) {
                const int k = (tid >> 4) + 32 * i, n4 = (tid & 15) * 4;
                const int gk = kt * 128 + k, gn = nt * 64 + n4;
                if (gn < t.N) {
                    float4 v = *(const float4*)(src + (long)gk * t.ld + gn);
                    if (t.scale) { const float s = t.scale[(long)e * t.scstride + gk]; v.x *= s; v.y *= s; v.z *= s; v.w *= s; }
                    R.v[q][i] = v;
                }
            }
        }
    }
}
__device__ __forceinline__ void cvt_store2(const CvtTask& t, int tid, int ub, int G, int nu, const CvtRegs& R, LAS float* tiles  ) {
    __syncthreads();
#pragma unroll
    for (int q = 0; q < 2; ++q)
#pragma unroll
        for (int i = 0; i < 4; ++i) {
            const int k = (tid >> 4) + 32 * i, n4 = (tid & 15) * 4;
            LAS float* tl = tiles + q * (128 * 65) + k * 65 + n4;
            tl[0] = R.v[q][i].x; tl[1] = R.v[q][i].y; tl[2] = R.v[q][i].z; tl[3] = R.v[q][i].w;
        }
    __syncthreads();
    const int n = tid >> 3, ks = (tid & 7) * 16;
#pragma unroll
    for (int q = 0; q < 2; ++q) {
        const int uu = ub + q * G;
        if (uu < nu) {
            int e, kt, nt; cvt_decode(t, uu, e, kt, nt);
            bf16_t* dst = t.dst + (long)e * t.dstride;
            const int gn = nt * 64 + n;
            if (gn < t.N) {
                int drow = gn;
                if (t.mapmode == 1) drow = (gn >> 7) * 256 + (gn & 127);
                else if (t.mapmode == 2) drow = (gn >> 7) * 256 + 128 + (gn & 127);
                const LAS float* tl = tiles + q * (128 * 65) + ks * 65 + n;
                u32x4 w0, w1;
                w0.x = cvt_pk_bf16(tl[0 * 65], tl[1 * 65]); w0.y = cvt_pk_bf16(tl[2 * 65], tl[3 * 65]);
                w0.z = cvt_pk_bf16(tl[4 * 65], tl[5 * 65]); w0.w = cvt_pk_bf16(tl[6 * 65], tl[7 * 65]);
                w1.x = cvt_pk_bf16(tl[8 * 65], tl[9 * 65]); w1.y = cvt_pk_bf16(tl[10 * 65], tl[11 * 65]);
                w1.z = cvt_pk_bf16(tl[12 * 65], tl[13 * 65]); w1.w = cvt_pk_bf16(tl[14 * 65], tl[15 * 65]);
                bf16_t* dp = dst + (long)drow * t.dld + kt * 128 + ks;
                *(u32x4*)dp = w0; *(u32x4*)(dp + 8) = w1;
            }
        }
    }
}
template <int t0, int t1>
__device__ __forceinline__ void cvt_phase(const Params& p, LAS unsigned char* lds) {
    LAS float* tiles = (LAS float*)lds;
    int tid = threadIdx.x; asm volatile("" : "+v"(tid));
    const int G = gridDim.x;
    int base = 0;
#pragma unroll
    for (int ti = t0; ti < t1; ++ti) {
        const CvtTask& t = p.cvt[ti];
        const int nu = cvt_units(t);
        int first = (int)blockIdx.x - (base % G); if (first < 0) first += G;
        CvtRegs A, B;
        if (first < nu) cvt_load2(t, tid, first, G, nu, A);
        for (int ub = first; ub < nu; ub += 2 * G) {
            const int un = ub + 2 * G;
            if (un < nu) cvt_load2(t, tid, un, G, nu, B);
            cvt_store2(t, tid, ub, G, nu, A, tiles);
            A = B;
        }
        base += nu;
    }
    __syncthreads();
}
#define JOB_CHUNKS 768
#define FILL_P1 0
#define FILL_P2C 0
#define FILL_P2A 0
#define FILL_P8 0
#define FILL_P9 0
#define NCH0 (JOB_CHUNKS - (128 * FILL_P1 + 32 * FILL_P2C + 96 * FILL_P2A))
template <int JOB>
__device__ __forceinline__ void cvt_job_chunk(const Params& p, int c, LAS float* tiles, int tid) {
    const int which = c >> 8, u0 = (c & 255) * 8;
    CvtTask t;
    const long eo = (long)JOB * 32 * 1024 * 512;
    const float* src = p.w1; if (which == 1) src = p.w3; if (which == 2) src = p.w2;
    t.src = src + eo;
    t.dst = (which == 2) ? (JOB ? p.W2T1 : p.W2T) : (JOB ? p.W13T1 : p.W13T);
    t.scale = (which == 2) ? nullptr : p.norm_ffn + JOB * 1024; t.scstride = 0;
    t.ld = (which == 2) ? 1024 : 512; t.K = (which == 2) ? 512 : 1024; t.N = (which == 2) ? 1024 : 512;
    t.dld = t.K; t.mapmode = (which == 2) ? 0 : 1 + which; t.nb = 32; t.sstride = (long)1024 * 512; t.dstride = (which == 2) ? (long)1024 * 512 : (long)1024 * 1024;
    CvtRegs A, B;
    cvt_load2(t, tid, u0, 1, 2048, A);
#pragma unroll 1
    for (int s2 = 0; s2 < 4; ++s2) {
        if (s2 < 3) cvt_load2(t, tid, u0 + 2 * (s2 + 1), 1, 2048, B);
        cvt_store2(t, tid, u0 + 2 * s2, 1, 2048, A, tiles);
        A = B;
    }
}
template <int JOB>
__device__ __forceinline__ void cvt_fill(const Params& p, LAS unsigned char* lds, int base, int max_chunks) {
    int tid = threadIdx.x; asm volatile("" : "+v"(tid));
    volatile LAS unsigned* slot = (volatile LAS unsigned*)(lds + LDS_MISC_OFF) + 32;
#pragma unroll 1
    for (int n = 0; n < max_chunks; ++n) {
        __syncthreads();
        if (tid == 0) *slot = (unsigned)__hip_atomic_fetch_add(p.cvtcur + JOB, 1, __ATOMIC_RELAXED, __HIP_MEMORY_SCOPE_AGENT);
        __syncthreads();
        const int c = base + __builtin_amdgcn_readfirstlane((int)*slot);
        if (c >= JOB_CHUNKS) break;
        cvt_job_chunk<JOB>(p, c, (LAS float*)lds, tid);
    }
    __syncthreads();
}
template <int JOB>
__device__ __forceinline__ void cvt_static(const Params& p, LAS unsigned char* lds, int n) {
    int tid = threadIdx.x; asm volatile("" : "+v"(tid));
#pragma unroll 1
    for (int c = blockIdx.x; c < n; c += gridDim.x) cvt_job_chunk<JOB>(p, c, (LAS float*)lds, tid);
    __syncthreads();
}
__device__ __forceinline__ void prep_small(const Params& p) {
    const int gtid = blockIdx.x * NTHR + threadIdx.x, gn = gridDim.x * NTHR;
    for (int i = gtid; i < 2 * 48 * 1024; i += gn) {
        const int l = i / (48 * 1024), r = i % (48 * 1024), n = r >> 10, k = r & 1023;
        float w = 0.f;
        if (n < 36) {
            const float g = p.norm_ffn[l * 1024 + k];
            w = g * ((n < 4) ? p.w_group[((long)l * 1024 + k) * 4 + n] : p.w_expert[((long)l * 1024 + k) * 32 + (n - 4)]);
        }
        const __bf16 hi = (__bf16)w; const __bf16 lo = (__bf16)(w - (float)hi);
        p.WRH[i] = __builtin_bit_cast(unsigned short, hi); p.WRL[i] = __builtin_bit_cast(unsigned short, lo);
    }
    for (int w = blockIdx.x; w < 256; w += gridDim.x) {
        const int cmb = w >> 6, sl = w & 63, l = cmb >> 1, kv = cmb & 1, n = threadIdx.x & 255, kh = threadIdx.x >> 8;
        const float* pos = (kv ? p.cmp_pos_v : p.cmp_pos_k) + (long)l * 2048 + sl * 32 + kh * 16;
        const float* wt = (kv ? p.cmp_w1_v : p.cmp_w1_k) + ((long)l * 2048 + sl * 32 + kh * 16) * 256 + n;
        float sacc = 0.f;
#pragma unroll
        for (int i = 0; i < 16; ++i) sacc = fmaf(pos[i], wt[(long)i * 256], sacc);
        p.CBP[((long)w * 2 + kh) * 256 + n] = sacc;
    }
    for (int i = gtid; i < 256 * 1024 / 8; i += gn) ((u32x4*)(p.HB + (long)T_TOK * DM))[i] = (u32x4){0u, 0u, 0u, 0u};
}

__device__ __forceinline__ void cb1_reduce(const Params& p) {
    const int wave = threadIdx.x >> 6, lane = threadIdx.x & 63;
    if (wave < 4) {
        for (int o = blockIdx.x * 4 + wave; o < 1024; o += gridDim.x * 4) {
            const int cmb = o >> 8, n = o & 255;
            const float* pp = p.CBP + ((long)cmb * 128) * 256 + n;
            float v = pp[(long)lane * 256] + pp[(long)(lane + 64) * 256];
            v = wave_sum_f(v);
            if (lane == 0) p.CB1[o] = v;
        }
    }
}
template <bool ADD_YS, bool LAST>
__device__ __forceinline__ void fin_phase(const Params& p, const float* hin, const float* gfinal) {
    int tid = threadIdx.x; asm volatile("" : "+v"(tid));
    const int wave = tid >> 6, lane = tid & 63;
    for (int row0 = (blockIdx.x * 8 + wave) * 2; row0 < T_TOK; row0 += gridDim.x * 16) {
        float v[2][2][8]; u32x4 ya[2][2], yb[2][2], hb[2][2];
#pragma unroll
        for (int q = 0; q < 2; ++q)
#pragma unroll
            for (int i = 0; i < 2; ++i) {
                if (ADD_YS) {
                    hb[q][i] = *(const u32x4*)(p.HB + (long)(row0 + q) * DM + i * 512 + lane * 8);
                    ya[q][i] = *(const u32x4*)(p.YS + ((long)(row0 + q) * 2) * DM + i * 512 + lane * 8);
                    yb[q][i] = *(const u32x4*)(p.YS + ((long)(row0 + q) * 2 + 1) * DM + i * 512 + lane * 8);
                } else {
                    const float4 a = *(const float4*)(hin + (long)(row0 + q) * DM + i * 512 + lane * 8), c = *(const float4*)(hin + (long)(row0 + q) * DM + i * 512 + lane * 8 + 4);
                    v[q][i][0] = a.x; v[q][i][1] = a.y; v[q][i][2] = a.z; v[q][i][3] = a.w; v[q][i][4] = c.x; v[q][i][5] = c.y; v[q][i][6] = c.z; v[q][i][7] = c.w;
                }
            }
#pragma unroll
        for (int q = 0; q < 2; ++q) {
            const int row = row0 + q;
            if (ADD_YS) {
#pragma unroll
                for (int i = 0; i < 2; ++i) {
                    const unsigned hw[4] = {hb[q][i].x, hb[q][i].y, hb[q][i].z, hb[q][i].w}, aw[4] = {ya[q][i].x, ya[q][i].y, ya[q][i].z, ya[q][i].w}, bw[4] = {yb[q][i].x, yb[q][i].y, yb[q][i].z, yb[q][i].w};
#pragma unroll
                    for (int j = 0; j < 4; ++j) {
                        v[q][i][2 * j] = bf16lo(hw[j]) + (bf16lo(aw[j]) + bf16lo(bw[j]));
                        v[q][i][2 * j + 1] = bf16hi(hw[j]) + (bf16hi(aw[j]) + bf16hi(bw[j]));
                    }
                }
            }
            float s = 0.f;
#pragma unroll
            for (int i = 0; i < 2; ++i)
#pragma unroll
                for (int j = 0; j < 8; ++j) s += v[q][i][j] * v[q][i][j];
            s = wave_sum_f(s);
            const float r = rsqrtf(s * (1.0f / DM) + 1e-5f);
            if (LAST) {
#pragma unroll
                for (int i = 0; i < 2; ++i) {
                    const float4 g0 = *(const float4*)(gfinal + i * 512 + lane * 8), g1 = *(const float4*)(gfinal + i * 512 + lane * 8 + 4);
                    float4 o0, o1;
                    o0.x = v[q][i][0] * r * g0.x; o0.y = v[q][i][1] * r * g0.y; o0.z = v[q][i][2] * r * g0.z; o0.w = v[q][i][3] * r * g0.w;
                    o1.x = v[q][i][4] * r * g1.x; o1.y = v[q][i][5] * r * g1.y; o1.z = v[q][i][6] * r * g1.z; o1.w = v[q][i][7] * r * g1.w;
                    *(float4*)(p.out + (long)row * DM + i * 512 + lane * 8) = o0; *(float4*)(p.out + (long)row * DM + i * 512 + lane * 8 + 4) = o1;
                }
            } else {
#pragma unroll
                for (int i = 0; i < 2; ++i) {
                    u32x4 w; w.x = cvt_pk_bf16(v[q][i][0], v[q][i][1]); w.y = cvt_pk_bf16(v[q][i][2], v[q][i][3]); w.z = cvt_pk_bf16(v[q][i][4], v[q][i][5]); w.w = cvt_pk_bf16(v[q][i][6], v[q][i][7]);
                    *(u32x4*)(p.HB + (long)row * DM + i * 512 + lane * 8) = w;
                }
                if (lane == 0) p.rsA[row] = r;
            }
        }
    }
}

namespace pg8 {
constexpr int BM = 256, BK = 64, HALF = 128, HTB = HALF * BK * 2, STAGE_BYTES = 8 * HTB, NXCD = 8, WGM = 8;
__host__ __device__ __forceinline__ int lds_byte(int r, int c) { const int st = (r >> 4) * 2 + (c >> 5), rr = r & 15, cc = c & 31, ob = rr * 64 + cc * 2; return st * 1024 + (ob ^ (((ob >> 9) & 1) << 5)); }
__host__ __device__ __forceinline__ void stage_rc(int b, int& R, int& C) { const int st = b / 1024, sb = b % 1024, swz = sb ^ (((sb >> 9) & 1) << 5); R = (st >> 1) * 16 + swz / 64; C = (st & 1) * 32 + (swz % 64) / 2; }
__host__ __device__ __forceinline__ int perm32(int rho) { const int n = rho >> 4, i = rho & 15; return 8 * (i >> 2) + 4 * n + (i & 3); }

struct Unit { int pm, pn, li; };
struct Gemm { const bf16_t* A; const bf16_t* Bt; int K, lda, ldb; const LAS int* gather; };

struct StaticOrder {
    int nM, nN, nwg, G, c;
    __device__ void init(int M, int N, int G_, int c_) { nM = M / BM; nN = N / BM; nwg = nM * nN; G = G_; c = c_; }
    __device__ bool next(int i, Unit& u) const {
        const long L = (long)i * G + c; if (L >= nwg) return false;
        int wgid = (int)L; { const int q = nwg / NXCD, r = nwg % NXCD, xcd = wgid % NXCD, off = wgid / NXCD; wgid = (xcd < r ? xcd * (q + 1) : r * (q + 1) + (xcd - r) * q) + off; }
        const int nig = WGM * nN, gid = wgid / nig, fm = gid * WGM, gsz = (nM - fm) < WGM ? (nM - fm) : WGM;
        u.pm = fm + ((wgid % nig) % gsz); u.pn = (wgid % nig) / gsz; u.li = 0; return true;
    }
};
struct CmpOrder {
    int c;
    __device__ bool next(int i, Unit& u) const { if (i > 0 || c >= 32) return false; u.pm = c; u.pn = c >> 4; u.li = 0; return true; }
};
struct MoeOrder {
    const LAS int* ul;
    __device__ bool next(int i, Unit& u) const {
        if (i >= ul[0]) return false;
        u.pm = ul[2 + 2 * i]; u.pn = ul[3 + 2 * i]; u.li = i; return true;
    }
};

template <class Epi, class Sched, bool GATHER, bool MID = false>
__device__ __forceinline__ void gemm_phase(LAS unsigned char* lds, const Gemm g, const Sched& S, const Epi& E) {
    int tid = threadIdx.x;
    asm volatile("" : "+v"(tid));
    const int wid = __builtin_amdgcn_readfirstlane(tid >> 6), lane = tid & 63, wr = wid >> 2, wc = wid & 3, fr = lane & 15, fq = lane >> 4;
    const int K = g.K, nt = K / BK;
    unsigned voffA[2], voffB[2];
#pragma unroll
    for (int i = 0; i < 2; ++i) { int R, C; stage_rc(tid * 16 + i * 8192, R, C); const int Rb = Epi::PERM ? ((R & ~31) + perm32(R & 31)) : R;
        voffA[i] = (unsigned)(R * g.lda + C) * 2u; voffB[i] = (unsigned)(Rb * g.ldb + C) * 2u; }
    const size_t kstep = (size_t)(BK * 2);
    const size_t hstepA = (size_t)HALF * g.lda * 2, tstepA = 2 * hstepA;
    const size_t hstepB = (size_t)HALF * g.ldb * 2, tstepB = 2 * hstepB;
    const unsigned ldsw = (unsigned)wid * 1024u;
    const int aoff = lds_byte(wr * 64 + fr, fq * 8), boff = lds_byte(wc * 32 + fr, fq * 8);
#define PG8_SA(b, h) (((b) * 2 + (h)) * HTB)
#define PG8_SB(b, h) ((4 + (b) * 2 + (h)) * HTB)
#define PG8_STAGE(bufoff, gbase, voff) do { _Pragma("unroll") for (int _i = 0; _i < 2; ++_i) \
        __builtin_amdgcn_global_load_lds((const unsigned*)((const char*)(gbase) + (voff)[_i]), (LAS unsigned*)(lds + (bufoff) + ldsw + _i * 8192), 16, 0, 0); } while (0)
#define PG8_STAGEG(bufoff, kb, o0, o1) do { \
        __builtin_amdgcn_global_load_lds((const unsigned*)((const char*)g.A + (kb) + (o0)), (LAS unsigned*)(lds + (bufoff) + ldsw), 16, 0, 0); \
        __builtin_amdgcn_global_load_lds((const unsigned*)((const char*)g.A + (kb) + (o1)), (LAS unsigned*)(lds + (bufoff) + ldsw + 8192), 16, 0, 0); } while (0)
#define PG8_STAGEA_CUR(bufoff, kb, h) do { if constexpr (GATHER) { PG8_STAGEG(bufoff, kb, oc[h][0], oc[h][1]); } else { PG8_STAGE(bufoff, cA + (kb) + (h) * hstepA, voffA); } } while (0)
#define PG8_STAGEA_SEL(bufoff, kb, h) do { if constexpr (GATHER) { PG8_STAGEG(bufoff, kb, (last ? on[h][0] : oc[h][0]), (last ? on[h][1] : oc[h][1])); } else { PG8_STAGE(bufoff, a2b + (kb) + (h) * hstepA, voffA); } } while (0)
#define PG8_LDA(dst, b, h) do { _Pragma("unroll") for (int m = 0; m < 4; ++m) _Pragma("unroll") for (int k = 0; k < 2; ++k) dst[m][k] = *(const LAS bf16x8*)(lds + PG8_SA(b, h) + aoff + m * 2048 + k * 1024); } while (0)
#define PG8_LDB(dst, b, h) do { _Pragma("unroll") for (int n = 0; n < 2; ++n) _Pragma("unroll") for (int k = 0; k < 2; ++k) dst[n][k] = *(const LAS bf16x8*)(lds + PG8_SB(b, h) + boff + n * 2048 + k * 1024); } while (0)
#define PG8_MMA(ai, bj, At, Bt) do { __builtin_amdgcn_s_setprio(1); _Pragma("unroll") for (int m = 0; m < 4; ++m) _Pragma("unroll") for (int n = 0; n < 2; ++n) _Pragma("unroll") for (int k = 0; k < 2; ++k) \
        acc[ai][bj][m][n] = __builtin_amdgcn_mfma_f32_16x16x32_bf16(Bt[n][k], At[m][k], acc[ai][bj][m][n], 0, 0, 0); __builtin_amdgcn_s_setprio(0); } while (0)
#define PG8_WAIT_V(n) asm volatile("s_waitcnt vmcnt(" #n ")" ::: "memory")
#define PG8_WAIT_L(n) asm volatile("s_waitcnt lgkmcnt(" #n ")" ::: "memory")
#define PG8_BAR __builtin_amdgcn_s_barrier()
#define PG8_SCHED __builtin_amdgcn_sched_barrier(0)
#define PG8_AOFF(dst, U) do { _Pragma("unroll") for (int _h = 0; _h < 2; ++_h) _Pragma("unroll") for (int _i = 0; _i < 2; ++_i) { \
        int _R, _C; stage_rc(tid * 16 + _i * 8192, _R, _C); const int _gr = g.gather[(U).li * BM + _h * HALF + _R]; \
        dst[_h][_i] = (unsigned)((_gr * g.lda + _C) * 2); } } while (0)
    Unit cur, nxt; int ui = 0;
    if (!S.next(0, cur)) return;
    f32x4 acc[2][2][4][2];
#pragma unroll
    for (int a = 0; a < 2; ++a)
#pragma unroll
        for (int b = 0; b < 2; ++b)
#pragma unroll
            for (int m = 0; m < 4; ++m)
#pragma unroll
                for (int n = 0; n < 2; ++n) acc[a][b][m][n] = (f32x4){0.f, 0.f, 0.f, 0.f};
    bf16x8 At[4][2], B0[2][2], B1[2][2];
    unsigned oc[2][2] = {{0u, 0u}, {0u, 0u}}, on[2][2] = {{0u, 0u}, {0u, 0u}};
    if constexpr (GATHER) { PG8_AOFF(oc, cur); }
    const char* cA = (const char*)g.A + (GATHER ? (size_t)0 : (size_t)cur.pm * tstepA);
    const char* cB = (const char*)g.Bt + (size_t)cur.pn * tstepB;
    PG8_STAGE(PG8_SB(0, 0), cB, voffB); PG8_STAGEA_CUR(PG8_SA(0, 0), 0, 0); PG8_STAGE(PG8_SB(0, 1), cB + hstepB, voffB); PG8_STAGEA_CUR(PG8_SA(0, 1), 0, 1);
    if (wr == 1) PG8_BAR;
    PG8_WAIT_V(4); PG8_BAR;
    PG8_STAGE(PG8_SB(1, 0), cB + kstep, voffB); PG8_STAGEA_CUR(PG8_SA(1, 0), kstep, 0); PG8_STAGE(PG8_SB(1, 1), cB + hstepB + kstep, voffB);
    PG8_WAIT_V(6); PG8_BAR;
    for (;;) {
        const bool has_next = S.next(ui + 1, nxt);
        if constexpr (GATHER) { if (has_next) { PG8_AOFF(on, nxt); } else { on[0][0] = oc[0][0]; on[0][1] = oc[0][1]; on[1][0] = oc[1][0]; on[1][1] = oc[1][1]; } }
        const char* nA = (has_next && !GATHER) ? (const char*)g.A + (size_t)nxt.pm * tstepA : cA;
        const char* nB = has_next ? (const char*)g.Bt + (size_t)nxt.pn * tstepB : cB;
        for (int t = 0; t < nt; t += 2) {
            if constexpr (MID) { if (t == nt / 2) E.mid(acc, cur, wr, wc, fr, fq); }
            const bool last = (t == nt - 2);
            const size_t k1 = (size_t)(t + 1) * kstep;
            const size_t k2 = last ? 0 : (size_t)(t + 2) * kstep, k3 = k2 + kstep;
            const char* a2b = last ? nA : cA;
            const char* b2 = last ? nB : cB + (size_t)(t + 2) * kstep; const char* b3 = b2 + kstep;
            PG8_LDB(B0, 0, 0); PG8_SCHED; PG8_LDA(At, 0, 0); PG8_STAGEA_CUR(PG8_SA(1, 1), k1, 1);
            PG8_WAIT_L(8); PG8_BAR; PG8_WAIT_L(0); PG8_MMA(0, 0, At, B0); PG8_BAR; PG8_SCHED;
            PG8_LDB(B1, 0, 1); PG8_STAGE(PG8_SB(0, 0), b2, voffB);
            PG8_BAR; PG8_WAIT_L(0); PG8_MMA(0, 1, At, B1); PG8_BAR;
            PG8_LDA(At, 0, 1); PG8_STAGEA_SEL(PG8_SA(0, 0), k2, 0);
            PG8_BAR; PG8_WAIT_L(0); PG8_MMA(1, 0, At, B0); PG8_BAR; PG8_SCHED;
            PG8_STAGE(PG8_SB(0, 1), b2 + hstepB, voffB);
            PG8_WAIT_V(6); PG8_BAR; PG8_MMA(1, 1, At, B1); PG8_BAR;
            PG8_LDB(B0, 1, 0); PG8_SCHED; PG8_LDA(At, 1, 0); PG8_STAGEA_SEL(PG8_SA(0, 1), k2, 1);
            PG8_WAIT_L(8); PG8_BAR; PG8_WAIT_L(0); PG8_MMA(0, 0, At, B0); PG8_BAR; PG8_SCHED;
            PG8_LDB(B1, 1, 1); PG8_STAGE(PG8_SB(1, 0), b3, voffB);
            PG8_BAR; PG8_WAIT_L(0); PG8_MMA(0, 1, At, B1); PG8_BAR;
            PG8_LDA(At, 1, 1); PG8_STAGEA_SEL(PG8_SA(1, 0), k3, 0);
            PG8_BAR; PG8_WAIT_L(0); PG8_MMA(1, 0, At, B0); PG8_BAR; PG8_SCHED;
            PG8_STAGE(PG8_SB(1, 1), b3 + hstepB, voffB);
            PG8_WAIT_V(6); PG8_BAR; PG8_MMA(1, 1, At, B1); PG8_BAR;
        }
        E(acc, cur, wr, wc, fr, fq);
        if (!has_next) break;
#pragma unroll
        for (int a = 0; a < 2; ++a)
#pragma unroll
            for (int b = 0; b < 2; ++b)
#pragma unroll
                for (int m = 0; m < 4; ++m)
#pragma unroll
                    for (int n = 0; n < 2; ++n) acc[a][b][m][n] = (f32x4){0.f, 0.f, 0.f, 0.f};
        cur = nxt; cA = nA; cB = nB; ++ui;
        if constexpr (GATHER) { oc[0][0] = on[0][0]; oc[0][1] = on[0][1]; oc[1][0] = on[1][0]; oc[1][1] = on[1][1]; }
    }
    PG8_WAIT_V(0);
    if (wr == 0) PG8_BAR;
    PG8_BAR;
#undef PG8_SA
#undef PG8_SB
#undef PG8_STAGE
#undef PG8_STAGEG
#undef PG8_STAGEA_CUR
#undef PG8_STAGEA_SEL
#undef PG8_LDA
#undef PG8_LDB
#undef PG8_MMA
#undef PG8_WAIT_V
#undef PG8_WAIT_L
#undef PG8_BAR
#undef PG8_SCHED
#undef PG8_AOFF
}
}

typedef f32x4 AccT[2][2][4][2];

struct EpiProj {
    static constexpr bool PERM = true;
    const float* rs; bf16_t* QA; bf16_t* KA; float* G24;
    __device__ __forceinline__ void operator()(const AccT& acc, const pg8::Unit& u, int wr, int wc, int fr, int fq) const {
        const int row0 = u.pm * 256 + wr * 64 + fr;
        const int pn = u.pn;
        float rr[2][4];
#pragma unroll
        for (int ai = 0; ai < 2; ++ai)
#pragma unroll
            for (int m = 0; m < 4; ++m) rr[ai][m] = rs[row0 + ai * 128 + m * 16];
        if (pn == 0 || pn == 1 || pn == 3 || pn == 4) {
            bf16_t* Q = QA + (long)((pn >= 3) ? 1 : 0) * T_TOK * 512 + ((pn == 1 || pn == 4) ? 256 : 0) + wc * 32 + fq * 8;
#pragma unroll
            for (int ai = 0; ai < 2; ++ai)
#pragma unroll
                for (int m = 0; m < 4; ++m) {
                    const int row = row0 + ai * 128 + m * 16;
                    const float sc = rr[ai][m] * QSCALE;
#pragma unroll
                    for (int bj = 0; bj < 2; ++bj) {
                        const f32x4 v0 = acc[ai][bj][m][0], v1 = acc[ai][bj][m][1];
                        u32x4 w; w.x = cvt_pk_bf16(v0[0] * sc, v0[1] * sc); w.y = cvt_pk_bf16(v0[2] * sc, v0[3] * sc); w.z = cvt_pk_bf16(v1[0] * sc, v1[1] * sc); w.w = cvt_pk_bf16(v1[2] * sc, v1[3] * sc);
                        *(u32x4*)(Q + (long)row * 512 + bj * 128) = w;
                    }
                    __builtin_amdgcn_sched_barrier(0);
                }
        } else if (pn == 8) {
            if (wc == 0 && fq < 3) {
#pragma unroll
                for (int ai = 0; ai < 2; ++ai)
#pragma unroll
                    for (int m = 0; m < 4; ++m) {
                        const int row = row0 + ai * 128 + m * 16;
                        const float r = rr[ai][m];
                        const f32x4 v0 = acc[ai][0][m][0], v1 = acc[ai][0][m][1];
                        float* gp = G24 + (long)row * 32 + fq * 8;
                        *(f32x4*)gp = (f32x4){fast_sigmoid(v0[0] * r), fast_sigmoid(v0[1] * r), fast_sigmoid(v0[2] * r), fast_sigmoid(v0[3] * r)};
                        *(f32x4*)(gp + 4) = (f32x4){fast_sigmoid(v1[0] * r), fast_sigmoid(v1[1] * r), fast_sigmoid(v1[2] * r), fast_sigmoid(v1[3] * r)};
                        __builtin_amdgcn_sched_barrier(0);
                    }
            }
        } else {
            const int g = wc >> 1, d0 = (wc & 1) * 32 + fq * 8;
            const int kslot = (pn == 2) ? 0 : (pn == 5) ? 1 : (pn - 3), vslot = (pn == 2) ? 5 : (pn == 5) ? 2 : pn;
            bf16_t* Kd = KA + (long)kslot * (16 * SEQ * 64) + (long)g * SEQ * 64 + d0;
            bf16_t* Vd = KA + (long)vslot * (16 * SEQ * 64);
            Vd += (pn == 5) ? ((long)g * SEQ * 64 + d0) : ((long)(g * 64 + d0) * SEQ);
#pragma unroll
            for (int ai = 0; ai < 2; ++ai)
#pragma unroll
                for (int m = 0; m < 4; ++m) {
                    const int row = row0 + ai * 128 + m * 16;
                    const float r = rr[ai][m];
                    const int b = row >> 12, s = row & 4095;
                    {
                        const f32x4 v0 = acc[ai][0][m][0], v1 = acc[ai][0][m][1];
                        u32x4 w; w.x = cvt_pk_bf16(v0[0] * r, v0[1] * r); w.y = cvt_pk_bf16(v0[2] * r, v0[3] * r); w.z = cvt_pk_bf16(v1[0] * r, v1[1] * r); w.w = cvt_pk_bf16(v1[2] * r, v1[3] * r);
                        *(u32x4*)(Kd + ((long)b * 2 * SEQ + s) * 64) = w;
                    }
                    const f32x4 v0 = acc[ai][1][m][0], v1 = acc[ai][1][m][1];
                    if (pn == 5) {
                        u32x4 w; w.x = cvt_pk_bf16(v0[0] * r, v0[1] * r); w.y = cvt_pk_bf16(v0[2] * r, v0[3] * r); w.z = cvt_pk_bf16(v1[0] * r, v1[1] * r); w.w = cvt_pk_bf16(v1[2] * r, v1[3] * r);
                        *(u32x4*)(Vd + ((long)b * 2 * SEQ + s) * 64) = w;
                    } else {
                        bf16_t* vp = Vd + (long)b * 2 * 64 * SEQ + s;
#pragma unroll
                        for (int j = 0; j < 4; ++j) {
                            vp[(long)j * SEQ] = (bf16_t)(cvt_pk_bf16(v0[j] * r, 0.f) & 0xffffu);
                            vp[(long)(4 + j) * SEQ] = (bf16_t)(cvt_pk_bf16(v1[j] * r, 0.f) & 0xffffu);
                        }
                    }
                    __builtin_amdgcn_sched_barrier(0);
                }
        }
    }
};
struct EpiCmp1 {
    static constexpr bool PERM = true;
    const float* cb1; bf16_t* CHID;
    __device__ __forceinline__ void operator()(const AccT& acc, const pg8::Unit& u, int wr, int wc, int fr, int fq) const {
        const int row0 = u.pm * 256 + wr * 64 + fr;
        const float* cb = cb1 + u.pn * 256 + wc * 32 + fq * 8;
#pragma unroll
        for (int bj = 0; bj < 2; ++bj) {
            const f32x4 b0 = *(const f32x4*)(cb + bj * 128), b1 = *(const f32x4*)(cb + bj * 128 + 4);
#pragma unroll
            for (int ai = 0; ai < 2; ++ai)
#pragma unroll
                for (int m = 0; m < 4; ++m) {
                    const int row = row0 + ai * 128 + m * 16;
                    float y[8];
#pragma unroll
                    for (int j = 0; j < 4; ++j) { y[j] = acc[ai][bj][m][0][j] + b0[j]; y[4 + j] = acc[ai][bj][m][1][j] + b1[j]; }
#pragma unroll
                    for (int j = 0; j < 8; ++j) { const float x = y[j]; const float uu = 0.7978845608028654f * (x + 0.044715f * x * x * x); y[j] = x * fast_sigmoid(2.0f * uu); }
                    u32x4 w; w.x = cvt_pk_bf16(y[0], y[1]); w.y = cvt_pk_bf16(y[2], y[3]); w.z = cvt_pk_bf16(y[4], y[5]); w.w = cvt_pk_bf16(y[6], y[7]);
                    *(u32x4*)(CHID + (long)row * 256 + bj * 128 + wc * 32 + fq * 8) = w;
                    __builtin_amdgcn_sched_barrier(0);
                }
        }
    }
};
__device__ __forceinline__ void cmp_gemm2(const Params& p, int l, int pm) {
    asm volatile("s_waitcnt vmcnt(0)" ::: "memory");
    __syncthreads();
    __builtin_amdgcn_fence(__ATOMIC_ACQUIRE, "agent");
    asm volatile("s_waitcnt vmcnt(0)" ::: "memory");
    int tid = threadIdx.x; asm volatile("" : "+v"(tid));
    const int wave = tid >> 6, lane = tid & 63, fr = lane & 15, fq = lane >> 4;
    const int kv = pm >> 4, bg = pm & 15;
    const bf16_t* A = p.CHID + ((long)pm * 256 + wave * 32) * 256;
    const bf16_t* Bt = p.CW2T + ((long)(l * 2 + kv) * 64) * 256;
    f32x4 acc[2][4];
#pragma unroll
    for (int rt = 0; rt < 2; ++rt)
#pragma unroll
        for (int ct = 0; ct < 4; ++ct) acc[rt][ct] = (f32x4){0.f, 0.f, 0.f, 0.f};
#pragma unroll
    for (int ks = 0; ks < 8; ++ks) {
        bf16x8 af[2], bf[4];
#pragma unroll
        for (int rt = 0; rt < 2; ++rt) af[rt] = *(const bf16x8*)(A + (long)(rt * 16 + fr) * 256 + ks * 32 + fq * 8);
#pragma unroll
        for (int ct = 0; ct < 4; ++ct) bf[ct] = *(const bf16x8*)(Bt + (long)(ct * 16 + fr) * 256 + ks * 32 + fq * 8);
#pragma unroll
        for (int rt = 0; rt < 2; ++rt)
#pragma unroll
            for (int ct = 0; ct < 4; ++ct) acc[rt][ct] = __builtin_amdgcn_mfma_f32_16x16x32_bf16(af[rt], bf[ct], acc[rt][ct], 0, 0, 0);
    }
#pragma unroll
    for (int rt = 0; rt < 2; ++rt)
#pragma unroll
        for (int ct = 0; ct < 4; ++ct) {
            const int n = ct * 16 + fr, i0 = wave * 32 + rt * 16 + 4 * fq;
            f32x4 v = acc[rt][ct];
            if (i0 + 3 == 255) v[3] = 0.f;
            if (kv == 0) {
#pragma unroll
                for (int j = 0; j < 4; ++j) p.KCMP[((long)bg * 256 + i0 + j) * 64 + n] = (bf16_t)(cvt_pk_bf16(v[j], 0.f) & 0xffffu);
            } else {
                u32x2 w; w.x = cvt_pk_bf16(v[0], v[1]); w.y = cvt_pk_bf16(v[2], v[3]);
                *(u32x2*)(p.VCMPT + ((long)bg * 64 + n) * 256 + i0) = w;
            }
        }
}

#define AT_ROWB 144
#define AT_KT(b) ((b) * 9216)
#define AT_VT(b) (18432 + (b) * 9216)
#define AT_IMP 36864
#define AT_SEL (36864 + 4 * 64 * 66 * 4)
#define NEG_INF (-INFINITY)

struct AttSt { f32x16 O0, O1, CI; float m, l; };
__device__ __forceinline__ void att_init(AttSt& s, float cb = 0.f) {
#pragma unroll
    for (int i = 0; i < 16; ++i) { s.O0[i] = 0.f; s.O1[i] = 0.f; s.CI[i] = cb; }
    s.m = NEG_INF; s.l = 0.f;
}
__device__ __forceinline__ u32x4 at_gload(int tid, const bf16_t* base, long rstride) {
    const int row = tid >> 3, piece = tid & 7;
    return *(const u32x4*)(base + (long)row * rstride + piece * 8);
}
__device__ __forceinline__ void at_lwrite(int tid, LAS unsigned char* dst, u32x4 v) {
    const int row = tid >> 3, piece = tid & 7;
    *(LAS u32x4*)(dst + row * AT_ROWB + piece * 16) = v;
}
typedef __bf16 bf16x2n __attribute__((ext_vector_type(2)));
__device__ __forceinline__ unsigned pk_bf16_native(float lo, float hi) { bf16x2n v = {(__bf16)lo, (__bf16)hi}; return __builtin_bit_cast(unsigned, v); }
__device__ __forceinline__ float max3f(float a, float b, float c) { float r; asm("v_max3_f32 %0, %1, %2, %3" : "=v"(r) : "v"(a), "v"(b), "v"(c)); return r; }
__device__ __forceinline__ void at_scores(LAS const unsigned char* ktl, const bf16x8 (&qf)[4], f32x16& s0, f32x16& s1, const f32x16& ci) {
    bf16x8 kf[8];
#pragma unroll
    for (int s = 0; s < 4; ++s) { kf[2 * s] = *(LAS const bf16x8*)(ktl + s * 32); kf[2 * s + 1] = *(LAS const bf16x8*)(ktl + 32 * AT_ROWB + s * 32); }
    __builtin_amdgcn_sched_barrier(0);
    s0 = __builtin_amdgcn_mfma_f32_32x32x16_bf16(kf[0], qf[0], ci, 0, 0, 0);
    s1 = __builtin_amdgcn_mfma_f32_32x32x16_bf16(kf[1], qf[0], ci, 0, 0, 0);
#pragma unroll
    for (int s = 1; s < 4; ++s) {
        s0 = __builtin_amdgcn_mfma_f32_32x32x16_bf16(kf[2 * s], qf[s], s0, 0, 0, 0);
        s1 = __builtin_amdgcn_mfma_f32_32x32x16_bf16(kf[2 * s + 1], qf[s], s1, 0, 0, 0);
    }
}
__device__ __forceinline__ void at_scores0(LAS const unsigned char* ktl, const bf16x8 (&qf)[4], f32x16& s0, f32x16& s1) {
    f32x16 z;
#pragma unroll
    for (int i = 0; i < 16; ++i) z[i] = 0.f;
    at_scores(ktl, qf, s0, s1, z);
}
__device__ __forceinline__ void at_vload(LAS const unsigned char* vtl, bf16x8 (&vf)[8]) {
#pragma unroll
    for (int ks = 0; ks < 4; ++ks) { vf[2 * ks] = *(LAS const bf16x8*)(vtl + ks * 32); vf[2 * ks + 1] = *(LAS const bf16x8*)(vtl + 32 * AT_ROWB + ks * 32); }
}
template <bool MASKQ = false>
__device__ __forceinline__ void at_pv(const bf16x8 (&vf)[8], const f32x16& p0, const f32x16& p1, AttSt& st, bool mine = true) {
    bf16x8 pf[4];
#pragma unroll
    for (int sg = 0; sg < 2; ++sg) {
        u32x4 a, b;
        a.x = pk_bf16_native(p0[8 * sg + 0], p0[8 * sg + 1]); a.y = pk_bf16_native(p0[8 * sg + 2], p0[8 * sg + 3]); a.z = pk_bf16_native(p0[8 * sg + 4], p0[8 * sg + 5]); a.w = pk_bf16_native(p0[8 * sg + 6], p0[8 * sg + 7]);
        b.x = pk_bf16_native(p1[8 * sg + 0], p1[8 * sg + 1]); b.y = pk_bf16_native(p1[8 * sg + 2], p1[8 * sg + 3]); b.z = pk_bf16_native(p1[8 * sg + 4], p1[8 * sg + 5]); b.w = pk_bf16_native(p1[8 * sg + 6], p1[8 * sg + 7]);
        if (MASKQ) { a.x = mine ? a.x : 0u; a.y = mine ? a.y : 0u; a.z = mine ? a.z : 0u; a.w = mine ? a.w : 0u; b.x = mine ? b.x : 0u; b.y = mine ? b.y : 0u; b.z = mine ? b.z : 0u; b.w = mine ? b.w : 0u; }
        pf[sg] = __builtin_bit_cast(bf16x8, a); pf[2 + sg] = __builtin_bit_cast(bf16x8, b);
    }
#pragma unroll
    for (int ks = 0; ks < 4; ++ks) {
        st.O0 = __builtin_amdgcn_mfma_f32_32x32x16_bf16(vf[2 * ks], pf[ks], st.O0, 0, 0, 0);
        st.O1 = __builtin_amdgcn_mfma_f32_32x32x16_bf16(vf[2 * ks + 1], pf[ks], st.O1, 0, 0, 0);
    }
}
#define AT_THR 20.0f
template <bool MASKQ = false>
__device__ __forceinline__ void at_softmax_pv(LAS const unsigned char* vtl, f32x16& s0, f32x16& s1, AttSt& st, bool mine = true) {
    bf16x8 vf[8];
    at_vload(vtl, vf);
    __builtin_amdgcn_sched_barrier(0);
    float tm = fmaxf(s0[15], s1[15]);
#pragma unroll
    for (int i = 0; i < 15; ++i) tm = max3f(tm, s0[i], s1[i]);
    tm = half_swap_max(tm);
    if (MASKQ) tm = mine ? tm : NEG_INF;
    const bool unset = (st.m == NEG_INF);
    const bool need = unset ? (tm > NEG_INF) : (tm > AT_THR);
    if (__any(need)) {
        const float delta = need ? tm : 0.f;
        const float al = __builtin_amdgcn_exp2f(-delta);
#pragma unroll
        for (int i = 0; i < 16; ++i) { s0[i] -= delta; s1[i] -= delta; st.O0[i] *= al; st.O1[i] *= al; st.CI[i] -= delta; }
        st.l *= al;
        st.m = need ? ((unset ? 0.f : st.m) + delta) : st.m;
    }
    typedef float f32x2v __attribute__((ext_vector_type(2)));
    f32x2v ls = (f32x2v){0.f, 0.f};
#pragma unroll
    for (int i = 0; i < 16; ++i) { s0[i] = __builtin_amdgcn_exp2f(s0[i]); s1[i] = __builtin_amdgcn_exp2f(s1[i]); }
#pragma unroll
    for (int i = 0; i < 16; i += 2) { ls += (f32x2v){s0[i], s0[i + 1]}; ls += (f32x2v){s1[i], s1[i + 1]}; }
    const float lsum = ls.x + ls.y;
    st.l += MASKQ ? (mine ? lsum : 0.f) : lsum;
    at_pv<MASKQ>(vf, s0, s1, st, mine);
}
__device__ __forceinline__ void at_softmax_abs(f32x16& s0, f32x16& s1, AttSt& st) {
    float tm = fmaxf(s0[15], s1[15]);
#pragma unroll
    for (int i = 0; i < 15; ++i) tm = max3f(tm, s0[i], s1[i]);
    tm = half_swap_max(tm);
    const float mn = fmaxf(st.m, tm);
    const float al = (st.m == NEG_INF) ? 0.f : __builtin_amdgcn_exp2f(st.m - mn);
    const float mu = (mn == NEG_INF) ? 0.f : mn;
#pragma unroll
    for (int i = 0; i < 16; ++i) { st.O0[i] *= al; st.O1[i] *= al; }
    st.l *= al; st.m = mn;
    typedef float f32x2v __attribute__((ext_vector_type(2)));
    f32x2v ls = (f32x2v){0.f, 0.f};
#pragma unroll
    for (int i = 0; i < 16; ++i) { s0[i] = __builtin_amdgcn_exp2f(s0[i] - mu); s1[i] = __builtin_amdgcn_exp2f(s1[i] - mu); }
#pragma unroll
    for (int i = 0; i < 16; i += 2) { ls += (f32x2v){s0[i], s0[i + 1]}; ls += (f32x2v){s1[i], s1[i + 1]}; }
    st.l += ls.x + ls.y;
}
#define AT_KO(tau, reg) (32 * (tau) + 16 * ((reg) >> 3) + ((reg) & 7))

__device__ __forceinline__ void at_bias_table(f32x16& s0, f32x16& s1, LAS const float* tabl) {
#pragma unroll
    for (int i = 0; i < 16; ++i) { s0[i] += tabl[AT_KO(0, i)]; s1[i] += tabl[AT_KO(1, i)]; }
}
__device__ __forceinline__ void at_mask_gt(f32x16& s0, f32x16& s1, int thrl) {
#pragma unroll
    for (int i = 0; i < 16; ++i) { s0[i] = (AT_KO(0, i) > thrl) ? s0[i] : NEG_INF; s1[i] = (AT_KO(1, i) > thrl) ? s1[i] : NEG_INF; }
}
__device__ __forceinline__ void at_mask_lt(f32x16& s0, f32x16& s1, int thrl) {
#pragma unroll
    for (int i = 0; i < 16; ++i) { s0[i] = (AT_KO(0, i) < thrl) ? s0[i] : NEG_INF; s1[i] = (AT_KO(1, i) < thrl) ? s1[i] : NEG_INF; }
}
__device__ __forceinline__ void at_store(bf16_t* dst  , const AttSt& st, float scale, int hq) {
#pragma unroll
    for (int dl = 0; dl < 2; ++dl)
#pragma unroll
        for (int sg = 0; sg < 2; ++sg) {
            const f32x16& O = dl ? st.O1 : st.O0;
            u32x4 w;
            w.x = cvt_pk_bf16(O[8 * sg + 0] * scale, O[8 * sg + 1] * scale); w.y = cvt_pk_bf16(O[8 * sg + 2] * scale, O[8 * sg + 3] * scale);
            w.z = cvt_pk_bf16(O[8 * sg + 4] * scale, O[8 * sg + 5] * scale); w.w = cvt_pk_bf16(O[8 * sg + 6] * scale, O[8 * sg + 7] * scale);
            *(u32x4*)(dst + 32 * dl + 16 * sg + 8 * hq) = w;
        }
}
__device__ __forceinline__ int at_pi(int rho) { return (rho & 0x13) | ((rho & 4) << 1) | ((rho & 8) >> 1); }

__device__ __forceinline__ void build_tables(const Params& p, LAS unsigned char* lds) {
    LAS float* TR = (LAS float*)(lds + LDS_TAB_OFF);
    for (int e = threadIdx.x; e < 16 * 256; e += NTHR) {
        const int h = e >> 8, x = e & 255, dist = 191 - x;
        float v;
        if (dist < 0) v = NEG_INF;
        else if (dist < 128) v = (p.rel_bias[kBucket[dist] * 16 + h] - ((h < 8) ? 0.f : p.rel_bias[31 * 16 + h])) * LOG2E;
        else v = (h < 8) ? NEG_INF : 0.f;
        TR[e] = v;
    }
    __syncthreads();
}

#define AT_STEP(RKL, RVL, RKW, RVW, KB, KST, KRS, VB, VST, VRS, ...) { \
        { const int jl_ = (j + 3 < je_) ? j + 3 : je_; RKL = at_gload(tid, (KB) + (long)jl_ * (KST), (KRS)); RVL = at_gload(tid, (VB) + (long)jl_ * (VST), (VRS)); } \
        { const int buf = (j - j0_) & 1; __VA_ARGS__ \
          if (j < je_) { at_lwrite(tid, lds + AT_KT(buf ^ 1), RKW); at_lwrite(tid, lds + AT_VT(buf ^ 1), RVW); } } \
        __syncthreads(); \
        if (j == je_) break; \
        ++j; }
struct TileSets { u32x4 k0, v0, k1, v1, k2, v2; };
#define AT_PRELOAD(S, J0, JE, KB, KST, KRS, VB, VST, VRS) { \
        const int a_ = (J0), e_ = (JE); const int b_ = (a_ + 1 < e_) ? a_ + 1 : e_, c_ = (a_ + 2 < e_) ? a_ + 2 : e_; \
        S.k0 = at_gload(tid, (KB) + (long)a_ * (KST), (KRS)); S.v0 = at_gload(tid, (VB) + (long)a_ * (VST), (VRS)); \
        S.k1 = at_gload(tid, (KB) + (long)b_ * (KST), (KRS)); S.v1 = at_gload(tid, (VB) + (long)b_ * (VST), (VRS)); \
        S.k2 = at_gload(tid, (KB) + (long)c_ * (KST), (KRS)); S.v2 = at_gload(tid, (VB) + (long)c_ * (VST), (VRS)); }
#define AT_LOOP_FROM(S, J0, JE, KB, KST, KRS, VB, VST, VRS, ...) { \
        const int j0_ = (J0), je_ = (JE); \
        at_lwrite(tid, lds + AT_KT(0), S.k0); at_lwrite(tid, lds + AT_VT(0), S.v0); \
        __syncthreads(); \
        for (int j = j0_;;) { \
            AT_STEP(S.k0, S.v0, S.k1, S.v1, KB, KST, KRS, VB, VST, VRS, __VA_ARGS__) \
            AT_STEP(S.k1, S.v1, S.k2, S.v2, KB, KST, KRS, VB, VST, VRS, __VA_ARGS__) \
            AT_STEP(S.k2, S.v2, S.k0, S.v0, KB, KST, KRS, VB, VST, VRS, __VA_ARGS__) \
        } }

__device__ __forceinline__ void attn_aw_unit(const Params& p, int l, int b, int g, int c, LAS unsigned char* lds) {
    int tid = threadIdx.x; asm volatile("" : "+v"(tid));
    const int wave = tid >> 6, lane = tid & 63, r = wave & 3, th = wave >> 2, hq = lane >> 5, ql = lane & 31;
    const int h = g * 4 + r, bg = b * 2 + g;
    const int tl = 32 * th + ql;
    const long tok = (long)b * SEQ + 64 * c + tl;
    LAS const unsigned char* ktl = lds + at_pi(ql) * AT_ROWB + 16 * hq;
    LAS const unsigned char* vtl = lds + at_pi(ql) * AT_ROWB + 16 * hq;
    LAS const float* TR = (LAS const float*)(lds + LDS_TAB_OFF);
    bf16x8 qf[4], qfb[4];
    AttSt st;
    const bf16_t* KAp = p.KA + (long)bg * SEQ * 64; const bf16_t* VAp = p.VAT + (long)bg * 64 * SEQ;
    const bf16_t* KWp = p.KW + (long)bg * SEQ * 64; const bf16_t* VWp = p.VWT + (long)bg * 64 * SEQ;
    const int ja0 = (c - 2 < 0) ? 0 : c - 2, jw0 = (c - 8 < 0) ? 0 : c - 8;
    TileSets SA, SW;
#pragma unroll
    for (int s = 0; s < 4; ++s) qf[s] = *(const bf16x8*)(p.QA + tok * 512 + h * 64 + 16 * s + 8 * hq);
    AT_PRELOAD(SA, ja0, c, KAp, 4096, 64, VAp, 64, SEQ)
#pragma unroll
    for (int s = 0; s < 4; ++s) qfb[s] = *(const bf16x8*)(p.QB + tok * 512 + h * 64 + 16 * s + 8 * hq);
    AT_PRELOAD(SW, jw0, c, KWp, 4096, 64, VWp, 64, SEQ)
    const float gwin = p.G24[tok * 32 + h * 3 + 2];
    const float sinkv = p.a_sinks[l * 8 + h] * LOG2E;
    const float cbw = p.rel_bias[31 * 16 + 8 + h] * LOG2E;
    {
        att_init(st);
        AT_LOOP_FROM(SA, ja0, c, KAp, 4096, 64, VAp, 64, SEQ, {
            f32x16 s0, s1;
            at_scores(ktl + AT_KT(buf), qf, s0, s1, st.CI);
            const int drel = 64 * (c - j) + tl;
            at_bias_table(s0, s1, TR + h * 256 + (191 - drel + 8 * hq));
            at_softmax_pv(vtl + AT_VT(buf), s0, s1, st); })
        float lt = half_swap_sum(st.l);
        lt += __builtin_amdgcn_exp2f(sinkv - st.m);
        at_store(p.OAB + tok * 1024 + h * 64, st, 1.0f / lt, hq);
    }
    {
        att_init(st, cbw);
        AT_LOOP_FROM(SW, jw0, c, KWp, 4096, 64, VWp, 64, SEQ, {
            f32x16 s0, s1;
            at_scores(ktl + AT_KT(buf), qfb, s0, s1, st.CI);
            if (j >= c - 2) {
                const int drel = 64 * (c - j) + tl;
                at_bias_table(s0, s1, TR + (8 + h) * 256 + (191 - drel + 8 * hq));
            } else if (j == c - 8) at_mask_gt(s0, s1, tl - 8 * hq);
            at_softmax_pv(vtl + AT_VT(buf), s0, s1, st); })
        const float lt = half_swap_sum(st.l);
        at_store(p.OW + tok * 512 + h * 64, st, gwin / lt, hq);
    }
}

__device__ __forceinline__ void attn_cs_unit(const Params& p, int b, int g, int c, LAS unsigned char* lds) {
    int tid = threadIdx.x; asm volatile("" : "+v"(tid));
    const int wave = tid >> 6, lane = tid & 63, r = wave & 3, th = wave >> 2, hq = lane >> 5, ql = lane & 31;
    const int h = g * 4 + r, bg = b * 2 + g;
    const int tl = 32 * th + ql, tq = 64 * c + tl;
    const long tok = (long)b * SEQ + tq;
    LAS const unsigned char* ktl = lds + at_pi(ql) * AT_ROWB + 16 * hq;
    LAS const unsigned char* vtl = lds + at_pi(ql) * AT_ROWB + 16 * hq;
    LAS const float* TR = (LAS const float*)(lds + LDS_TAB_OFF);
    LAS float* IMP = (LAS float*)(lds + AT_IMP);
    LAS unsigned long long* SEL = (LAS unsigned long long*)(lds + AT_SEL);
    bf16x8 qf[4];
#pragma unroll
    for (int s = 0; s < 4; ++s) qf[s] = *(const bf16x8*)(p.QB + tok * 512 + h * 64 + 16 * s + 8 * hq);
    const int nv = (tq >= 31) ? ((tq - 31) / 16 + 1) : 0;
    const int nv_hi = (64 * c + 63 - 31) / 16 + 1;
    const int ntile = (nv_hi + 63) / 64;
    const bf16_t* KC = p.KCMP + (long)bg * 256 * 64; const bf16_t* VCT = p.VCMPT + (long)bg * 64 * 256;
    const bf16_t* KSp = p.KS + (long)bg * SEQ * 64; const bf16_t* VSp = p.VST + (long)bg * 64 * SEQ;
    TileSets S1, S2;
    AT_PRELOAD(S2, 0, ntile - 1, KC, 4096, 64, VCT, 64, 256)
    AttSt st; att_init(st);
    float imp_carry = 0.f, rf0 = NEG_INF, rf1 = NEG_INF, rf2 = NEG_INF, rf3 = NEG_INF;
    LAS float* IMF = (LAS float*)(lds + AT_SEL + 512);
    AT_LOOP_FROM(S2, 0, ntile - 1, KC, 4096, 64, VCT, 64, 256, {
        f32x16 s0, s1;
        at_scores0(ktl + AT_KT(buf), qf, s0, s1);
        at_mask_lt(s0, s1, nv - 64 * j - 8 * hq);
        const float mb = st.m;
        at_softmax_abs(s0, s1, st);
        if (j == 0) rf0 = st.m; else if (j == 1) rf1 = st.m; else if (j == 2) rf2 = st.m; else rf3 = st.m;
        imp_carry *= (mb == NEG_INF) ? 0.f : __builtin_amdgcn_exp2f(mb - st.m);
        if (c >= 16) { float G0[4], G1[4];
          _Pragma("unroll") for (int a = 0; a < 4; ++a) { G0[a] = (s0[4 * a] + s0[4 * a + 1]) + (s0[4 * a + 2] + s0[4 * a + 3]); G1[a] = (s1[4 * a] + s1[4 * a + 1]) + (s1[4 * a + 2] + s1[4 * a + 3]); }
          const float r01 = half_other(s0[7], hq), r03 = half_other(s0[15], hq), r11 = half_other(s1[7], hq), r13 = half_other(s1[15], hq);
          LAS float* irow = IMP + (r * 64 + tl) * 66 + 16 * j + 2 * hq;
          irow[0]  = G0[0] + (hq ? r01 : imp_carry);
          irow[1]  = G0[1] + s0[3];
          irow[4]  = G0[2] + (hq ? r03 : r01);
          irow[5]  = G0[3] + s0[11];
          irow[8]  = G1[0] + (hq ? r11 : r03);
          irow[9]  = G1[1] + s1[3];
          irow[12] = G1[2] + (hq ? r13 : r11);
          irow[13] = G1[3] + s1[11];
          imp_carry = r13; }
        { bf16x8 vf[8]; at_vload(vtl + AT_VT(buf), vf); at_pv(vf, s0, s1, st); } })
    AT_PRELOAD(S1, 0, c, KSp, 4096, 64, VSp, 64, SEQ)
    const float g0 = p.G24[tok * 32 + h * 3 + 0], g1 = p.G24[tok * 32 + h * 3 + 1];
    const float cbs = p.rel_bias[31 * 16 + 8 + h] * LOG2E;
    u32x4 owp[4];
#pragma unroll
    for (int q4 = 0; q4 < 4; ++q4) owp[q4] = *(const u32x4*)(p.OW + tok * 512 + h * 64 + 32 * (q4 >> 1) + 16 * (q4 & 1) + 8 * hq);
    const float l1 = half_swap_sum(st.l);
    const float inv1 = (l1 > 0.f) ? 1.0f / l1 : 0.f;
    if (c >= 16) {
        if (hq == 0) {
            LAS float* fr = IMF + (r * 64 + tl) * 4;
            fr[0] = (rf0 == NEG_INF) ? 0.f : __builtin_amdgcn_exp2f(rf0 - st.m) * inv1; fr[1] = (rf1 == NEG_INF) ? 0.f : __builtin_amdgcn_exp2f(rf1 - st.m) * inv1;
            fr[2] = (rf2 == NEG_INF) ? 0.f : __builtin_amdgcn_exp2f(rf2 - st.m) * inv1; fr[3] = (rf3 == NEG_INF) ? 0.f : __builtin_amdgcn_exp2f(rf3 - st.m) * inv1;
        }
        __syncthreads();
    }
    const float g0n = g0 * inv1;
    unsigned long long mysel;
    if (c < 16) {
        mysel = (2ull << c) - 1ull;
    } else {
        const int js = lane, tb = c;
        const bool causal = js <= tb, forced = (js == 0) || (js == tb) || (js == tb - 1);
        const bool cand = causal && !forced;
        const unsigned long long mforced = __ballot(causal && forced), mcand = __ballot(cand);
        const int want = 16 - __builtin_popcountll(mforced);
#pragma unroll 1
        for (int k = 0; k < 8; k += 2) {
            const int t = 8 * wave + k;
            const int jt = js >> 4;
            const unsigned va = __float_as_uint((IMP[t * 66 + js] * IMF[t * 4 + jt] + IMP[(64 + t) * 66 + js] * IMF[(64 + t) * 4 + jt]) + (IMP[(128 + t) * 66 + js] * IMF[(128 + t) * 4 + jt] + IMP[(192 + t) * 66 + js] * IMF[(192 + t) * 4 + jt]));
            const unsigned vc = __float_as_uint((IMP[(t + 1) * 66 + js] * IMF[(t + 1) * 4 + jt] + IMP[(65 + t) * 66 + js] * IMF[(65 + t) * 4 + jt]) + (IMP[(129 + t) * 66 + js] * IMF[(129 + t) * 4 + jt] + IMP[(193 + t) * 66 + js] * IMF[(193 + t) * 4 + jt]));
            unsigned Ta = 0u, Tc = 0u; bool da = false, dc = false;
            unsigned long long msa = 0ull, msc = 0ull;
#pragma unroll 1
            for (int bit = 30; bit >= 0; --bit) {
                const unsigned tra = Ta | (1u << bit), trc = Tc | (1u << bit);
                const unsigned long long mga = __ballot(cand && va >= tra), mgc = __ballot(cand && vc >= trc);
                const int ca = __builtin_popcountll(mga), cc = __builtin_popcountll(mgc);
                if (!da) { if (ca == want) { msa = mga; da = true; } else Ta = (ca > want) ? tra : Ta; }
                if (!dc) { if (cc == want) { msc = mgc; dc = true; } else Tc = (cc > want) ? trc : Tc; }
                if (da && dc) break;
            }
            if (!da) {
                const unsigned long long mgt = __ballot(cand && va > Ta), meq = __ballot(cand && va == Ta);
                const int rq = want - __builtin_popcountll(mgt);
                const int below = __builtin_amdgcn_mbcnt_hi((unsigned)(meq >> 32), __builtin_amdgcn_mbcnt_lo((unsigned)meq, 0));
                msa = mgt | __ballot(cand && va == Ta && below < rq);
            }
            if (!dc) {
                const unsigned long long mgt = __ballot(cand && vc > Tc), meq = __ballot(cand && vc == Tc);
                const int rq = want - __builtin_popcountll(mgt);
                const int below = __builtin_amdgcn_mbcnt_hi((unsigned)(meq >> 32), __builtin_amdgcn_mbcnt_lo((unsigned)meq, 0));
                msc = mgt | __ballot(cand && vc == Tc && below < rq);
            }
            if (lane == 0) { SEL[t] = msa | mforced; SEL[t + 1] = msc | mforced; }
        }
        __syncthreads();
        mysel = SEL[tl];
    }
    u32x4 part[4];
#pragma unroll
    for (int dl = 0; dl < 2; ++dl)
#pragma unroll
        for (int sg = 0; sg < 2; ++sg) {
            const f32x16& O = dl ? st.O1 : st.O0;
            const u32x4 wv = owp[dl * 2 + sg];
            u32x4 w;
            w.x = cvt_pk_bf16(O[8 * sg + 0] * g0n + bf16lo(wv.x), O[8 * sg + 1] * g0n + bf16hi(wv.x)); w.y = cvt_pk_bf16(O[8 * sg + 2] * g0n + bf16lo(wv.y), O[8 * sg + 3] * g0n + bf16hi(wv.y));
            w.z = cvt_pk_bf16(O[8 * sg + 4] * g0n + bf16lo(wv.z), O[8 * sg + 5] * g0n + bf16hi(wv.z)); w.w = cvt_pk_bf16(O[8 * sg + 6] * g0n + bf16lo(wv.w), O[8 * sg + 7] * g0n + bf16hi(wv.w));
            part[dl * 2 + sg] = w;
        }
    {
        att_init(st, cbs);
        AT_LOOP_FROM(S1, 0, c, KSp, 4096, 64, VSp, 64, SEQ, {
            const bool mine = (mysel >> j) & 1ull;
            if (__ballot(mine) != 0ull) {
                f32x16 s0, s1;
                at_scores(ktl + AT_KT(buf), qf, s0, s1, st.CI);
                if (j >= c - 2) {
                    const int drel = 64 * (c - j) + tl;
                    at_bias_table(s0, s1, TR + (8 + h) * 256 + (191 - drel + 8 * hq));
                }
                at_softmax_pv<true>(vtl + AT_VT(buf), s0, s1, st, mine);
            } })
        const float lt = half_swap_sum(st.l);
        const float g1l = g1 / lt;
        bf16_t* dst = p.OAB + tok * 1024 + 512 + h * 64;
#pragma unroll
        for (int dl = 0; dl < 2; ++dl)
#pragma unroll
            for (int sg = 0; sg < 2; ++sg) {
                const f32x16& O = dl ? st.O1 : st.O0;
                const u32x4 wv = part[dl * 2 + sg];
                u32x4 w;
                w.x = cvt_pk_bf16(O[8 * sg + 0] * g1l + bf16lo(wv.x), O[8 * sg + 1] * g1l + bf16hi(wv.x)); w.y = cvt_pk_bf16(O[8 * sg + 2] * g1l + bf16lo(wv.y), O[8 * sg + 3] * g1l + bf16hi(wv.y));
                w.z = cvt_pk_bf16(O[8 * sg + 4] * g1l + bf16lo(wv.z), O[8 * sg + 5] * g1l + bf16hi(wv.z)); w.w = cvt_pk_bf16(O[8 * sg + 6] * g1l + bf16lo(wv.w), O[8 * sg + 7] * g1l + bf16hi(wv.w));
                *(u32x4*)(dst + 32 * dl + 16 * sg + 8 * hq) = w;
            }
    }
}
struct EpiGate {
    static constexpr bool PERM = true;
    const float* rs; bf16_t* DST;
    __device__ __forceinline__ void operator()(const AccT& acc, const pg8::Unit& u, int wr, int wc, int fr, int fq) const {
        const int row0 = u.pm * 256 + wr * 64 + fr;
        float rr[2][4];
#pragma unroll
        for (int ai = 0; ai < 2; ++ai)
#pragma unroll
            for (int m = 0; m < 4; ++m) rr[ai][m] = rs[row0 + ai * 128 + m * 16];
#pragma unroll
        for (int ai = 0; ai < 2; ++ai)
#pragma unroll
            for (int m = 0; m < 4; ++m) {
                const float r = rr[ai][m];
                bf16_t* dp = DST + (long)(row0 + ai * 128 + m * 16) * 1024 + u.pn * 256 + wc * 32 + fq * 8;
#pragma unroll
                for (int bj = 0; bj < 2; ++bj) {
                    const f32x4 v0 = acc[ai][bj][m][0], v1 = acc[ai][bj][m][1];
                    u32x4 w; w.x = cvt_pk_bf16(fast_sigmoid(v0[0] * r), fast_sigmoid(v0[1] * r)); w.y = cvt_pk_bf16(fast_sigmoid(v0[2] * r), fast_sigmoid(v0[3] * r));
                    w.z = cvt_pk_bf16(fast_sigmoid(v1[0] * r), fast_sigmoid(v1[1] * r)); w.w = cvt_pk_bf16(fast_sigmoid(v1[2] * r), fast_sigmoid(v1[3] * r));
                    *(u32x4*)(dp + bj * 128) = w;
                    __builtin_amdgcn_sched_barrier(0);
                }
            }
    }
};
struct EpiMerge2 {
    static constexpr bool PERM = true;
    bf16_t* MERGED; const bf16_t* GB;
    static __device__ __forceinline__ float gclamp(float g) { return fmaxf(g, 1e-30f); }
    __device__ __forceinline__ void mid(AccT& acc, const pg8::Unit& u, int wr, int wc, int fr, int fq) const {
        int row0 = u.pm * 256 + wr * 64 + fr;
        asm volatile("" : "+v"(row0));
        const long cbase = (long)u.pn * 256 + wc * 32 + fq * 8;
        u32x4 ac[2], bc[2], an[2], bn[2];
#pragma unroll
        for (int bj = 0; bj < 2; ++bj) {
            ac[bj] = *(const u32x4*)(MERGED + (long)row0 * 1024 + cbase + bj * 128); bc[bj] = *(const u32x4*)(GB + (long)row0 * 1024 + cbase + bj * 128);
            an[bj] = ac[bj]; bn[bj] = bc[bj];
        }
#pragma unroll
        for (int i = 0; i < 8; ++i) {
            const int ai = i >> 2, m = i & 3;
            if (i < 7) {
                const long on = (long)(row0 + ((i + 1) >> 2) * 128 + ((i + 1) & 3) * 16) * 1024 + cbase;
#pragma unroll
                for (int bj = 0; bj < 2; ++bj) { an[bj] = *(const u32x4*)(MERGED + on + bj * 128); bn[bj] = *(const u32x4*)(GB + on + bj * 128); }
            }
#pragma unroll
            for (int bj = 0; bj < 2; ++bj) {
                const u32x4 a = ac[bj], b = bc[bj];
                f32x4& v0 = acc[ai][bj][m][0]; f32x4& v1 = acc[ai][bj][m][1];
                v0[0] *= bf16lo(a.x) * __builtin_amdgcn_rcpf(gclamp(bf16lo(b.x))); v0[1] *= bf16hi(a.x) * __builtin_amdgcn_rcpf(gclamp(bf16hi(b.x)));
                v0[2] *= bf16lo(a.y) * __builtin_amdgcn_rcpf(gclamp(bf16lo(b.y))); v0[3] *= bf16hi(a.y) * __builtin_amdgcn_rcpf(gclamp(bf16hi(b.y)));
                v1[0] *= bf16lo(a.z) * __builtin_amdgcn_rcpf(gclamp(bf16lo(b.z))); v1[1] *= bf16hi(a.z) * __builtin_amdgcn_rcpf(gclamp(bf16hi(b.z)));
                v1[2] *= bf16lo(a.w) * __builtin_amdgcn_rcpf(gclamp(bf16lo(b.w))); v1[3] *= bf16hi(a.w) * __builtin_amdgcn_rcpf(gclamp(bf16hi(b.w)));
            }
#pragma unroll
            for (int bj = 0; bj < 2; ++bj) { ac[bj] = an[bj]; bc[bj] = bn[bj]; }
            __builtin_amdgcn_sched_barrier(0);
        }
    }
    __device__ __forceinline__ void operator()(const AccT& acc, const pg8::Unit& u, int wr, int wc, int fr, int fq) const {
        const int row0 = u.pm * 256 + wr * 64 + fr;
        const long cbase = (long)u.pn * 256 + wc * 32 + fq * 8;
        u32x4 gc[2], gn[2];
#pragma unroll
        for (int bj = 0; bj < 2; ++bj) { gc[bj] = *(const u32x4*)(GB + (long)row0 * 1024 + cbase + bj * 128); gn[bj] = gc[bj]; }
#pragma unroll
        for (int i = 0; i < 8; ++i) {
            const int ai = i >> 2, m = i & 3;
            const long o = (long)(row0 + ai * 128 + m * 16) * 1024 + cbase;
            if (i < 7) {
                const long on = (long)(row0 + ((i + 1) >> 2) * 128 + ((i + 1) & 3) * 16) * 1024 + cbase;
#pragma unroll
                for (int bj = 0; bj < 2; ++bj) gn[bj] = *(const u32x4*)(GB + on + bj * 128);
            }
#pragma unroll
            for (int bj = 0; bj < 2; ++bj) {
                const f32x4 v0 = acc[ai][bj][m][0], v1 = acc[ai][bj][m][1];
                const u32x4 gg = gc[bj];
                u32x4 w;
                w.x = cvt_pk_bf16(gclamp(bf16lo(gg.x)) * v0[0], gclamp(bf16hi(gg.x)) * v0[1]); w.y = cvt_pk_bf16(gclamp(bf16lo(gg.y)) * v0[2], gclamp(bf16hi(gg.y)) * v0[3]);
                w.z = cvt_pk_bf16(gclamp(bf16lo(gg.z)) * v1[0], gclamp(bf16hi(gg.z)) * v1[1]); w.w = cvt_pk_bf16(gclamp(bf16lo(gg.w)) * v1[2], gclamp(bf16hi(gg.w)) * v1[3]);
                *(u32x4*)(MERGED + o + bj * 128) = w;
            }
#pragma unroll
            for (int bj = 0; bj < 2; ++bj) gc[bj] = gn[bj];
            __builtin_amdgcn_sched_barrier(0);
        }
    }
};
struct EpiOut {
    static constexpr bool PERM = true;
    bf16_t* HB; float* ssq16;
    __device__ __forceinline__ void operator()(const AccT& acc, const pg8::Unit& u, int wr, int wc, int fr, int fq) const {
        const int row0 = u.pm * 256 + wr * 64 + fr;
        const long cbase = (long)u.pn * 256 + wc * 32 + fq * 8;
        u32x4 cur[2], nxt[2];
#pragma unroll
        for (int bj = 0; bj < 2; ++bj) cur[bj] = *(const u32x4*)(HB + (long)row0 * 1024 + cbase + bj * 128);
#pragma unroll
        for (int i = 0; i < 8; ++i) {
            const int ai = i >> 2, m = i & 3;
            const int row = row0 + ai * 128 + m * 16;
            if (i < 7) {
                const int rown = row0 + ((i + 1) >> 2) * 128 + ((i + 1) & 3) * 16;
#pragma unroll
                for (int bj = 0; bj < 2; ++bj) nxt[bj] = *(const u32x4*)(HB + (long)rown * 1024 + cbase + bj * 128);
            }
            float ss = 0.f;
#pragma unroll
            for (int bj = 0; bj < 2; ++bj) {
                const long oo = (long)row * 1024 + cbase + bj * 128;
                const u32x4 c = cur[bj];
                const f32x4 h0 = {bf16lo(c.x), bf16hi(c.x), bf16lo(c.y), bf16hi(c.y)}, h1 = {bf16lo(c.z), bf16hi(c.z), bf16lo(c.w), bf16hi(c.w)};
                const f32x4 v0 = h0 + acc[ai][bj][m][0], v1 = h1 + acc[ai][bj][m][1];
                u32x4 w; w.x = cvt_pk_bf16(v0[0], v0[1]); w.y = cvt_pk_bf16(v0[2], v0[3]); w.z = cvt_pk_bf16(v1[0], v1[1]); w.w = cvt_pk_bf16(v1[2], v1[3]);
                *(u32x4*)(HB + oo) = w;
                ss += ((v0[0] * v0[0] + v0[1] * v0[1]) + (v0[2] * v0[2] + v0[3] * v0[3])) + ((v1[0] * v1[0] + v1[1] * v1[1]) + (v1[2] * v1[2] + v1[3] * v1[3]));
            }
            ss += swz_xor<16>(ss); ss = half_swap_sum(ss);
            if (fq == 0) ssq16[(long)row * 16 + u.pn * 4 + wc] = ss;
#pragma unroll
            for (int bj = 0; bj < 2; ++bj) cur[bj] = nxt[bj];
            __builtin_amdgcn_sched_barrier(0);
        }
    }
};

__device__ __forceinline__ void gates24_phase(const Params& p, int l, LAS unsigned char* lds) {
    constexpr int WROW = 136;
    LAS bf16_t* WB = (LAS bf16_t*)lds;
    int tid = threadIdx.x; asm volatile("" : "+v"(tid));
    const int wave = tid >> 6, lane = tid & 63, fr = lane & 15, kq = lane >> 4;
    const bf16_t* W = p.WinT + ((long)l * 4352 + 2048) * 1024;
    for (int tile = blockIdx.x; tile < T_TOK / 128; tile += gridDim.x) {
        const long t0 = (long)tile * 128;
        const bf16_t* xrow = p.HB + (t0 + wave * 16 + fr) * DM + kq * 8;
        f32x4 acc[2];
#pragma unroll
        for (int ct = 0; ct < 2; ++ct) acc[ct] = (f32x4){0.f, 0.f, 0.f, 0.f};
        for (int kc = 0; kc < 1024; kc += 128) {
            bf16x8 xv[4];
#pragma unroll
            for (int ks = 0; ks < 4; ++ks) xv[ks] = *(const bf16x8*)(xrow + kc + ks * 32);
            __syncthreads();
            { const int row = tid >> 4, piece = tid & 15;
              const u32x4 v = *(const u32x4*)(W + (long)row * 1024 + kc + piece * 8);
              *(LAS u32x4*)(WB + row * WROW + piece * 8) = v; }
            __syncthreads();
#pragma unroll
            for (int ks = 0; ks < 4; ++ks)
#pragma unroll
                for (int ct = 0; ct < 2; ++ct) {
                    const bf16x8 bw = *(LAS const bf16x8*)(WB + (ct * 16 + fr) * WROW + ks * 32 + kq * 8);
                    acc[ct] = __builtin_amdgcn_mfma_f32_16x16x32_bf16(xv[ks], bw, acc[ct], 0, 0, 0);
                }
        }
#pragma unroll
        for (int j = 0; j < 4; ++j) {
            const long t = t0 + wave * 16 + 4 * kq + j;
            const float r = p.rsA[t];
            p.G24[t * 32 + fr] = fast_sigmoid(acc[0][j] * r);
            if (fr < 8) p.G24[t * 32 + 16 + fr] = fast_sigmoid(acc[1][j] * r);
        }
    }
    __syncthreads();
}
typedef __bf16 bf16x8n __attribute__((ext_vector_type(8)));
__device__ __forceinline__ void router_phase(const Params& p, int l, LAS unsigned char* lds) {
    constexpr int WROW = 136;
    LAS bf16_t* WB = (LAS bf16_t*)lds;
    LAS float* LG = (LAS float*)(lds + 2 * 48 * WROW * 2);
    LAS int* HIST = (LAS int*)(lds + 2 * 48 * WROW * 2 + 128 * 37 * 4);
    int tid = threadIdx.x; asm volatile("" : "+v"(tid));
    const int wave = tid >> 6, lane = tid & 63, fr = lane & 15, kq = lane >> 4;
    const bf16_t* WH = p.WRH + (long)l * 48 * 1024; const bf16_t* WL = p.WRL + (long)l * 48 * 1024;
    if (blockIdx.x == 0 && tid == 0) p.rsB[T_TOK] = 1.0f;
    for (int tile = blockIdx.x; tile < T_TOK / 128; tile += gridDim.x) {
        const long t0 = (long)tile * 128;
        const bf16_t* xrow = p.HB + (t0 + wave * 16 + fr) * DM + kq * 8;
        f32x4 acc[3];
#pragma unroll
        for (int ct = 0; ct < 3; ++ct) acc[ct] = (f32x4){0.f, 0.f, 0.f, 0.f};
        if (tid < 32) HIST[tid] = 0;
        for (int kc = 0; kc < 1024; kc += 128) {
            bf16x8 xv[4];
#pragma unroll
            for (int ks = 0; ks < 4; ++ks) xv[ks] = *(const bf16x8*)(xrow + kc + ks * 32);
            __syncthreads();
#pragma unroll
            for (int i = 0; i < 3; ++i) {
                const int idx = tid + 512 * i, part = idx / 768, rem = idx % 768, row = rem >> 4, piece = rem & 15;
                const u32x4 v = *(const u32x4*)((part ? WL : WH) + (long)row * 1024 + kc + piece * 8);
                *(LAS u32x4*)(WB + (part * 48 + row) * WROW + piece * 8) = v;
            }
            __syncthreads();
#pragma unroll
            for (int ks = 0; ks < 4; ++ks) {
#pragma unroll
                for (int ct = 0; ct < 3; ++ct) {
                    const bf16x8 bh = *(LAS const bf16x8*)(WB + (ct * 16 + fr) * WROW + ks * 32 + kq * 8);
                    const bf16x8 bl = *(LAS const bf16x8*)(WB + (48 + ct * 16 + fr) * WROW + ks * 32 + kq * 8);
                    acc[ct] = __builtin_amdgcn_mfma_f32_16x16x32_bf16(xv[ks], bh, acc[ct], 0, 0, 0);
                    acc[ct] = __builtin_amdgcn_mfma_f32_16x16x32_bf16(xv[ks], bl, acc[ct], 0, 0, 0);
                }
            }
        }
#pragma unroll
        for (int ct = 0; ct < 3; ++ct) {
            const int n = ct * 16 + fr;
            if (n < 36) {
#pragma unroll
                for (int j = 0; j < 4; ++j) LG[(wave * 16 + 4 * kq + j) * 37 + n] = acc[ct][j];
            }
        }
        __syncthreads();
        if (tid < 128) {
            const long t = t0 + tid;
            float ss = 0.f;
#pragma unroll
            for (int i = 0; i < 4; ++i) { const float4 q = *(const float4*)(p.ssq16 + t * 16 + i * 4); ss += (q.x + q.y) + (q.z + q.w); }
            const float r = rsqrtf(ss * (1.0f / DM) + 1e-5f);
            p.rsB[t] = r;
            float gl[4]; int gs = 0; float gmax;
#pragma unroll
            for (int j = 0; j < 4; ++j) gl[j] = LG[tid * 37 + j] * r + p.b_group[l * 4 + j];
            gmax = gl[0];
#pragma unroll
            for (int j = 1; j < 4; ++j) if (gl[j] > gmax) { gmax = gl[j]; gs = j; }
            float den = 0.f;
#pragma unroll
            for (int j = 0; j < 4; ++j) den += __expf(gl[j] - gmax);
            const float gw = 1.0f / den;
            float el[8];
#pragma unroll
            for (int j = 0; j < 8; ++j) el[j] = LG[tid * 37 + 4 + gs * 8 + j] * r + p.b_expert[l * 32 + gs * 8 + j];
            int i0 = 0; float v0 = el[0];
#pragma unroll
            for (int j = 1; j < 8; ++j) if (el[j] > v0) { v0 = el[j]; i0 = j; }
            int i1 = -1; float v1 = NEG_INF;
#pragma unroll
            for (int j = 0; j < 8; ++j) if (j != i0 && (i1 < 0 || el[j] > v1)) { v1 = el[j]; i1 = j; }
            const float ex = __expf(v1 - v0);
            const float w0 = 1.0f / (1.0f + ex), w1 = ex / (1.0f + ex);
            const int e0 = gs * 8 + i0, e1 = gs * 8 + i1;
            p.eid[t * 2] = e0; p.eid[t * 2 + 1] = e1;
            p.ew[t * 2] = w0 * gw; p.ew[t * 2 + 1] = w1 * gw;
            __hip_atomic_fetch_add(HIST + e0, 1, __ATOMIC_RELAXED, __HIP_MEMORY_SCOPE_WORKGROUP);
            __hip_atomic_fetch_add(HIST + e1, 1, __ATOMIC_RELAXED, __HIP_MEMORY_SCOPE_WORKGROUP);
        }
        __syncthreads();
        if (tid < 32) p.cnt_tile[tile * 32 + tid] = HIST[tid];
        __syncthreads();
    }
}
__device__ __forceinline__ void scatter_phase(const Params& p, LAS unsigned char* lds) {
    LAS int* PST = (LAS int*)lds;
    LAS int* CNT = PST + 64;
    LAS int* PRE = PST + 128;
    LAS int* LCN = PST + 192;
    int tid = threadIdx.x; asm volatile("" : "+v"(tid));
    for (int tile = blockIdx.x; tile < T_TOK / 128; tile += gridDim.x) {
        __syncthreads();
        {
            LAS int* RT = PST + 256;
            LAS int* RP = RT + 512;
            const int e = tid & 31, grp = tid >> 5;
            int tot = 0, pre = 0;
#pragma unroll 4
            for (int i = grp; i < T_TOK / 128; i += 16) { const int c = p.cnt_tile[i * 32 + e]; tot += c; pre += (i < tile) ? c : 0; }
            RT[grp * 32 + e] = tot; RP[grp * 32 + e] = pre;
        }
        __syncthreads();
        if (tid < 32) {
            int tot = 0, pre = 0;
#pragma unroll
            for (int gq = 0; gq < 16; ++gq) { tot += PST[256 + gq * 32 + tid]; pre += PST[256 + 512 + gq * 32 + tid]; }
            CNT[tid] = tot; PRE[tid] = pre; LCN[tid] = 0;
        }
        __syncthreads();
        if (tid == 0) { int acc = 0; for (int e = 0; e < 32; ++e) { PST[e] = acc; acc += (CNT[e] + 255) / 256 * 256; } PST[32] = acc; }
        __syncthreads();
        if (tile == 0 && tid == 0) p.ntiles[0] = PST[32] / 256;
        if (tile == 0 && tid < 32) { p.counts[tid] = PST[tid] / 256; p.counts[32 + tid] = (PST[tid + 1] - PST[tid]) / 256; }
        if (tile < 32) {
            const int e = tile, s0 = PST[e], s1 = PST[e + 1], c = CNT[e];
            for (int tI = s0 / 256 + tid; tI < s1 / 256; tI += NTHR) p.tile_e[tI] = e;
            for (int s = s0 + c + tid; s < s1; s += NTHR) { p.toks[s] = T_TOK; p.slotw[s] = 0.f; p.slotdst[s] = -1; }
        }
        if (tid < 256) {
            const int a = tile * 256 + tid;
            const int e = p.eid[a];
            const int lp = __hip_atomic_fetch_add(LCN + e, 1, __ATOMIC_RELAXED, __HIP_MEMORY_SCOPE_WORKGROUP);
            const int s = PST[e] + PRE[e] + lp;
            p.toks[s] = a >> 1; p.slotw[s] = p.ew[a]; p.slotdst[s] = a;
        }
    }
}
template <int WHICH>
__device__ __forceinline__ void moe_stage_units(const Params& p, LAS unsigned char* lds) {
    LAS int* ul = (LAS int*)(lds + LDS_META_OFF);
    LAS int* ia = ul + 64; LAS float* fa = (LAS float*)(ia + 6 * 256);
    int tid = threadIdx.x; asm volatile("" : "+v"(tid));
    const int nt = p.ntiles[0];
    const int W = (int)gridDim.x >> 3, x = (int)blockIdx.x & 7, r = (int)blockIdx.x >> 3;
    int mx = 0;
#pragma unroll
    for (int q = 0; q < 8; ++q) { const int s = p.counts[32 + q] + p.counts[40 + q] + p.counts[48 + q] + p.counts[56 + q]; mx = s > mx ? s : mx; }
    const int rounds_plain = (nt * 4 + (int)gridDim.x - 1) / (int)gridDim.x;
    const bool local = ((int)gridDim.x & 7) == 0 && W > 0 && (mx * 4 + W - 1) / W <= (rounds_plain < 6 ? rounds_plain : 6);
    if (local) {
        const int n0 = p.counts[32 + x], n1 = p.counts[40 + x], n2 = p.counts[48 + x], n3 = p.counts[56 + x], tot = 4 * (n0 + n1 + n2 + n3);
        if (tid < 6) {
            const int j = tid * W + r, jt = j >> 2;
            const bool ok = j < tot;
            int pm = 0;
            if (ok) {
                if (jt < n0) pm = p.counts[x] + jt;
                else if (jt < n0 + n1) pm = p.counts[8 + x] + (jt - n0);
                else if (jt < n0 + n1 + n2) pm = p.counts[16 + x] + (jt - n0 - n1);
                else pm = p.counts[24 + x] + (jt - n0 - n1 - n2);
            }
            ul[2 + 2 * tid] = pm; ul[3 + 2 * tid] = ok ? p.tile_e[pm] * 4 + (j & 3) : 0;
        }
        if (tid == 0) { const int n = tot > r ? (tot - r + W - 1) / W : 0; ul[0] = n > 6 ? 6 : n; }
    } else {
        if (tid < 6) {
            const long L = (long)tid * gridDim.x + blockIdx.x;
            const bool ok = L < (long)nt * 4;
            const int pm = ok ? (int)(L >> 2) : 0;
            ul[2 + 2 * tid] = pm; ul[3 + 2 * tid] = ok ? p.tile_e[pm] * 4 + (int)(L & 3) : 0;
        }
        if (tid == 0) { const long rem = (long)nt * 4 - blockIdx.x; int n = rem > 0 ? (int)((rem + gridDim.x - 1) / gridDim.x) : 0; ul[0] = n > 6 ? 6 : n; }
    }
    __syncthreads();
    const int nu = ul[0];
    for (int e = tid; e < nu * 256; e += NTHR) {
        const int li = e >> 8, r = e & 255, row = ul[2 + 2 * li] * 256 + r;
        if (WHICH == 0) { const int tk = p.toks[row]; ia[e] = tk; fa[e] = p.rsB[tk]; }
        else { ia[e] = p.slotdst[row]; fa[e] = p.slotw[row]; }
    }
    __syncthreads();
}
struct EpiMoe1 {
    static constexpr bool PERM = true;
    const LAS float* rsl; bf16_t* HMID;
    __device__ __forceinline__ void operator()(const AccT& acc, const pg8::Unit& u, int wr, int wc, int fr, int fq) const {
        const int row0 = u.pm * 256 + wr * 64 + fr;
        const int q = u.pn & 3;
        float rr[2][4];
#pragma unroll
        for (int ai = 0; ai < 2; ++ai)
#pragma unroll
            for (int m = 0; m < 4; ++m) rr[ai][m] = rsl[u.li * 256 + wr * 64 + fr + ai * 128 + m * 16];
#pragma unroll
        for (int ai = 0; ai < 2; ++ai)
#pragma unroll
            for (int m = 0; m < 4; ++m) {
                const float r = rr[ai][m];
                float y[8];
#pragma unroll
                for (int j = 0; j < 4; ++j) {
                    const float a0 = acc[ai][0][m][0][j] * r, b0 = acc[ai][1][m][0][j] * r, a1 = acc[ai][0][m][1][j] * r, b1 = acc[ai][1][m][1][j] * r;
                    y[j] = a0 * fast_sigmoid(a0) * b0; y[4 + j] = a1 * fast_sigmoid(a1) * b1;
                }
                u32x4 w; w.x = cvt_pk_bf16(y[0], y[1]); w.y = cvt_pk_bf16(y[2], y[3]); w.z = cvt_pk_bf16(y[4], y[5]); w.w = cvt_pk_bf16(y[6], y[7]);
                *(u32x4*)(HMID + (long)(row0 + ai * 128 + m * 16) * 512 + q * 128 + wc * 32 + fq * 8) = w;
                __builtin_amdgcn_sched_barrier(0);
            }
    }
};
struct EpiMoe2 {
    static constexpr bool PERM = true;
    const LAS int* dstl; const LAS float* wl; bf16_t* YS;
    __device__ __forceinline__ void operator()(const AccT& acc, const pg8::Unit& u, int wr, int wc, int fr, int fq) const {
        const int row0 = u.pm * 256 + wr * 64 + fr;
        const int q = u.pn & 3;
        int dd[2][4]; float ww[2][4];
#pragma unroll
        for (int ai = 0; ai < 2; ++ai)
#pragma unroll
            for (int m = 0; m < 4; ++m) { const int lr = u.li * 256 + wr * 64 + fr + ai * 128 + m * 16; dd[ai][m] = dstl[lr]; ww[ai][m] = wl[lr]; }
#pragma unroll
        for (int ai = 0; ai < 2; ++ai)
#pragma unroll
            for (int m = 0; m < 4; ++m) {
                if (dd[ai][m] >= 0) {
                    const float wv = ww[ai][m];
                    bf16_t* dp = YS + (long)dd[ai][m] * 1024 + q * 256 + wc * 32 + fq * 8;
#pragma unroll
                    for (int bj = 0; bj < 2; ++bj) {
                        const f32x4 v0 = acc[ai][bj][m][0], v1 = acc[ai][bj][m][1];
                        u32x4 w; w.x = cvt_pk_bf16(v0[0] * wv, v0[1] * wv); w.y = cvt_pk_bf16(v0[2] * wv, v0[3] * wv); w.z = cvt_pk_bf16(v1[0] * wv, v1[1] * wv); w.w = cvt_pk_bf16(v1[2] * wv, v1[3] * wv);
                        *(u32x4*)(dp + bj * 128) = w;
                    }
                }
                __builtin_amdgcn_sched_barrier(0);
            }
    }
};

#define FAST_PHASES_2_TO_10 \
        if (IN(2)) { \
            if ((int)blockIdx.x < 32) { \
                pg8::Gemm g{p.KVC, p.CW1T + (size_t)l * 512 * 2048, 2048, 1024, 2048, nullptr}; \
                pg8::CmpOrder S{(int)blockIdx.x}; \
                EpiCmp1 E{p.CB1 + l * 512, p.CHID}; \
                pg8::gemm_phase<EpiCmp1, pg8::CmpOrder, false>(lds, g, S, E); \
                cmp_gemm2(p, l, blockIdx.x); \
                if (l == 0) cvt_fill<0>(p, lds, NCH0, FILL_P2C); \
            } else { \
                  \
                const int nw = (int)gridDim.x - 32; \
                if (__builtin_amdgcn_readfirstlane((int)threadIdx.x) >= 256) __builtin_amdgcn_s_setprio(1);     \
                for (int u = (int)blockIdx.x - 32; u < 1024; u += nw) attn_aw_unit(p, l, (u & 15) >> 1, u & 1, 63 - (u >> 4), lds); \
                __builtin_amdgcn_s_setprio(0); \
                if (l == 0 && (1024 - ((int)blockIdx.x - 32) + nw - 1) / nw < (1024 + nw - 1) / nw) cvt_fill<0>(p, lds, NCH0, FILL_P2A); \
            } \
            GRID_BAR(); \
        } \
        if (IN(3)) { \
            if (__builtin_amdgcn_readfirstlane((int)threadIdx.x) >= 256) __builtin_amdgcn_s_setprio(1); \
            for (int k = blockIdx.x; k < 1024; k += gridDim.x) { \
                const int bgk = k & 15, cg = (k >> 4) & 15, i4 = k >> 8; \
                const int c = (i4 == 0) ? 63 - cg : (i4 == 1) ? 32 + cg : (i4 == 2) ? 31 - cg : cg; \
                attn_cs_unit(p, bgk >> 1, bgk & 1, c, lds); \
            } \
            __builtin_amdgcn_s_setprio(0); \
            GRID_BAR(); \
        } \
        if (IN(4)) { \
            pg8::StaticOrder S; S.init(T_TOK, 1024, gridDim.x, blockIdx.x); \
            { pg8::Gemm g{p.HB, p.WinT + ((size_t)l * 4352 + 2072) * 1024, 1024, 1024, 1024, nullptr}; EpiGate E{p.rsA, p.MERGED}; \
              pg8::gemm_phase<EpiGate, pg8::StaticOrder, false>(lds, g, S, E); } \
            { pg8::Gemm g{p.HB, p.WinT + ((size_t)l * 4352 + 3096) * 1024, 1024, 1024, 1024, nullptr}; EpiGate E{p.rsA, p.TMP2}; \
              pg8::gemm_phase<EpiGate, pg8::StaticOrder, false>(lds, g, S, E); } \
            { pg8::Gemm g{p.OAB, p.WabT + (size_t)l * 1024 * 1024, 1024, 1024, 1024, nullptr}; EpiMerge2 E{p.MERGED, p.TMP2}; \
              pg8::gemm_phase<EpiMerge2, pg8::StaticOrder, false, true>(lds, g, S, E); } \
            GRID_BAR(); \
        } \
        if (IN(5)) { \
            pg8::StaticOrder S; S.init(T_TOK, 1024, gridDim.x, blockIdx.x); \
            pg8::Gemm g{p.MERGED, p.WoutT + (size_t)l * 1024 * 1024, 1024, 1024, 1024, nullptr}; \
            EpiOut E{p.HB, p.ssq16}; \
            pg8::gemm_phase<EpiOut, pg8::StaticOrder, false>(lds, g, S, E); \
            GRID_BAR(); \
        } \
        if (IN(6)) { router_phase(p, l, lds); GRID_BAR(); } \
        if (IN(7)) { if (l == 0) cvt_fill<0>(p, lds, NCH0, 100000); scatter_phase(p, lds); GRID_BAR(); } \
        if (IN(8)) { \
            moe_stage_units<0>(p, lds); \
            LAS int* ul_ = (LAS int*)(lds + LDS_META_OFF); \
            pg8::MoeOrder S{ul_}; \
            pg8::Gemm g{p.HB, l ? p.W13T1 : p.W13T, 1024, 1024, 1024, ul_ + 64}; \
            EpiMoe1 E{(LAS float*)(ul_ + 64 + 6 * 256), p.HMID}; \
            pg8::gemm_phase<EpiMoe1, pg8::MoeOrder, true>(lds, g, S, E); \
            if (l == 0 && ul_[0] < (p.ntiles[0] * 4 + (int)gridDim.x - 1) / (int)gridDim.x) cvt_fill<1>(p, lds, 0, FILL_P8); \
            GRID_BAR(); \
        } \
        if (IN(9)) { \
            moe_stage_units<1>(p, lds); \
            LAS int* ul_ = (LAS int*)(lds + LDS_META_OFF); \
            pg8::MoeOrder S{ul_}; \
            pg8::Gemm g{p.HMID, l ? p.W2T1 : p.W2T, 512, 512, 512, nullptr}; \
            EpiMoe2 E{ul_ + 64, (LAS float*)(ul_ + 64 + 6 * 256), p.YS}; \
            pg8::gemm_phase<EpiMoe2, pg8::MoeOrder, false>(lds, g, S, E); \
            if (l == 0 && ul_[0] < (p.ntiles[0] * 4 + (int)gridDim.x - 1) / (int)gridDim.x) cvt_fill<1>(p, lds, 0, FILL_P9); \
            GRID_BAR(); \
        } \
        if (IN(10)) { \
            if (l == 1) fin_phase<true, true>(p, nullptr, p.norm_final); \
            else { fin_phase<true, false>(p, nullptr, nullptr); cvt_fill<1>(p, lds, 0, 100000); } \
            GRID_BAR(); \
        }
__global__ void __launch_bounds__(NTHR, 2) mega(Params p) {
    extern __shared__ __attribute__((aligned(16))) unsigned char lds_raw[];
    LAS unsigned char* lds = (LAS unsigned char*)lds_raw;
    volatile LAS unsigned* misc = (volatile LAS unsigned*)(lds + LDS_MISC_OFF);
    if (threadIdx.x < 64) misc[threadIdx.x] = 0u;
    build_tables(p, lds);
    const bool multi = (p.ph_hi - p.ph_lo > 1) || (p.l_hi - p.l_lo > 1);
    XcdBarrier bar; bar.bar = p.bar; bar.x = 0; bar.st = misc;
    if (multi) bar = xcd_barrier_post(p.bar, misc);
#define GRID_BAR() do { if (multi) xcd_barrier(bar); } while (0)
#define IN(k) (p.ph_lo <= (k) && (k) < p.ph_hi)

    if (IN(0) && p.l_lo == 0) {
        cvt_phase<0, 8>(p, lds);
        cvt_static<0>(p, lds, NCH0);
        prep_small(p);
        fin_phase<false, false>(p, p.x, nullptr);
        GRID_BAR();
    }
    for (int l = p.l_lo; l < p.l_hi; ++l) {
        if (IN(1)) {
            if (l == 0) cb1_reduce(p);
            pg8::Gemm g{p.HB, p.WinT + (size_t)l * 4352 * 1024, 1024, 1024, 1024, nullptr};
            pg8::StaticOrder S; S.init(T_TOK, 2048, gridDim.x, blockIdx.x);
            EpiProj E{p.rsA, p.QA, p.KA, p.G24};
            pg8::gemm_phase<EpiProj, pg8::StaticOrder, false>(lds, g, S, E);
            gates24_phase(p, l, lds);
            GRID_BAR();
        }
        FAST_PHASES_2_TO_10
    }
#undef IN
#undef GRID_BAR
}

struct HostState { int grid; bool ok; };
static void setup_params(Params& p, void* const* d_in, void* d_out, void* d_ws, size_t ws_size, size_t& used) {
    p.x = (const float*)d_in[0]; p.rel_bias = (const float*)d_in[1]; p.norm_mix = (const float*)d_in[2]; p.w_in = (const float*)d_in[3];
    p.a_sinks = (const float*)d_in[4]; p.cmp_pos_k = (const float*)d_in[5]; p.cmp_w1_k = (const float*)d_in[6]; p.cmp_w2_k = (const float*)d_in[7];
    p.cmp_pos_v = (const float*)d_in[8]; p.cmp_w1_v = (const float*)d_in[9]; p.cmp_w2_v = (const float*)d_in[10];
    p.w_br_a = (const float*)d_in[11]; p.w_br_b = (const float*)d_in[12]; p.w_out = (const float*)d_in[13]; p.norm_ffn = (const float*)d_in[14];
    p.w_group = (const float*)d_in[15]; p.b_group = (const float*)d_in[16]; p.w_expert = (const float*)d_in[17]; p.b_expert = (const float*)d_in[18];
    p.w1 = (const float*)d_in[19]; p.w3 = (const float*)d_in[20]; p.w2 = (const float*)d_in[21]; p.norm_final = (const float*)d_in[22];
    p.out = (float*)d_out;
    char* ws = (char*)d_ws; size_t off = 0;
    auto alloc = [&](size_t bytes) { void* q = ws + off; off += (bytes + 4095) & ~(size_t)4095; return q; };
    p.bar = (unsigned*)alloc(XCD_BAR_WORDS * 4);
    p.counts = (int*)alloc(256); p.cursor = (int*)alloc(256); p.ntiles = (int*)alloc(256); p.tile_e = (int*)alloc(NTILE_MAX * 4 + 256); p.cnt_tile = (int*)alloc((size_t)(T_TOK / 128) * 32 * 4);
    p.rsA = (float*)alloc(T_TOK * 4); p.rsB = (float*)alloc(T_TOK * 4); p.ssq16 = (float*)alloc((size_t)T_TOK * 16 * 4);
    p.HB = (bf16_t*)alloc((size_t)(T_TOK + 256) * DM * 2);
    p.WinT = (bf16_t*)alloc((size_t)2 * 4352 * 1024 * 2);
    p.WabT = (bf16_t*)alloc((size_t)2 * 1024 * 1024 * 2); p.WoutT = (bf16_t*)alloc((size_t)2 * 1024 * 1024 * 2);
    p.CW1T = (bf16_t*)alloc((size_t)2 * 512 * 2048 * 2); p.CW2T = (bf16_t*)alloc((size_t)2 * 2 * 64 * 256 * 2); p.CB1 = (float*)alloc(1024 * 4); p.CBP = (float*)alloc((size_t)512 * 256 * 4);
    p.W13T = (bf16_t*)alloc((size_t)32 * 1024 * 1024 * 2); p.W2T = (bf16_t*)alloc((size_t)32 * 1024 * 512 * 2);
    p.W13T1 = (bf16_t*)d_out; p.W2T1 = p.W13T1 + (size_t)32 * 1024 * 1024;
    p.cvtcur = (int*)(p.bar + 3584);
    p.WRH = (bf16_t*)alloc((size_t)2 * 48 * 1024 * 2); p.WRL = (bf16_t*)alloc((size_t)2 * 48 * 1024 * 2);
    p.eid = (int*)alloc((size_t)T_TOK * 2 * 4); p.ew = (float*)alloc((size_t)T_TOK * 2 * 4);
    p.toks = (int*)alloc((size_t)PMAXF * 4); p.slotw = (float*)alloc((size_t)PMAXF * 4); p.slotdst = (int*)alloc((size_t)PMAXF * 4);
    const size_t region0 = off;
    p.QA = (bf16_t*)alloc((size_t)T_TOK * 512 * 2); p.QB = (bf16_t*)alloc((size_t)T_TOK * 512 * 2);
    {
        const size_t slot = (size_t)16 * SEQ * 64;
        p.KA = (bf16_t*)alloc(8 * slot * 2); p.KVC = p.KA + slot; p.KS = p.KA + 3 * slot; p.KW = p.KA + 4 * slot; p.VAT = p.KA + 5 * slot; p.VST = p.KA + 6 * slot; p.VWT = p.KA + 7 * slot;
    }
    p.G24 = (float*)alloc((size_t)T_TOK * 32 * 4);
    p.CHID = (bf16_t*)alloc((size_t)8192 * 256 * 2); p.KCMP = (bf16_t*)alloc((size_t)16 * 256 * 64 * 2); p.VCMPT = (bf16_t*)alloc((size_t)16 * 64 * 256 * 2);
    p.OAB = (bf16_t*)alloc((size_t)T_TOK * 1024 * 2); p.OW = (bf16_t*)alloc((size_t)T_TOK * 512 * 2);
    p.MERGED = (bf16_t*)alloc((size_t)T_TOK * 1024 * 2);
    const size_t region1 = off;
    p.TMP2 = p.QA;
    p.HMID = (bf16_t*)(ws + region0);
    size_t moe_end = region0 + (((size_t)PMAXF * 512 * 2 + 4095) & ~(size_t)4095);
    p.YS = (bf16_t*)(ws + moe_end); moe_end += (size_t)T_TOK * 2 * 1024 * 2;
    used = (moe_end > region1) ? moe_end : region1;
    (void)ws_size;
    auto task = [&](int i, const float* src, bf16_t* dst, const float* scale, int scstride, int ld, int K, int N, int mapmode, int nb, long ss, long ds, int dld = 0) {
        CvtTask& t = p.cvt[i]; t.dld = dld ? dld : K; t.src = src; t.dst = dst; t.scale = scale; t.scstride = scstride; t.ld = ld; t.K = K; t.N = N; t.mapmode = mapmode; t.nb = nb; t.sstride = ss; t.dstride = ds; };
    task(0, p.w_in, p.WinT, p.norm_mix, 1024, INC, 1024, INC, 0, 2, (long)1024 * INC, (long)4352 * 1024);
    task(1, p.w_br_a, p.WabT, nullptr, 0, 1024, 512, 1024, 0, 2, (long)512 * 1024, (long)1024 * 1024, 1024);
    task(2, p.w_br_b, p.WabT + 512, nullptr, 0, 1024, 512, 1024, 0, 2, (long)512 * 1024, (long)1024 * 1024, 1024);
    task(3, p.w_out, p.WoutT, nullptr, 0, 1024, 1024, 1024, 0, 2, (long)1024 * 1024, (long)1024 * 1024);
    task(4, p.cmp_w1_k, p.CW1T, nullptr, 0, 256, 2048, 256, 0, 2, (long)2048 * 256, (long)512 * 2048);
    task(5, p.cmp_w1_v, p.CW1T + (size_t)256 * 2048, nullptr, 0, 256, 2048, 256, 0, 2, (long)2048 * 256, (long)512 * 2048);
    task(6, p.cmp_w2_k, p.CW2T, nullptr, 0, 64, 256, 64, 0, 2, (long)256 * 64, (long)2 * 64 * 256);
    task(7, p.cmp_w2_v, p.CW2T + (size_t)64 * 256, nullptr, 0, 64, 256, 64, 0, 2, (long)256 * 64, (long)2 * 64 * 256);
}
static HostState& host_state() {
    static HostState hs{0, false};
    if (hs.grid == 0) {
        int dev = 0, cus = 0, per_cu = 0;
        hs.grid = -1;
        if (hipGetDevice(&dev) != hipSuccess) return hs;
        if (hipDeviceGetAttribute(&cus, hipDeviceAttributeMultiprocessorCount, dev) != hipSuccess) return hs;
        if (hipFuncSetAttribute((const void*)mega, hipFuncAttributeMaxDynamicSharedMemorySize, LDS_TOTAL) != hipSuccess) return hs;
        if (hipOccupancyMaxActiveBlocksPerMultiprocessor(&per_cu, (const void*)mega, NTHR, LDS_TOTAL) != hipSuccess || per_cu < 1) { (void)hipGetLastError(); return hs; }
        hs.grid = cus;
        hs.ok = true;
    }
    return hs;
}
static void launch_mega(const Params& base, int ph_lo, int ph_hi, int l_lo, int l_hi, hipStream_t stream) {
    Params p = base; p.ph_lo = ph_lo; p.ph_hi = ph_hi; p.l_lo = l_lo; p.l_hi = l_hi;
    hipLaunchKernelGGL(mega, dim3(host_state().grid), dim3(NTHR), LDS_TOTAL, stream, p);
}
extern "C" void kernel_launch(void* const* d_in, const int* in_sizes, int n_in, void* d_out, int out_size, void* d_ws, size_t ws_size,
                              hipStream_t stream) {
    HostState& hs = host_state();
    if (!hs.ok) return;
    Params P; memset(&P, 0, sizeof(P));
    size_t used = 0;
    setup_params(P, d_in, d_out, d_ws, ws_size, used);
    if (used > ws_size) return;
    (void)in_sizes; (void)n_in; (void)out_size;
    hipMemsetAsync(P.bar, 0, 16384, stream);
    launch_mega(P, 0, 11, 0, 2, stream);
}
```

```cpp
#include <string.h>
#include <hip/hip_runtime.h>
#include <stdint.h>

#define T_TOK 32768
#define SEQ 4096
#define DM 1024
#define INC 4120

__device__ const unsigned char kBucket[128] = {0, 1, 2, 3, 4, 5, 6, 7, 8, 9, 10, 11, 12, 13, 14, 15, 16, 16, 16, 17, 17, 18, 18, 18, 19, 19, 19, 20, 20, 20, 20, 21, 21, 21, 21, 22, 22, 22, 22, 22, 23, 23, 23, 23, 23, 23, 24, 24, 24, 24, 24, 24, 25, 25, 25, 25, 25, 25, 25, 26, 26, 26, 26, 26, 26, 26, 26, 27, 27, 27, 27, 27, 27, 27, 27, 27, 27, 28, 28, 28, 28, 28, 28, 28, 28, 28, 28, 29, 29, 29, 29, 29, 29, 29, 29, 29, 29, 29, 29, 30, 30, 30, 30, 30, 30, 30, 30, 30, 30, 30, 30, 30, 30, 31, 31, 31, 31, 31, 31, 31, 31, 31, 31, 31, 31, 31, 31, 31};

#define LAS __attribute__((address_space(3)))
typedef unsigned short bf16_t;
typedef short bf16x8 __attribute__((ext_vector_type(8)));
typedef float f32x4 __attribute__((ext_vector_type(4)));
typedef float f32x16 __attribute__((ext_vector_type(16)));
typedef unsigned u32x4 __attribute__((ext_vector_type(4)));
typedef unsigned u32x2 __attribute__((ext_vector_type(2)));


typedef unsigned u32x2s __attribute__((ext_vector_type(2)));
__device__ __forceinline__ float half_swap_max(float v) { const u32x2s r = __builtin_amdgcn_permlane32_swap(__float_as_uint(v), __float_as_uint(v), false, false); return fmaxf(__uint_as_float(r.x), __uint_as_float(r.y)); }
__device__ __forceinline__ float half_swap_sum(float v) { const u32x2s r = __builtin_amdgcn_permlane32_swap(__float_as_uint(v), __float_as_uint(v), false, false); return __uint_as_float(r.x) + __uint_as_float(r.y); }
__device__ __forceinline__ float half_other(float v, int hq) { const u32x2s r = __builtin_amdgcn_permlane32_swap(__float_as_uint(v), __float_as_uint(v), false, false); return __uint_as_float(hq ? r.x : r.y); }
template <int M> __device__ __forceinline__ float swz_xor(float v) { return __int_as_float(__builtin_amdgcn_ds_swizzle(__float_as_int(v), (M << 10) | 0x1f)); }
__device__ __forceinline__ float wave_sum_f(float v) {
    v += swz_xor<1>(v); v += swz_xor<2>(v); v += swz_xor<4>(v); v += swz_xor<8>(v); v += swz_xor<16>(v);
    return half_swap_sum(v);
}

#define NTHR 512
#define LDS_STAGE 131072
#define LDS_TAB_OFF 131072
#define LDS_MISC_OFF (131072 + 16384)
#define LDS_META_OFF (131072 + 16384 + 1024)
#define LDS_TOTAL (131072 + 16384 + 1024 + 12544)

#define QSCALE 0.18033688011112042f
#define LOG2E 1.4426950408889634f

__device__ __forceinline__ unsigned cvt_pk_bf16(float lo, float hi) { unsigned r; asm volatile("v_cvt_pk_bf16_f32 %0, %1, %2" : "=v"(r) : "v"(lo), "v"(hi)); return r; }
__device__ __forceinline__ float bf16_to_f(unsigned short b) { return __uint_as_float(((unsigned)b) << 16); }
__device__ __forceinline__ float bf16lo(unsigned w) { return __uint_as_float(w << 16); }
__device__ __forceinline__ float bf16hi(unsigned w) { return __uint_as_float(w & 0xffff0000u); }
__device__ __forceinline__ float fast_sigmoid(float x) { return __builtin_amdgcn_rcpf(1.0f + __builtin_amdgcn_exp2f(-1.4426950408889634f * x)); }

#define XB_TMO      128
#define XB_XCNT(j)  (256  + 64 * (j))
#define XB_XSUB(j)  (1280 + 64 * (j))
#define XB_XGEN(j)  (2304 + 64 * (j))
#define XB_TOP      3328
#define XB_TOPGEN   3392
#define XCD_BAR_WORDS 3456
#define XB_SPIN_CAP (1u << 18)

__device__ __forceinline__ unsigned xb_ld(unsigned* p)              { return __hip_atomic_load(p, __ATOMIC_RELAXED, __HIP_MEMORY_SCOPE_AGENT); }
__device__ __forceinline__ unsigned xb_add(unsigned* p, unsigned v) { return __hip_atomic_fetch_add(p, v, __ATOMIC_RELAXED, __HIP_MEMORY_SCOPE_AGENT); }
__device__ __forceinline__ unsigned xb_xcc_id() { return (unsigned)__builtin_amdgcn_s_getreg((3 << 11) | 20) & 0xFu; }
#define XB_SPIN(cond, bar) do { unsigned _sp = 0; while (cond) { __builtin_amdgcn_s_sleep(1); \
    if ((++_sp & 255u) == 0u) { if (xb_ld(&(bar)[XB_TMO])) break; if (_sp > XB_SPIN_CAP) { atomicAdd(&(bar)[XB_TMO], 1u); break; } } } } while (0)

struct XcdBarrier { unsigned* bar; unsigned x; volatile LAS unsigned* st; };

__device__ __forceinline__ XcdBarrier xcd_barrier_post(unsigned* bar, volatile LAS unsigned* st) {
    XcdBarrier b; b.bar = bar; b.x = xb_xcc_id(); b.st = st;
    if (threadIdx.x == 0) (void)xb_add(&bar[XB_XCNT(b.x)], 1u);
    return b;
}
__device__ __forceinline__ void xcd_barrier_complete(unsigned* bar, unsigned x, unsigned& nloc, unsigned& nx) {
    const unsigned G = gridDim.x * gridDim.y * gridDim.z;
    unsigned sum, cnt, mine, sp = 0u;
    for (;;) {
        sum = 0u; cnt = 0u; mine = 0u;
#pragma unroll
        for (unsigned j = 0; j < 16; ++j) { const unsigned c = xb_ld(&bar[XB_XCNT(j)]); sum += c; cnt += (c > 0u) ? 1u : 0u; mine = (j == x) ? c : mine; }
        if (sum == G) break;
        __builtin_amdgcn_s_sleep(1);
        if ((++sp & 255u) == 0u) { if (xb_ld(&bar[XB_TMO])) break; if (sp > XB_SPIN_CAP) { atomicAdd(&bar[XB_TMO], 1u); break; } }
    }
    nloc = mine > 0u ? mine : 1u; nx = cnt > 0u ? cnt : 1u;
}
__device__ __forceinline__ void xcd_barrier(const XcdBarrier& b) {
    asm volatile("s_waitcnt vmcnt(0)" ::: "memory");
    __syncthreads();
    if (threadIdx.x == 0) {
        unsigned* bar = b.bar;
        __builtin_amdgcn_s_waitcnt(0);
        unsigned nloc = b.st[0], nx = b.st[1];
        if (nloc == 0u) { xcd_barrier_complete(bar, b.x, nloc, nx); b.st[0] = nloc; b.st[1] = nx; }
        const unsigned old = xb_add(&bar[XB_XSUB(b.x)], 1u);
        const unsigned gen = old / nloc;
        if (old + 1u == (gen + 1u) * nloc) {
            __builtin_amdgcn_fence(__ATOMIC_RELEASE, "agent");
            asm volatile("s_waitcnt vmcnt(0)" ::: "memory");
            const unsigned og = xb_add(&bar[XB_TOP], 1u);
            const unsigned tg = og / nx;
            if (og + 1u == (tg + 1u) * nx) xb_add(&bar[XB_TOPGEN], 1u);
            else XB_SPIN(xb_ld(&bar[XB_TOPGEN]) == tg, bar);
            __builtin_amdgcn_fence(__ATOMIC_ACQUIRE, "agent");
            xb_add(&bar[XB_XGEN(b.x)], 1u);
            asm volatile("s_waitcnt vmcnt(0)" ::: "memory");
        } else {
            XB_SPIN(xb_ld(&bar[XB_XGEN(b.x)]) == gen, bar);
            __builtin_amdgcn_fence(__ATOMIC_ACQUIRE, "agent");
            asm volatile("s_waitcnt vmcnt(0)" ::: "memory");
        }
    }
    __syncthreads();
}

struct CvtTask {
    const float* src; bf16_t* dst; const float* scale;
    int ld, K, N, mapmode;
    int dld;
    int nb; int scstride;
    long sstride, dstride;
};
#define NCVT 16
struct Params {
    const float* x; const float* rel_bias; const float* norm_mix; const float* w_in; const float* a_sinks;
    const float* cmp_pos_k; const float* cmp_w1_k; const float* cmp_w2_k; const float* cmp_pos_v; const float* cmp_w1_v; const float* cmp_w2_v;
    const float* w_br_a; const float* w_br_b; const float* w_out; const float* norm_ffn; const float* w_group; const float* b_group;
    const float* w_expert; const float* b_expert; const float* w1; const float* w3; const float* w2; const float* norm_final;
    float* out;
    unsigned* bar;
    int* counts; int* cursor; int* ntiles; int* tile_e; int* cnt_tile;
    float* rsA; float* rsB; float* ssq16;
    bf16_t* HB;
    bf16_t* WinT;
    bf16_t* WabT; bf16_t* WoutT;
    bf16_t* CW1T; bf16_t* CW2T; float* CB1; float* CBP;
    bf16_t* W13T; bf16_t* W2T;
    bf16_t* W13T1; bf16_t* W2T1;
    int* cvtcur;
    bf16_t* WRH; bf16_t* WRL;
    bf16_t* QA; bf16_t* QB;
    bf16_t* KA; bf16_t* KVC; bf16_t* KS; bf16_t* KW;
    bf16_t* VAT; bf16_t* VST; bf16_t* VWT;
    float* G24;
    bf16_t* CHID; bf16_t* KCMP; bf16_t* VCMPT;
    bf16_t* OAB; bf16_t* OW;
    bf16_t* MERGED; bf16_t* TMP2;
    int* eid; float* ew; int* toks; float* slotw; int* slotdst;
    bf16_t* HMID; bf16_t* YS;
    CvtTask cvt[NCVT];
    int ph_lo, ph_hi, l_lo, l_hi;
};
#define PMAXF (65536 + 32 * 256)
#define NTILE_MAX (PMAXF / 256)

__device__ __forceinline__ int cvt_units(const CvtTask& t) { return t.nb * (t.K / 128) * ((t.N + 63) / 64); }
struct CvtRegs { float4 v[2][4]; };
__device__ __forceinline__ void cvt_decode(const CvtTask& t, int u, int& e, int& kt, int& nt) {
    int nkt = t.K / 128, nnt = (t.N + 63) / 64;
    asm volatile("" : "+s"(nkt), "+s"(nnt));
    e = u / (nkt * nnt); const int r = u % (nkt * nnt); kt = r / nnt; nt = r % nnt;
}
__device__ __forceinline__ void cvt_load2(const CvtTask& t, int tid, int ub, int G, int nu, CvtRegs& R) {
#pragma unroll
    for (int q = 0; q < 2; ++q) {
        const int uu = ub + q * G;
#pragma unroll
        for (int i = 0; i < 4; ++i) R.v[q][i] = make_float4(0.f, 0.f, 0.f, 0.f);
        if (uu < nu) {
            int e, kt, nt; cvt_decode(t, uu, e, kt, nt);
            const float* src = t.src + (long)e * t.sstride;
#pragma unroll
            for (int i = 0; i < 4; ++i) {
                const int k = (tid >> 4) + 32 * i, n4 = (tid & 15) * 4;
                const int gk = kt * 128 + k, gn = nt * 64 + n4;
                if (gn < t.N) {
                    float4 v = *(const float4*)(src + (long)gk * t.ld + gn);
                    if (t.scale) { const float s = t.scale[(long)e * t.scstride + gk]; v.x *= s; v.y *= s; v.z *= s; v.w *= s; }
                    R.v[q][i] = v;
                }
            }
        }
    }
}
__device__ __forceinline__ void cvt_store2(const CvtTask& t, int tid, int ub, int G, int nu, const CvtRegs& R, LAS float* tiles  ) {
    __syncthreads();
#pragma unroll
    for (int q = 0; q < 2; ++q)
#pragma unroll
        for (int i = 0; i < 4; ++i) {
            const int k = (tid >> 4) + 32 * i, n4 = (tid & 15) * 4;
            LAS float* tl = tiles + q * (128 * 65) + k * 65 + n4;
            tl[0] = R.v[q][i].x; tl[1] = R.v[q][i].y; tl[2] = R.v[q][i].z; tl[3] = R.v[q][i].w;
        }
    __syncthreads();
    const int n = tid >> 3, ks = (tid & 7) * 16;
#pragma unroll
    for (int q = 0; q < 2; ++q) {
        const int uu = ub + q * G;
        if (uu < nu) {
            int e, kt, nt; cvt_decode(t, uu, e, kt, nt);
            bf16_t* dst = t.dst + (long)e * t.dstride;
            const int gn = nt * 64 + n;
            if (gn < t.N) {
                int drow = gn;
                if (t.mapmode == 1) drow = (gn >> 7) * 256 + (gn & 127);
                else if (t.mapmode == 2) drow = (gn >> 7) * 256 + 128 + (gn & 127);
                const LAS float* tl = tiles + q * (128 * 65) + ks * 65 + n;
                u32x4 w0, w1;
                w0.x = cvt_pk_bf16(tl[0 * 65], tl[1 * 65]); w0.y = cvt_pk_bf16(tl[2 * 65], tl[3 * 65]);
                w0.z = cvt_pk_bf16(tl[4 * 65], tl[5 * 65]); w0.w = cvt_pk_bf16(tl[6 * 65], tl[7 * 65]);
                w1.x = cvt_pk_bf16(tl[8 * 65], tl[9 * 65]); w1.y = cvt_pk_bf16(tl[10 * 65], tl[11 * 65]);
                w1.z = cvt_pk_bf16(tl[12 * 65], tl[13 * 65]); w1.w = cvt_pk_bf16(tl[14 * 65], tl[15 * 65]);
                bf16_t* dp = dst + (long)drow * t.dld + kt * 128 + ks;
                *(u32x4*)dp = w0; *(u32x4*)(dp + 8) = w1;
            }
        }
    }
}
template <int t0, int t1>
__device__ __forceinline__ void cvt_phase(const Params& p, LAS unsigned char* lds) {
    LAS float* tiles = (LAS float*)lds;
    int tid = threadIdx.x; asm volatile("" : "+v"(tid));
    const int G = gridDim.x;
    int base = 0;
#pragma unroll
    for (int ti = t0; ti < t1; ++ti) {
        const CvtTask& t = p.cvt[ti];
        const int nu = cvt_units(t);
        int first = (int)blockIdx.x - (base % G); if (first < 0) first += G;
        CvtRegs A, B;
        if (first < nu) cvt_load2(t, tid, first, G, nu, A);
        for (int ub = first; ub < nu; ub += 2 * G) {
            const int un = ub + 2 * G;
            if (un < nu) cvt_load2(t, tid, un, G, nu, B);
            cvt_store2(t, tid, ub, G, nu, A, tiles);
            A = B;
        }
        base += nu;
    }
    __syncthreads();
}
#define JOB_CHUNKS 768
#define FILL_P1 0
#define FILL_P2C 0
#define FILL_P2A 0
#define FILL_P8 0
#define FILL_P9 0
#define NCH0 (JOB_CHUNKS - (128 * FILL_P1 + 32 * FILL_P2C + 96 * FILL_P2A))
template <int JOB>
__device__ __forceinline__ void cvt_job_chunk(const Params& p, int c, LAS float* tiles, int tid) {
    const int which = c >> 8, u0 = (c & 255) * 8;
    CvtTask t;
    const long eo = (long)JOB * 32 * 1024 * 512;
    const float* src = p.w1; if (which == 1) src = p.w3; if (which == 2) src = p.w2;
    t.src = src + eo;
    t.dst = (which == 2) ? (JOB ? p.W2T1 : p.W2T) : (JOB ? p.W13T1 : p.W13T);
    t.scale = (which == 2) ? nullptr : p.norm_ffn + JOB * 1024; t.scstride = 0;
    t.ld = (which == 2) ? 1024 : 512; t.K = (which == 2) ? 512 : 1024; t.N = (which == 2) ? 1024 : 512;
    t.dld = t.K; t.mapmode = (which == 2) ? 0 : 1 + which; t.nb = 32; t.sstride = (long)1024 * 512; t.dstride = (which == 2) ? (long)1024 * 512 : (long)1024 * 1024;
    CvtRegs A, B;
    cvt_load2(t, tid, u0, 1, 2048, A);
#pragma unroll 1
    for (int s2 = 0; s2 < 4; ++s2) {
        if (s2 < 3) cvt_load2(t, tid, u0 + 2 * (s2 + 1), 1, 2048, B);
        cvt_store2(t, tid, u0 + 2 * s2, 1, 2048, A, tiles);
        A = B;
    }
}
template <int JOB>
__device__ __forceinline__ void cvt_fill(const Params& p, LAS unsigned char* lds, int base, int max_chunks) {
    int tid = threadIdx.x; asm volatile("" : "+v"(tid));
    volatile LAS unsigned* slot = (volatile LAS unsigned*)(lds + LDS_MISC_OFF) + 32;
#pragma unroll 1
    for (int n = 0; n < max_chunks; ++n) {
        __syncthreads();
        if (tid == 0) *slot = (unsigned)__hip_atomic_fetch_add(p.cvtcur + JOB, 1, __ATOMIC_RELAXED, __HIP_MEMORY_SCOPE_AGENT);
        __syncthreads();
        const int c = base + __builtin_amdgcn_readfirstlane((int)*slot);
        if (c >= JOB_CHUNKS) break;
        cvt_job_chunk<JOB>(p, c, (LAS float*)lds, tid);
    }
    __syncthreads();
}
template <int JOB>
__device__ __forceinline__ void cvt_static(const Params& p, LAS unsigned char* lds, int n) {
    int tid = threadIdx.x; asm volatile("" : "+v"(tid));
#pragma unroll 1
    for (int c = blockIdx.x; c < n; c += gridDim.x) cvt_job_chunk<JOB>(p, c, (LAS float*)lds, tid);
    __syncthreads();
}
__device__ __forceinline__ void prep_small(const Params& p) {
    const int gtid = blockIdx.x * NTHR + threadIdx.x, gn = gridDim.x * NTHR;
    for (int i = gtid; i < 2 * 48 * 1024; i += gn) {
        const int l = i / (48 * 1024), r = i % (48 * 1024), n = r >> 10, k = r & 1023;
        float w = 0.f;
        if (n < 36) {
            const float g = p.norm_ffn[l * 1024 + k];
            w = g * ((n < 4) ? p.w_group[((long)l * 1024 + k) * 4 + n] : p.w_expert[((long)l * 1024 + k) * 32 + (n - 4)]);
        }
        const __bf16 hi = (__bf16)w; const __bf16 lo = (__bf16)(w - (float)hi);
        p.WRH[i] = __builtin_bit_cast(unsigned short, hi); p.WRL[i] = __builtin_bit_cast(unsigned short, lo);
    }
    for (int w = blockIdx.x; w < 256; w += gridDim.x) {
        const int cmb = w >> 6, sl = w & 63, l = cmb >> 1, kv = cmb & 1, n = threadIdx.x & 255, kh = threadIdx.x >> 8;
        const float* pos = (kv ? p.cmp_pos_v : p.cmp_pos_k) + (long)l * 2048 + sl * 32 + kh * 16;
        const float* wt = (kv ? p.cmp_w1_v : p.cmp_w1_k) + ((long)l * 2048 + sl * 32 + kh * 16) * 256 + n;
        float sacc = 0.f;
#pragma unroll
        for (int i = 0; i < 16; ++i) sacc = fmaf(pos[i], wt[(long)i * 256], sacc);
        p.CBP[((long)w * 2 + kh) * 256 + n] = sacc;
    }
    for (int i = gtid; i < 256 * 1024 / 8; i += gn) ((u32x4*)(p.HB + (long)T_TOK * DM))[i] = (u32x4){0u, 0u, 0u, 0u};
}

__device__ __forceinline__ void cb1_reduce(const Params& p) {
    const int wave = threadIdx.x >> 6, lane = threadIdx.x & 63;
    if (wave < 4) {
        for (int o = blockIdx.x * 4 + wave; o < 1024; o += gridDim.x * 4) {
            const int cmb = o >> 8, n = o & 255;
            const float* pp = p.CBP + ((long)cmb * 128) * 256 + n;
            float v = pp[(long)lane * 256] + pp[(long)(lane + 64) * 256];
            v = wave_sum_f(v);
            if (lane == 0) p.CB1[o] = v;
        }
    }
}
template <bool ADD_YS, bool LAST>
__device__ __forceinline__ void fin_phase(const Params& p, const float* hin, const float* gfinal) {
    int tid = threadIdx.x; asm volatile("" : "+v"(tid));
    const int wave = tid >> 6, lane = tid & 63;
    for (int row0 = (blockIdx.x * 8 + wave) * 2; row0 < T_TOK; row0 += gridDim.x * 16) {
        float v[2][2][8]; u32x4 ya[2][2], yb[2][2], hb[2][2];
#pragma unroll
        for (int q = 0; q < 2; ++q)
#pragma unroll
            for (int i = 0; i < 2; ++i) {
                if (ADD_YS) {
                    hb[q][i] = *(const u32x4*)(p.HB + (long)(row0 + q) * DM + i * 512 + lane * 8);
                    ya[q][i] = *(const u32x4*)(p.YS + ((long)(row0 + q) * 2) * DM + i * 512 + lane * 8);
                    yb[q][i] = *(const u32x4*)(p.YS + ((long)(row0 + q) * 2 + 1) * DM + i * 512 + lane * 8);
                } else {
                    const float4 a = *(const float4*)(hin + (long)(row0 + q) * DM + i * 512 + lane * 8), c = *(const float4*)(hin + (long)(row0 + q) * DM + i * 512 + lane * 8 + 4);
                    v[q][i][0] = a.x; v[q][i][1] = a.y; v[q][i][2] = a.z; v[q][i][3] = a.w; v[q][i][4] = c.x; v[q][i][5] = c.y; v[q][i][6] = c.z; v[q][i][7] = c.w;
                }
            }
#pragma unroll
        for (int q = 0; q < 2; ++q) {
            const int row = row0 + q;
            if (ADD_YS) {
#pragma unroll
                for (int i = 0; i < 2; ++i) {
                    const unsigned hw[4] = {hb[q][i].x, hb[q][i].y, hb[q][i].z, hb[q][i].w}, aw[4] = {ya[q][i].x, ya[q][i].y, ya[q][i].z, ya[q][i].w}, bw[4] = {yb[q][i].x, yb[q][i].y, yb[q][i].z, yb[q][i].w};
#pragma unroll
                    for (int j = 0; j < 4; ++j) {
                        v[q][i][2 * j] = bf16lo(hw[j]) + (bf16lo(aw[j]) + bf16lo(bw[j]));
                        v[q][i][2 * j + 1] = bf16hi(hw[j]) + (bf16hi(aw[j]) + bf16hi(bw[j]));
                    }
                }
            }
            float s = 0.f;
#pragma unroll
            for (int i = 0; i < 2; ++i)
#pragma unroll
                for (int j = 0; j < 8; ++j) s += v[q][i][j] * v[q][i][j];
            s = wave_sum_f(s);
            const float r = rsqrtf(s * (1.0f / DM) + 1e-5f);
            if (LAST) {
#pragma unroll
                for (int i = 0; i < 2; ++i) {
                    const float4 g0 = *(const float4*)(gfinal + i * 512 + lane * 8), g1 = *(const float4*)(gfinal + i * 512 + lane * 8 + 4);
                    float4 o0, o1;
                    o0.x = v[q][i][0] * r * g0.x; o0.y = v[q][i][1] * r * g0.y; o0.z = v[q][i][2] * r * g0.z; o0.w = v[q][i][3] * r * g0.w;
                    o1.x = v[q][i][4] * r * g1.x; o1.y = v[q][i][5] * r * g1.y; o1.z = v[q][i][6] * r * g1.z; o1.w = v[q][i][7] * r * g1.w;
                    *(float4*)(p.out + (long)row * DM + i * 512 + lane * 8) = o0; *(float4*)(p.out + (long)row * DM + i * 512 + lane * 8 + 4) = o1;
                }
            } else {
#pragma unroll
                for (int i = 0; i < 2; ++i) {
                    u32x4 w; w.x = cvt_pk_bf16(v[q][i][0], v[q][i][1]); w.y = cvt_pk_bf16(v[q][i][2], v[q][i][3]); w.z = cvt_pk_bf16(v[q][i][4], v[q][i][5]); w.w = cvt_pk_bf16(v[q][i][6], v[q][i][7]);
                    *(u32x4*)(p.HB + (long)row * DM + i * 512 + lane * 8) = w;
                }
                if (lane == 0) p.rsA[row] = r;
            }
        }
    }
}

namespace pg8 {
constexpr int BM = 256, BK = 64, HALF = 128, HTB = HALF * BK * 2, STAGE_BYTES = 8 * HTB, NXCD = 8, WGM = 8;
__host__ __device__ __forceinline__ int lds_byte(int r, int c) { const int st = (r >> 4) * 2 + (c >> 5), rr = r & 15, cc = c & 31, ob = rr * 64 + cc * 2; return st * 1024 + (ob ^ (((ob >> 9) & 1) << 5)); }
__host__ __device__ __forceinline__ void stage_rc(int b, int& R, int& C) { const int st = b / 1024, sb = b % 1024, swz = sb ^ (((sb >> 9) & 1) << 5); R = (st >> 1) * 16 + swz / 64; C = (st & 1) * 32 + (swz % 64) / 2; }
__host__ __device__ __forceinline__ int perm32(int rho) { const int n = rho >> 4, i = rho & 15; return 8 * (i >> 2) + 4 * n + (i & 3); }

struct Unit { int pm, pn, li; };
struct Gemm { const bf16_t* A; const bf16_t* Bt; int K, lda, ldb; const LAS int* gather; };

struct StaticOrder {
    int nM, nN, nwg, G, c;
    __device__ void init(int M, int N, int G_, int c_) { nM = M / BM; nN = N / BM; nwg = nM * nN; G = G_; c = c_; }
    __device__ bool next(int i, Unit& u) const {
        const long L = (long)i * G + c; if (L >= nwg) return false;
        int wgid = (int)L; { const int q = nwg / NXCD, r = nwg % NXCD, xcd = wgid % NXCD, off = wgid / NXCD; wgid = (xcd < r ? xcd * (q + 1) : r * (q + 1) + (xcd - r) * q) + off; }
        const int nig = WGM * nN, gid = wgid / nig, fm = gid * WGM, gsz = (nM - fm) < WGM ? (nM - fm) : WGM;
        u.pm = fm + ((wgid % nig) % gsz); u.pn = (wgid % nig) / gsz; u.li = 0; return true;
    }
};
struct CmpOrder {
    int c;
    __device__ bool next(int i, Unit& u) const { if (i > 0 || c >= 32) return false; u.pm = c; u.pn = c >> 4; u.li = 0; return true; }
};
struct MoeOrder {
    const LAS int* ul;
    __device__ bool next(int i, Unit& u) const {
        if (i >= ul[0]) return false;
        u.pm = ul[2 + 2 * i]; u.pn = ul[3 + 2 * i]; u.li = i; return true;
    }
};

template <class Epi, class Sched, bool GATHER, bool MID = false>
__device__ __forceinline__ void gemm_phase(LAS unsigned char* lds, const Gemm g, const Sched& S, const Epi& E) {
    int tid = threadIdx.x;
    asm volatile("" : "+v"(tid));
    const int wid = __builtin_amdgcn_readfirstlane(tid >> 6), lane = tid & 63, wr = wid >> 2, wc = wid & 3, fr = lane & 15, fq = lane >> 4;
    const int K = g.K, nt = K / BK;
    unsigned voffA[2], voffB[2];
#pragma unroll
    for (int i = 0; i < 2; ++i) { int R, C; stage_rc(tid * 16 + i * 8192, R, C); const int Rb = Epi::PERM ? ((R & ~31) + perm32(R & 31)) : R;
        voffA[i] = (unsigned)(R * g.lda + C) * 2u; voffB[i] = (unsigned)(Rb * g.ldb + C) * 2u; }
    const size_t kstep = (size_t)(BK * 2);
    const size_t hstepA = (size_t)HALF * g.lda * 2, tstepA = 2 * hstepA;
    const size_t hstepB = (size_t)HALF * g.ldb * 2, tstepB = 2 * hstepB;
    const unsigned ldsw = (unsigned)wid * 1024u;
    const int aoff = lds_byte(wr * 64 + fr, fq * 8), boff = lds_byte(wc * 32 + fr, fq * 8);
#define PG8_SA(b, h) (((b) * 2 + (h)) * HTB)
#define PG8_SB(b, h) ((4 + (b) * 2 + (h)) * HTB)
#define PG8_STAGE(bufoff, gbase, voff) do { _Pragma("unroll") for (int _i = 0; _i < 2; ++_i) \
        __builtin_amdgcn_global_load_lds((const unsigned*)((const char*)(gbase) + (voff)[_i]), (LAS unsigned*)(lds + (bufoff) + ldsw + _i * 8192), 16, 0, 0); } while (0)
#define PG8_STAGEG(bufoff, kb, o0, o1) do { \
        __builtin_amdgcn_global_load_lds((const unsigned*)((const char*)g.A + (kb) + (o0)), (LAS unsigned*)(lds + (bufoff) + ldsw), 16, 0, 0); \
        __builtin_amdgcn_global_load_lds((const unsigned*)((const char*)g.A + (kb) + (o1)), (LAS unsigned*)(lds + (bufoff) + ldsw + 8192), 16, 0, 0); } while (0)
#define PG8_STAGEA_CUR(bufoff, kb, h) do { if constexpr (GATHER) { PG8_STAGEG(bufoff, kb, oc[h][0], oc[h][1]); } else { PG8_STAGE(bufoff, cA + (kb) + (h) * hstepA, voffA); } } while (0)
#define PG8_STAGEA_SEL(bufoff, kb, h) do { if constexpr (GATHER) { PG8_STAGEG(bufoff, kb, (last ? on[h][0] : oc[h][0]), (last ? on[h][1] : oc[h][1])); } else { PG8_STAGE(bufoff, a2b + (kb) + (h) * hstepA, voffA); } } while (0)
#define PG8_LDA(dst, b, h) do { _Pragma("unroll") for (int m = 0; m < 4; ++m) _Pragma("unroll") for (int k = 0; k < 2; ++k) dst[m][k] = *(const LAS bf16x8*)(lds + PG8_SA(b, h) + aoff + m * 2048 + k * 1024); } while (0)
#define PG8_LDB(dst, b, h) do { _Pragma("unroll") for (int n = 0; n < 2; ++n) _Pragma("unroll") for (int k = 0; k < 2; ++k) dst[n][k] = *(const LAS bf16x8*)(lds + PG8_SB(b, h) + boff + n * 2048 + k * 1024); } while (0)
#define PG8_MMA(ai, bj, At, Bt) do { __builtin_amdgcn_s_setprio(1); _Pragma("unroll") for (int m = 0; m < 4; ++m) _Pragma("unroll") for (int n = 0; n < 2; ++n) _Pragma("unroll") for (int k = 0; k < 2; ++k) \
        acc[ai][bj][m][n] = __builtin_amdgcn_mfma_f32_16x16x32_bf16(Bt[n][k], At[m][k], acc[ai][bj][m][n], 0, 0, 0); __builtin_amdgcn_s_setprio(0); } while (0)
#define PG8_WAIT_V(n) asm volatile("s_waitcnt vmcnt(" #n ")" ::: "memory")
#define PG8_WAIT_L(n) asm volatile("s_waitcnt lgkmcnt(" #n ")" ::: "memory")
#define PG8_BAR __builtin_amdgcn_s_barrier()
#define PG8_SCHED __builtin_amdgcn_sched_barrier(0)
#define PG8_AOFF(dst, U) do { _Pragma("unroll") for (int _h = 0; _h < 2; ++_h) _Pragma("unroll") for (int _i = 0; _i < 2; ++_i) { \
        int _R, _C; stage_rc(tid * 16 + _i * 8192, _R, _C); const int _gr = g.gather[(U).li * BM + _h * HALF + _R]; \
        dst[_h][_i] = (unsigned)((_gr * g.lda + _C) * 2); } } while (0)
    Unit cur, nxt; int ui = 0;
    if (!S.next(0, cur)) return;
    f32x4 acc[2][2][4][2];
#pragma unroll
    for (int a = 0; a < 2; ++a)
#pragma unroll
        for (int b = 0; b < 2; ++b)
#pragma unroll
            for (int m = 0; m < 4; ++m)
#pragma unroll
                for (int n = 0; n < 2; ++n) acc[a][b][m][n] = (f32x4){0.f, 0.f, 0.f, 0.f};
    bf16x8 At[4][2], B0[2][2], B1[2][2];
    unsigned oc[2][2] = {{0u, 0u}, {0u, 0u}}, on[2][2] = {{0u, 0u}, {0u, 0u}};
    if constexpr (GATHER) { PG8_AOFF(oc, cur); }
    const char* cA = (const char*)g.A + (GATHER ? (size_t)0 : (size_t)cur.pm * tstepA);
    const char* cB = (const char*)g.Bt + (size_t)cur.pn * tstepB;
    PG8_STAGE(PG8_SB(0, 0), cB, voffB); PG8_STAGEA_CUR(PG8_SA(0, 0), 0, 0); PG8_STAGE(PG8_SB(0, 1), cB + hstepB, voffB); PG8_STAGEA_CUR(PG8_SA(0, 1), 0, 1);
    if (wr == 1) PG8_BAR;
    PG8_WAIT_V(4); PG8_BAR;
    PG8_STAGE(PG8_SB(1, 0), cB + kstep, voffB); PG8_STAGEA_CUR(PG8_SA(1, 0), kstep, 0); PG8_STAGE(PG8_SB(1, 1), cB + hstepB + kstep, voffB);
    PG8_WAIT_V(6); PG8_BAR;
    for (;;) {
        const bool has_next = S.next(ui + 1, nxt);
        if constexpr (GATHER) { if (has_next) { PG8_AOFF(on, nxt); } else { on[0][0] = oc[0][0]; on[0][1] = oc[0][1]; on[1][0] = oc[1][0]; on[1][1] = oc[1][1]; } }
        const char* nA = (has_next && !GATHER) ? (const char*)g.A + (size_t)nxt.pm * tstepA : cA;
        const char* nB = has_next ? (const char*)g.Bt + (size_t)nxt.pn * tstepB : cB;
        for (int t = 0; t < nt; t += 2) {
            if constexpr (MID) { if (t == nt / 2) E.mid(acc, cur, wr, wc, fr, fq); }
            const bool last = (t == nt - 2);
            const size_t k1 = (size_t)(t + 1) * kstep;
            const size_t k2 = last ? 0 : (size_t)(t + 2) * kstep, k3 = k2 + kstep;
            const char* a2b = last ? nA : cA;
            const char* b2 = last ? nB : cB + (size_t)(t + 2) * kstep; const char* b3 = b2 + kstep;
            PG8_LDB(B0, 0, 0); PG8_SCHED; PG8_LDA(At, 0, 0); PG8_STAGEA_CUR(PG8_SA(1, 1), k1, 1);
            PG8_WAIT_L(8); PG8_BAR; PG8_WAIT_L(0); PG8_MMA(0, 0, At, B0); PG8_BAR; PG8_SCHED;
            PG8_LDB(B1, 0, 1); PG8_STAGE(PG8_SB(0, 0), b2, voffB);
            PG8_BAR; PG8_WAIT_L(0); PG8_MMA(0, 1, At, B1); PG8_BAR;
            PG8_LDA(At, 0, 1); PG8_STAGEA_SEL(PG8_SA(0, 0), k2, 0);
            PG8_BAR; PG8_WAIT_L(0); PG8_MMA(1, 0, At, B0); PG8_BAR; PG8_SCHED;
            PG8_STAGE(PG8_SB(0, 1), b2 + hstepB, voffB);
            PG8_WAIT_V(6); PG8_BAR; PG8_MMA(1, 1, At, B1); PG8_BAR;
            PG8_LDB(B0, 1, 0); PG8_SCHED; PG8_LDA(At, 1, 0); PG8_STAGEA_SEL(PG8_SA(0, 1), k2, 1);
            PG8_WAIT_L(8); PG8_BAR; PG8_WAIT_L(0); PG8_MMA(0, 0, At, B0); PG8_BAR; PG8_SCHED;
            PG8_LDB(B1, 1, 1); PG8_STAGE(PG8_SB(1, 0), b3, voffB);
            PG8_BAR; PG8_WAIT_L(0); PG8_MMA(0, 1, At, B1); PG8_BAR;
            PG8_LDA(At, 1, 1); PG8_STAGEA_SEL(PG8_SA(1, 0), k3, 0);
            PG8_BAR; PG8_WAIT_L(0); PG8_MMA(1, 0, At, B0); PG8_BAR; PG8_SCHED;
            PG8_STAGE(PG8_SB(1, 1), b3 + hstepB, voffB);
            PG8_WAIT_V(6); PG8_BAR; PG8_MMA(1, 1, At, B1); PG8_BAR;
        }
        E(acc, cur, wr, wc, fr, fq);
        if (!has_next) break;
#pragma unroll
        for (int a = 0; a < 2; ++a)
#pragma unroll
            for (int b = 0; b < 2; ++b)
#pragma unroll
                for (int m = 0; m < 4; ++m)
#pragma unroll
                    for (int n = 0; n < 2; ++n) acc[a][b][m][n] = (f32x4){0.f, 0.f, 0.f, 0.f};
        cur = nxt; cA = nA; cB = nB; ++ui;
        if constexpr (GATHER) { oc[0][0] = on[0][0]; oc[0][1] = on[0][1]; oc[1][0] = on[1][0]; oc[1][1] = on[1][1]; }
    }
    PG8_WAIT_V(0);
    if (wr == 0) PG8_BAR;
    PG8_BAR;
#undef PG8_SA
#undef PG8_SB
#undef PG8_STAGE
#undef PG8_STAGEG
#undef PG8_STAGEA_CUR
#undef PG8_STAGEA_SEL
#undef PG8_LDA
#undef PG8_LDB
#undef PG8_MMA
#undef PG8_WAIT_V
#undef PG8_WAIT_L
#undef PG8_BAR
#undef PG8_SCHED
#undef PG8_AOFF
}
}

typedef f32x4 AccT[2][2][4][2];

struct EpiProj {
    static constexpr bool PERM = true;
    const float* rs; bf16_t* QA; bf16_t* KA; float* G24;
    __device__ __forceinline__ void operator()(const AccT& acc, const pg8::Unit& u, int wr, int wc, int fr, int fq) const {
        const int row0 = u.pm * 256 + wr * 64 + fr;
        const int pn = u.pn;
        float rr[2][4];
#pragma unroll
        for (int ai = 0; ai < 2; ++ai)
#pragma unroll
            for (int m = 0; m < 4; ++m) rr[ai][m] = rs[row0 + ai * 128 + m * 16];
        if (pn == 0 || pn == 1 || pn == 3 || pn == 4) {
            bf16_t* Q = QA + (long)((pn >= 3) ? 1 : 0) * T_TOK * 512 + ((pn == 1 || pn == 4) ? 256 : 0) + wc * 32 + fq * 8;
#pragma unroll
            for (int ai = 0; ai < 2; ++ai)
#pragma unroll
                for (int m = 0; m < 4; ++m) {
                    const int row = row0 + ai * 128 + m * 16;
                    const float sc = rr[ai][m] * QSCALE;
#pragma unroll
                    for (int bj = 0; bj < 2; ++bj) {
                        const f32x4 v0 = acc[ai][bj][m][0], v1 = acc[ai][bj][m][1];
                        u32x4 w; w.x = cvt_pk_bf16(v0[0] * sc, v0[1] * sc); w.y = cvt_pk_bf16(v0[2] * sc, v0[3] * sc); w.z = cvt_pk_bf16(v1[0] * sc, v1[1] * sc); w.w = cvt_pk_bf16(v1[2] * sc, v1[3] * sc);
                        *(u32x4*)(Q + (long)row * 512 + bj * 128) = w;
                    }
                    __builtin_amdgcn_sched_barrier(0);
                }
        } else if (pn == 8) {
            if (wc == 0 && fq < 3) {
#pragma unroll
                for (int ai = 0; ai < 2; ++ai)
#pragma unroll
                    for (int m = 0; m < 4; ++m) {
                        const int row = row0 + ai * 128 + m * 16;
                        const float r = rr[ai][m];
                        const f32x4 v0 = acc[ai][0][m][0], v1 = acc[ai][0][m][1];
                        float* gp = G24 + (long)row * 32 + fq * 8;
                        *(f32x4*)gp = (f32x4){fast_sigmoid(v0[0] * r), fast_sigmoid(v0[1] * r), fast_sigmoid(v0[2] * r), fast_sigmoid(v0[3] * r)};
                        *(f32x4*)(gp + 4) = (f32x4){fast_sigmoid(v1[0] * r), fast_sigmoid(v1[1] * r), fast_sigmoid(v1[2] * r), fast_sigmoid(v1[3] * r)};
                        __builtin_amdgcn_sched_barrier(0);
                    }
            }
        } else {
            const int g = wc >> 1, d0 = (wc & 1) * 32 + fq * 8;
            const int kslot = (pn == 2) ? 0 : (pn == 5) ? 1 : (pn - 3), vslot = (pn == 2) ? 5 : (pn == 5) ? 2 : pn;
            bf16_t* Kd = KA + (long)kslot * (16 * SEQ * 64) + (long)g * SEQ * 64 + d0;
            bf16_t* Vd = KA + (long)vslot * (16 * SEQ * 64);
            Vd += (pn == 5) ? ((long)g * SEQ * 64 + d0) : ((long)(g * 64 + d0) * SEQ);
#pragma unroll
            for (int ai = 0; ai < 2; ++ai)
#pragma unroll
                for (int m = 0; m < 4; ++m) {
                    const int row = row0 + ai * 128 + m * 16;
                    const float r = rr[ai][m];
                    const int b = row >> 12, s = row & 4095;
                    {
                        const f32x4 v0 = acc[ai][0][m][0], v1 = acc[ai][0][m][1];
                        u32x4 w; w.x = cvt_pk_bf16(v0[0] * r, v0[1] * r); w.y = cvt_pk_bf16(v0[2] * r, v0[3] * r); w.z = cvt_pk_bf16(v1[0] * r, v1[1] * r); w.w = cvt_pk_bf16(v1[2] * r, v1[3] * r);
                        *(u32x4*)(Kd + ((long)b * 2 * SEQ + s) * 64) = w;
                    }
                    const f32x4 v0 = acc[ai][1][m][0], v1 = acc[ai][1][m][1];
                    if (pn == 5) {
                        u32x4 w; w.x = cvt_pk_bf16(v0[0] * r, v0[1] * r); w.y = cvt_pk_bf16(v0[2] * r, v0[3] * r); w.z = cvt_pk_bf16(v1[0] * r, v1[1] * r); w.w = cvt_pk_bf16(v1[2] * r, v1[3] * r);
                        *(u32x4*)(Vd + ((long)b * 2 * SEQ + s) * 64) = w;
                    } else {
                        bf16_t* vp = Vd + (long)b * 2 * 64 * SEQ + s;
#pragma unroll
                        for (int j = 0; j < 4; ++j) {
                            vp[(long)j * SEQ] = (bf16_t)(cvt_pk_bf16(v0[j] * r, 0.f) & 0xffffu);
                            vp[(long)(4 + j) * SEQ] = (bf16_t)(cvt_pk_bf16(v1[j] * r, 0.f) & 0xffffu);
                        }
                    }
                    __builtin_amdgcn_sched_barrier(0);
                }
        }
    }
};
struct EpiCmp1 {
    static constexpr bool PERM = true;
    const float* cb1; bf16_t* CHID;
    __device__ __forceinline__ void operator()(const AccT& acc, const pg8::Unit& u, int wr, int wc, int fr, int fq) const {
        const int row0 = u.pm * 256 + wr * 64 + fr;
        const float* cb = cb1 + u.pn * 256 + wc * 32 + fq * 8;
#pragma unroll
        for (int bj = 0; bj < 2; ++bj) {
            const f32x4 b0 = *(const f32x4*)(cb + bj * 128), b1 = *(const f32x4*)(cb + bj * 128 + 4);
#pragma unroll
            for (int ai = 0; ai < 2; ++ai)
#pragma unroll
                for (int m = 0; m < 4; ++m) {
                    const int row = row0 + ai * 128 + m * 16;
                    float y[8];
#pragma unroll
                    for (int j = 0; j < 4; ++j) { y[j] = acc[ai][bj][m][0][j] + b0[j]; y[4 + j] = acc[ai][bj][m][1][j] + b1[j]; }
#pragma unroll
                    for (int j = 0; j < 8; ++j) { const float x = y[j]; const float uu = 0.7978845608028654f * (x + 0.044715f * x * x * x); y[j] = x * fast_sigmoid(2.0f * uu); }
                    u32x4 w; w.x = cvt_pk_bf16(y[0], y[1]); w.y = cvt_pk_bf16(y[2], y[3]); w.z = cvt_pk_bf16(y[4], y[5]); w.w = cvt_pk_bf16(y[6], y[7]);
                    *(u32x4*)(CHID + (long)row * 256 + bj * 128 + wc * 32 + fq * 8) = w;
                    __builtin_amdgcn_sched_barrier(0);
                }
        }
    }
};
__device__ __forceinline__ void cmp_gemm2(const Params& p, int l, int pm) {
    asm volatile("s_waitcnt vmcnt(0)" ::: "memory");
    __syncthreads();
    __builtin_amdgcn_fence(__ATOMIC_ACQUIRE, "agent");
    asm volatile("s_waitcnt vmcnt(0)" ::: "memory");
    int tid = threadIdx.x; asm volatile("" : "+v"(tid));
    const int wave = tid >> 6, lane = tid & 63, fr = lane & 15, fq = lane >> 4;
    const int kv = pm >> 4, bg = pm & 15;
    const bf16_t* A = p.CHID + ((long)pm * 256 + wave * 32) * 256;
    const bf16_t* Bt = p.CW2T + ((long)(l * 2 + kv) * 64) * 256;
    f32x4 acc[2][4];
#pragma unroll
    for (int rt = 0; rt < 2; ++rt)
#pragma unroll
        for (int ct = 0; ct < 4; ++ct) acc[rt][ct] = (f32x4){0.f, 0.f, 0.f, 0.f};
#pragma unroll
    for (int ks = 0; ks < 8; ++ks) {
        bf16x8 af[2], bf[4];
#pragma unroll
        for (int rt = 0; rt < 2; ++rt) af[rt] = *(const bf16x8*)(A + (long)(rt * 16 + fr) * 256 + ks * 32 + fq * 8);
#pragma unroll
        for (int ct = 0; ct < 4; ++ct) bf[ct] = *(const bf16x8*)(Bt + (long)(ct * 16 + fr) * 256 + ks * 32 + fq * 8);
#pragma unroll
        for (int rt = 0; rt < 2; ++rt)
#pragma unroll
            for (int ct = 0; ct < 4; ++ct) acc[rt][ct] = __builtin_amdgcn_mfma_f32_16x16x32_bf16(af[rt], bf[ct], acc[rt][ct], 0, 0, 0);
    }
#pragma unroll
    for (int rt = 0; rt < 2; ++rt)
#pragma unroll
        for (int ct = 0; ct < 4; ++ct) {
            const int n = ct * 16 + fr, i0 = wave * 32 + rt * 16 + 4 * fq;
            f32x4 v = acc[rt][ct];
            if (i0 + 3 == 255) v[3] = 0.f;
            if (kv == 0) {
#pragma unroll
                for (int j = 0; j < 4; ++j) p.KCMP[((long)bg * 256 + i0 + j) * 64 + n] = (bf16_t)(cvt_pk_bf16(v[j], 0.f) & 0xffffu);
            } else {
                u32x2 w; w.x = cvt_pk_bf16(v[0], v[1]); w.y = cvt_pk_bf16(v[2], v[3]);
                *(u32x2*)(p.VCMPT + ((long)bg * 64 + n) * 256 + i0) = w;
            }
        }
}

#define AT_ROWB 144
#define AT_KT(b) ((b) * 9216)
#define AT_VT(b) (18432 + (b) * 9216)
#define AT_IMP 36864
#define AT_SEL (36864 + 4 * 64 * 66 * 4)
#define NEG_INF (-INFINITY)

struct AttSt { f32x16 O0, O1, CI; float m, l; };
__device__ __forceinline__ void att_init(AttSt& s, float cb = 0.f) {
#pragma unroll
    for (int i = 0; i < 16; ++i) { s.O0[i] = 0.f; s.O1[i] = 0.f; s.CI[i] = cb; }
    s.m = NEG_INF; s.l = 0.f;
}
__device__ __forceinline__ u32x4 at_gload(int tid, const bf16_t* base, long rstride) {
    const int row = tid >> 3, piece = tid & 7;
    return *(const u32x4*)(base + (long)row * rstride + piece * 8);
}
__device__ __forceinline__ void at_lwrite(int tid, LAS unsigned char* dst, u32x4 v) {
    const int row = tid >> 3, piece = tid & 7;
    *(LAS u32x4*)(dst + row * AT_ROWB + piece * 16) = v;
}
typedef __bf16 bf16x2n __attribute__((ext_vector_type(2)));
__device__ __forceinline__ unsigned pk_bf16_native(float lo, float hi) { bf16x2n v = {(__bf16)lo, (__bf16)hi}; return __builtin_bit_cast(unsigned, v); }
__device__ __forceinline__ float max3f(float a, float b, float c) { float r; asm("v_max3_f32 %0, %1, %2, %3" : "=v"(r) : "v"(a), "v"(b), "v"(c)); return r; }
__device__ __forceinline__ void at_scores(LAS const unsigned char* ktl, const bf16x8 (&qf)[4], f32x16& s0, f32x16& s1, const f32x16& ci) {
    bf16x8 kf[8];
#pragma unroll
    for (int s = 0; s < 4; ++s) { kf[2 * s] = *(LAS const bf16x8*)(ktl + s * 32); kf[2 * s + 1] = *(LAS const bf16x8*)(ktl + 32 * AT_ROWB + s * 32); }
    __builtin_amdgcn_sched_barrier(0);
    s0 = __builtin_amdgcn_mfma_f32_32x32x16_bf16(kf[0], qf[0], ci, 0, 0, 0);
    s1 = __builtin_amdgcn_mfma_f32_32x32x16_bf16(kf[1], qf[0], ci, 0, 0, 0);
#pragma unroll
    for (int s = 1; s < 4; ++s) {
        s0 = __builtin_amdgcn_mfma_f32_32x32x16_bf16(kf[2 * s], qf[s], s0, 0, 0, 0);
        s1 = __builtin_amdgcn_mfma_f32_32x32x16_bf16(kf[2 * s + 1], qf[s], s1, 0, 0, 0);
    }
}
__device__ __forceinline__ void at_scores0(LAS const unsigned char* ktl, const bf16x8 (&qf)[4], f32x16& s0, f32x16& s1) {
    f32x16 z;
#pragma unroll
    for (int i = 0; i < 16; ++i) z[i] = 0.f;
    at_scores(ktl, qf, s0, s1, z);
}
__device__ __forceinline__ void at_vload(LAS const unsigned char* vtl, bf16x8 (&vf)[8]) {
#pragma unroll
    for (int ks = 0; ks < 4; ++ks) { vf[2 * ks] = *(LAS const bf16x8*)(vtl + ks * 32); vf[2 * ks + 1] = *(LAS const bf16x8*)(vtl + 32 * AT_ROWB + ks * 32); }
}
template <bool MASKQ = false>
__device__ __forceinline__ void at_pv(const bf16x8 (&vf)[8], const f32x16& p0, const f32x16& p1, AttSt& st, bool mine = true) {
    bf16x8 pf[4];
#pragma unroll
    for (int sg = 0; sg < 2; ++sg) {
        u32x4 a, b;
        a.x = pk_bf16_native(p0[8 * sg + 0], p0[8 * sg + 1]); a.y = pk_bf16_native(p0[8 * sg + 2], p0[8 * sg + 3]); a.z = pk_bf16_native(p0[8 * sg + 4], p0[8 * sg + 5]); a.w = pk_bf16_native(p0[8 * sg + 6], p0[8 * sg + 7]);
        b.x = pk_bf16_native(p1[8 * sg + 0], p1[8 * sg + 1]); b.y = pk_bf16_native(p1[8 * sg + 2], p1[8 * sg + 3]); b.z = pk_bf16_native(p1[8 * sg + 4], p1[8 * sg + 5]); b.w = pk_bf16_native(p1[8 * sg + 6], p1[8 * sg + 7]);
        if (MASKQ) { a.x = mine ? a.x : 0u; a.y = mine ? a.y : 0u; a.z = mine ? a.z : 0u; a.w = mine ? a.w : 0u; b.x = mine ? b.x : 0u; b.y = mine ? b.y : 0u; b.z = mine ? b.z : 0u; b.w = mine ? b.w : 0u; }
        pf[sg] = __builtin_bit_cast(bf16x8, a); pf[2 + sg] = __builtin_bit_cast(bf16x8, b);
    }
#pragma unroll
    for (int ks = 0; ks < 4; ++ks) {
        st.O0 = __builtin_amdgcn_mfma_f32_32x32x16_bf16(vf[2 * ks], pf[ks], st.O0, 0, 0, 0);
        st.O1 = __builtin_amdgcn_mfma_f32_32x32x16_bf16(vf[2 * ks + 1], pf[ks], st.O1, 0, 0, 0);
    }
}
#define AT_THR 20.0f
template <bool MASKQ = false>
__device__ __forceinline__ void at_softmax_pv(LAS const unsigned char* vtl, f32x16& s0, f32x16& s1, AttSt& st, bool mine = true) {
    bf16x8 vf[8];
    at_vload(vtl, vf);
    __builtin_amdgcn_sched_barrier(0);
    float tm = fmaxf(s0[15], s1[15]);
#pragma unroll
    for (int i = 0; i < 15; ++i) tm = max3f(tm, s0[i], s1[i]);
    tm = half_swap_max(tm);
    if (MASKQ) tm = mine ? tm : NEG_INF;
    const bool unset = (st.m == NEG_INF);
    const bool need = unset ? (tm > NEG_INF) : (tm > AT_THR);
    if (__any(need)) {
        const float delta = need ? tm : 0.f;
        const float al = __builtin_amdgcn_exp2f(-delta);
#pragma unroll
        for (int i = 0; i < 16; ++i) { s0[i] -= delta; s1[i] -= delta; st.O0[i] *= al; st.O1[i] *= al; st.CI[i] -= delta; }
        st.l *= al;
        st.m = need ? ((unset ? 0.f : st.m) + delta) : st.m;
    }
    typedef float f32x2v __attribute__((ext_vector_type(2)));
    f32x2v ls = (f32x2v){0.f, 0.f};
#pragma unroll
    for (int i = 0; i < 16; ++i) { s0[i] = __builtin_amdgcn_exp2f(s0[i]); s1[i] = __builtin_amdgcn_exp2f(s1[i]); }
#pragma unroll
    for (int i = 0; i < 16; i += 2) { ls += (f32x2v){s0[i], s0[i + 1]}; ls += (f32x2v){s1[i], s1[i + 1]}; }
    const float lsum = ls.x + ls.y;
    st.l += MASKQ ? (mine ? lsum : 0.f) : lsum;
    at_pv<MASKQ>(vf, s0, s1, st, mine);
}
__device__ __forceinline__ void at_softmax_abs(f32x16& s0, f32x16& s1, AttSt& st) {
    float tm = fmaxf(s0[15], s1[15]);
#pragma unroll
    for (int i = 0; i < 15; ++i) tm = max3f(tm, s0[i], s1[i]);
    tm = half_swap_max(tm);
    const float mn = fmaxf(st.m, tm);
    const float al = (st.m == NEG_INF) ? 0.f : __builtin_amdgcn_exp2f(st.m - mn);
    const float mu = (mn == NEG_INF) ? 0.f : mn;
#pragma unroll
    for (int i = 0; i < 16; ++i) { st.O0[i] *= al; st.O1[i] *= al; }
    st.l *= al; st.m = mn;
    typedef float f32x2v __attribute__((ext_vector_type(2)));
    f32x2v ls = (f32x2v){0.f, 0.f};
#pragma unroll
    for (int i = 0; i < 16; ++i) { s0[i] = __builtin_amdgcn_exp2f(s0[i] - mu); s1[i] = __builtin_amdgcn_exp2f(s1[i] - mu); }
#pragma unroll
    for (int i = 0; i < 16; i += 2) { ls += (f32x2v){s0[i], s0[i + 1]}; ls += (f32x2v){s1[i], s1[i + 1]}; }
    st.l += ls.x + ls.y;
}
#define AT_KO(tau, reg) (32 * (tau) + 16 * ((reg) >> 3) + ((reg) & 7))

__device__ __forceinline__ void at_bias_table(f32x16& s0, f32x16& s1, LAS const float* tabl) {
#pragma unroll
    for (int i = 0; i < 16; ++i) { s0[i] += tabl[AT_KO(0, i)]; s1[i] += tabl[AT_KO(1, i)]; }
}
__device__ __forceinline__ void at_mask_gt(f32x16& s0, f32x16& s1, int thrl) {
#pragma unroll
    for (int i = 0; i < 16; ++i) { s0[i] = (AT_KO(0, i) > thrl) ? s0[i] : NEG_INF; s1[i] = (AT_KO(1, i) > thrl) ? s1[i] : NEG_INF; }
}
__device__ __forceinline__ void at_mask_lt(f32x16& s0, f32x16& s1, int thrl) {
#pragma unroll
    for (int i = 0; i < 16; ++i) { s0[i] = (AT_KO(0, i) < thrl) ? s0[i] : NEG_INF; s1[i] = (AT_KO(1, i) < thrl) ? s1[i] : NEG_INF; }
}
__device__ __forceinline__ void at_store(bf16_t* dst  , const AttSt& st, float scale, int hq) {
#pragma unroll
    for (int dl = 0; dl < 2; ++dl)
#pragma unroll
        for (int sg = 0; sg < 2; ++sg) {
            const f32x16& O = dl ? st.O1 : st.O0;
            u32x4 w;
            w.x = cvt_pk_bf16(O[8 * sg + 0] * scale, O[8 * sg + 1] * scale); w.y = cvt_pk_bf16(O[8 * sg + 2] * scale, O[8 * sg + 3] * scale);
            w.z = cvt_pk_bf16(O[8 * sg + 4] * scale, O[8 * sg + 5] * scale); w.w = cvt_pk_bf16(O[8 * sg + 6] * scale, O[8 * sg + 7] * scale);
            *(u32x4*)(dst + 32 * dl + 16 * sg + 8 * hq) = w;
        }
}
__device__ __forceinline__ int at_pi(int rho) { return (rho & 0x13) | ((rho & 4) << 1) | ((rho & 8) >> 1); }

__device__ __forceinline__ void build_tables(const Params& p, LAS unsigned char* lds) {
    LAS float* TR = (LAS float*)(lds + LDS_TAB_OFF);
    for (int e = threadIdx.x; e < 16 * 256; e += NTHR) {
        const int h = e >> 8, x = e & 255, dist = 191 - x;
        float v;
        if (dist < 0) v = NEG_INF;
        else if (dist < 128) v = (p.rel_bias[kBucket[dist] * 16 + h] - ((h < 8) ? 0.f : p.rel_bias[31 * 16 + h])) * LOG2E;
        else v = (h < 8) ? NEG_INF : 0.f;
        TR[e] = v;
    }
    __syncthreads();
}

#define AT_STEP(RKL, RVL, RKW, RVW, KB, KST, KRS, VB, VST, VRS, ...) { \
        { const int jl_ = (j + 3 < je_) ? j + 3 : je_; RKL = at_gload(tid, (KB) + (long)jl_ * (KST), (KRS)); RVL = at_gload(tid, (VB) + (long)jl_ * (VST), (VRS)); } \
        { const int buf = (j - j0_) & 1; __VA_ARGS__ \
          if (j < je_) { at_lwrite(tid, lds + AT_KT(buf ^ 1), RKW); at_lwrite(tid, lds + AT_VT(buf ^ 1), RVW); } } \
        __syncthreads(); \
        if (j == je_) break; \
        ++j; }
struct TileSets { u32x4 k0, v0, k1, v1, k2, v2; };
#define AT_PRELOAD(S, J0, JE, KB, KST, KRS, VB, VST, VRS) { \
        const int a_ = (J0), e_ = (JE); const int b_ = (a_ + 1 < e_) ? a_ + 1 : e_, c_ = (a_ + 2 < e_) ? a_ + 2 : e_; \
        S.k0 = at_gload(tid, (KB) + (long)a_ * (KST), (KRS)); S.v0 = at_gload(tid, (VB) + (long)a_ * (VST), (VRS)); \
        S.k1 = at_gload(tid, (KB) + (long)b_ * (KST), (KRS)); S.v1 = at_gload(tid, (VB) + (long)b_ * (VST), (VRS)); \
        S.k2 = at_gload(tid, (KB) + (long)c_ * (KST), (KRS)); S.v2 = at_gload(tid, (VB) + (long)c_ * (VST), (VRS)); }
#define AT_LOOP_FROM(S, J0, JE, KB, KST, KRS, VB, VST, VRS, ...) { \
        const int j0_ = (J0), je_ = (JE); \
        at_lwrite(tid, lds + AT_KT(0), S.k0); at_lwrite(tid, lds + AT_VT(0), S.v0); \
        __syncthreads(); \
        for (int j = j0_;;) { \
            AT_STEP(S.k0, S.v0, S.k1, S.v1, KB, KST, KRS, VB, VST, VRS, __VA_ARGS__) \
            AT_STEP(S.k1, S.v1, S.k2, S.v2, KB, KST, KRS, VB, VST, VRS, __VA_ARGS__) \
            AT_STEP(S.k2, S.v2, S.k0, S.v0, KB, KST, KRS, VB, VST, VRS, __VA_ARGS__) \
        } }

__device__ __forceinline__ void attn_aw_unit(const Params& p, int l, int b, int g, int c, LAS unsigned char* lds, int PARTS) {
    int tid = threadIdx.x; asm volatile("" : "+v"(tid));
    const int wave = tid >> 6, lane = tid & 63, r = wave & 3, th = wave >> 2, hq = lane >> 5, ql = lane & 31;
    const int h = g * 4 + r, bg = b * 2 + g;
    const int tl = 32 * th + ql;
    const long tok = (long)b * SEQ + 64 * c + tl;
    LAS const unsigned char* ktl = lds + at_pi(ql) * AT_ROWB + 16 * hq;
    LAS const unsigned char* vtl = lds + at_pi(ql) * AT_ROWB + 16 * hq;
    LAS const float* TR = (LAS const float*)(lds + LDS_TAB_OFF);
    bf16x8 qf[4], qfb[4];
    AttSt st;
    const bf16_t* KAp = p.KA + (long)bg * SEQ * 64; const bf16_t* VAp = p.VAT + (long)bg * 64 * SEQ;
    const bf16_t* KWp = p.KW + (long)bg * SEQ * 64; const bf16_t* VWp = p.VWT + (long)bg * 64 * SEQ;
    const int ja0 = (c - 2 < 0) ? 0 : c - 2, jw0 = (c - 8 < 0) ? 0 : c - 8;
    TileSets SA, SW;
    float gwin = 0.f, sinkv = 0.f, cbw = 0.f;
    if (PARTS & 1) {
#pragma unroll
        for (int s = 0; s < 4; ++s) qf[s] = *(const bf16x8*)(p.QA + tok * 512 + h * 64 + 16 * s + 8 * hq);
        AT_PRELOAD(SA, ja0, c, KAp, 4096, 64, VAp, 64, SEQ)
        sinkv = p.a_sinks[l * 8 + h] * LOG2E;
    }
    if (PARTS & 2) {
#pragma unroll
        for (int s = 0; s < 4; ++s) qfb[s] = *(const bf16x8*)(p.QB + tok * 512 + h * 64 + 16 * s + 8 * hq);
        AT_PRELOAD(SW, jw0, c, KWp, 4096, 64, VWp, 64, SEQ)
        gwin = p.G24[tok * 32 + h * 3 + 2];
        cbw = p.rel_bias[31 * 16 + 8 + h] * LOG2E;
    }
    if (PARTS & 1) {
        att_init(st);
        AT_LOOP_FROM(SA, ja0, c, KAp, 4096, 64, VAp, 64, SEQ, {
            f32x16 s0, s1;
            at_scores(ktl + AT_KT(buf), qf, s0, s1, st.CI);
            const int drel = 64 * (c - j) + tl;
            at_bias_table(s0, s1, TR + h * 256 + (191 - drel + 8 * hq));
            at_softmax_pv(vtl + AT_VT(buf), s0, s1, st); })
        float lt = half_swap_sum(st.l);
        lt += __builtin_amdgcn_exp2f(sinkv - st.m);
        at_store(p.OAB + tok * 1024 + h * 64, st, 1.0f / lt, hq);
    }
    if (PARTS & 2) {
        att_init(st, cbw);
        AT_LOOP_FROM(SW, jw0, c, KWp, 4096, 64, VWp, 64, SEQ, {
            f32x16 s0, s1;
            at_scores(ktl + AT_KT(buf), qfb, s0, s1, st.CI);
            if (j >= c - 2) {
                const int drel = 64 * (c - j) + tl;
                at_bias_table(s0, s1, TR + (8 + h) * 256 + (191 - drel + 8 * hq));
            } else if (j == c - 8) at_mask_gt(s0, s1, tl - 8 * hq);
            at_softmax_pv(vtl + AT_VT(buf), s0, s1, st); })
        const float lt = half_swap_sum(st.l);
        at_store(p.OW + tok * 512 + h * 64, st, gwin / lt, hq);
    }
}

__device__ __forceinline__ void attn_cs_unit(const Params& p, int b, int g, int c, LAS unsigned char* lds) {
    int tid = threadIdx.x; asm volatile("" : "+v"(tid));
    const int wave = tid >> 6, lane = tid & 63, r = wave & 3, th = wave >> 2, hq = lane >> 5, ql = lane & 31;
    const int h = g * 4 + r, bg = b * 2 + g;
    const int tl = 32 * th + ql, tq = 64 * c + tl;
    const long tok = (long)b * SEQ + tq;
    LAS const unsigned char* ktl = lds + at_pi(ql) * AT_ROWB + 16 * hq;
    LAS const unsigned char* vtl = lds + at_pi(ql) * AT_ROWB + 16 * hq;
    LAS const float* TR = (LAS const float*)(lds + LDS_TAB_OFF);
    LAS float* IMP = (LAS float*)(lds + AT_IMP);
    LAS unsigned long long* SEL = (LAS unsigned long long*)(lds + AT_SEL);
    bf16x8 qf[4];
#pragma unroll
    for (int s = 0; s < 4; ++s) qf[s] = *(const bf16x8*)(p.QB + tok * 512 + h * 64 + 16 * s + 8 * hq);
    const int nv = (tq >= 31) ? ((tq - 31) / 16 + 1) : 0;
    const int nv_hi = (64 * c + 63 - 31) / 16 + 1;
    const int ntile = (nv_hi + 63) / 64;
    const bf16_t* KC = p.KCMP + (long)bg * 256 * 64; const bf16_t* VCT = p.VCMPT + (long)bg * 64 * 256;
    const bf16_t* KSp = p.KS + (long)bg * SEQ * 64; const bf16_t* VSp = p.VST + (long)bg * 64 * SEQ;
    TileSets S1, S2;
    AT_PRELOAD(S2, 0, ntile - 1, KC, 4096, 64, VCT, 64, 256)
    AttSt st; att_init(st);
    float imp_carry = 0.f, rf0 = NEG_INF, rf1 = NEG_INF, rf2 = NEG_INF, rf3 = NEG_INF;
    LAS float* IMF = (LAS float*)(lds + AT_SEL + 512);
    AT_LOOP_FROM(S2, 0, ntile - 1, KC, 4096, 64, VCT, 64, 256, {
        f32x16 s0, s1;
        at_scores0(ktl + AT_KT(buf), qf, s0, s1);
        at_mask_lt(s0, s1, nv - 64 * j - 8 * hq);
        const float mb = st.m;
        at_softmax_abs(s0, s1, st);
        if (j == 0) rf0 = st.m; else if (j == 1) rf1 = st.m; else if (j == 2) rf2 = st.m; else rf3 = st.m;
        imp_carry *= (mb == NEG_INF) ? 0.f : __builtin_amdgcn_exp2f(mb - st.m);
        if (c >= 16) { float G0[4], G1[4];
          _Pragma("unroll") for (int a = 0; a < 4; ++a) { G0[a] = (s0[4 * a] + s0[4 * a + 1]) + (s0[4 * a + 2] + s0[4 * a + 3]); G1[a] = (s1[4 * a] + s1[4 * a + 1]) + (s1[4 * a + 2] + s1[4 * a + 3]); }
          const float r01 = half_other(s0[7], hq), r03 = half_other(s0[15], hq), r11 = half_other(s1[7], hq), r13 = half_other(s1[15], hq);
          LAS float* irow = IMP + (r * 64 + tl) * 66 + 16 * j + 2 * hq;
          irow[0]  = G0[0] + (hq ? r01 : imp_carry);
          irow[1]  = G0[1] + s0[3];
          irow[4]  = G0[2] + (hq ? r03 : r01);
          irow[5]  = G0[3] + s0[11];
          irow[8]  = G1[0] + (hq ? r11 : r03);
          irow[9]  = G1[1] + s1[3];
          irow[12] = G1[2] + (hq ? r13 : r11);
          irow[13] = G1[3] + s1[11];
          imp_carry = r13; }
        { bf16x8 vf[8]; at_vload(vtl + AT_VT(buf), vf); at_pv(vf, s0, s1, st); } })
    AT_PRELOAD(S1, 0, c, KSp, 4096, 64, VSp, 64, SEQ)
    const float g0 = p.G24[tok * 32 + h * 3 + 0], g1 = p.G24[tok * 32 + h * 3 + 1];
    const float cbs = p.rel_bias[31 * 16 + 8 + h] * LOG2E;
    u32x4 owp[4];
#pragma unroll
    for (int q4 = 0; q4 < 4; ++q4) owp[q4] = *(const u32x4*)(p.OW + tok * 512 + h * 64 + 32 * (q4 >> 1) + 16 * (q4 & 1) + 8 * hq);
    const float l1 = half_swap_sum(st.l);
    const float inv1 = (l1 > 0.f) ? 1.0f / l1 : 0.f;
    if (c >= 16) {
        if (hq == 0) {
            LAS float* fr = IMF + (r * 64 + tl) * 4;
            fr[0] = (rf0 == NEG_INF) ? 0.f : __builtin_amdgcn_exp2f(rf0 - st.m) * inv1; fr[1] = (rf1 == NEG_INF) ? 0.f : __builtin_amdgcn_exp2f(rf1 - st.m) * inv1;
            fr[2] = (rf2 == NEG_INF) ? 0.f : __builtin_amdgcn_exp2f(rf2 - st.m) * inv1; fr[3] = (rf3 == NEG_INF) ? 0.f : __builtin_amdgcn_exp2f(rf3 - st.m) * inv1;
        }
        __syncthreads();
    }
    const float g0n = g0 * inv1;
    unsigned long long mysel;
    if (c < 16) {
        mysel = (2ull << c) - 1ull;
    } else {
        const int js = lane, tb = c;
        const bool causal = js <= tb, forced = (js == 0) || (js == tb) || (js == tb - 1);
        const bool cand = causal && !forced;
        const unsigned long long mforced = __ballot(causal && forced), mcand = __ballot(cand);
        const int want = 16 - __builtin_popcountll(mforced);
#pragma unroll 1
        for (int k = 0; k < 8; k += 2) {
            const int t = 8 * wave + k;
            const int jt = js >> 4;
            const unsigned va = __float_as_uint((IMP[t * 66 + js] * IMF[t * 4 + jt] + IMP[(64 + t) * 66 + js] * IMF[(64 + t) * 4 + jt]) + (IMP[(128 + t) * 66 + js] * IMF[(128 + t) * 4 + jt] + IMP[(192 + t) * 66 + js] * IMF[(192 + t) * 4 + jt]));
            const unsigned vc = __float_as_uint((IMP[(t + 1) * 66 + js] * IMF[(t + 1) * 4 + jt] + IMP[(65 + t) * 66 + js] * IMF[(65 + t) * 4 + jt]) + (IMP[(129 + t) * 66 + js] * IMF[(129 + t) * 4 + jt] + IMP[(193 + t) * 66 + js] * IMF[(193 + t) * 4 + jt]));
            unsigned Ta = 0u, Tc = 0u; bool da = false, dc = false;
            unsigned long long msa = 0ull, msc = 0ull;
#pragma unroll 1
            for (int bit = 30; bit >= 0; --bit) {
                const unsigned tra = Ta | (1u << bit), trc = Tc | (1u << bit);
                const unsigned long long mga = __ballot(cand && va >= tra), mgc = __ballot(cand && vc >= trc);
                const int ca = __builtin_popcountll(mga), cc = __builtin_popcountll(mgc);
                if (!da) { if (ca == want) { msa = mga; da = true; } else Ta = (ca > want) ? tra : Ta; }
                if (!dc) { if (cc == want) { msc = mgc; dc = true; } else Tc = (cc > want) ? trc : Tc; }
                if (da && dc) break;
            }
            if (!da) {
                const unsigned long long mgt = __ballot(cand && va > Ta), meq = __ballot(cand && va == Ta);
                const int rq = want - __builtin_popcountll(mgt);
                const int below = __builtin_amdgcn_mbcnt_hi((unsigned)(meq >> 32), __builtin_amdgcn_mbcnt_lo((unsigned)meq, 0));
                msa = mgt | __ballot(cand && va == Ta && below < rq);
            }
            if (!dc) {
                const unsigned long long mgt = __ballot(cand && vc > Tc), meq = __ballot(cand && vc == Tc);
                const int rq = want - __builtin_popcountll(mgt);
                const int below = __builtin_amdgcn_mbcnt_hi((unsigned)(meq >> 32), __builtin_amdgcn_mbcnt_lo((unsigned)meq, 0));
                msc = mgt | __ballot(cand && vc == Tc && below < rq);
            }
            if (lane == 0) { SEL[t] = msa | mforced; SEL[t + 1] = msc | mforced; }
        }
        __syncthreads();
        mysel = SEL[tl];
    }
    u32x4 part[4];
#pragma unroll
    for (int dl = 0; dl < 2; ++dl)
#pragma unroll
        for (int sg = 0; sg < 2; ++sg) {
            const f32x16& O = dl ? st.O1 : st.O0;
            const u32x4 wv = owp[dl * 2 + sg];
            u32x4 w;
            w.x = cvt_pk_bf16(O[8 * sg + 0] * g0n + bf16lo(wv.x), O[8 * sg + 1] * g0n + bf16hi(wv.x)); w.y = cvt_pk_bf16(O[8 * sg + 2] * g0n + bf16lo(wv.y), O[8 * sg + 3] * g0n + bf16hi(wv.y));
            w.z = cvt_pk_bf16(O[8 * sg + 4] * g0n + bf16lo(wv.z), O[8 * sg + 5] * g0n + bf16hi(wv.z)); w.w = cvt_pk_bf16(O[8 * sg + 6] * g0n + bf16lo(wv.w), O[8 * sg + 7] * g0n + bf16hi(wv.w));
            part[dl * 2 + sg] = w;
        }
    {
        att_init(st, cbs);
        AT_LOOP_FROM(S1, 0, c, KSp, 4096, 64, VSp, 64, SEQ, {
            const bool mine = (mysel >> j) & 1ull;
            if (__ballot(mine) != 0ull) {
                f32x16 s0, s1;
                at_scores(ktl + AT_KT(buf), qf, s0, s1, st.CI);
                if (j >= c - 2) {
                    const int drel = 64 * (c - j) + tl;
                    at_bias_table(s0, s1, TR + (8 + h) * 256 + (191 - drel + 8 * hq));
                }
                at_softmax_pv<true>(vtl + AT_VT(buf), s0, s1, st, mine);
            } })
        const float lt = half_swap_sum(st.l);
        const float g1l = g1 / lt;
        bf16_t* dst = p.OAB + tok * 1024 + 512 + h * 64;
#pragma unroll
        for (int dl = 0; dl < 2; ++dl)
#pragma unroll
            for (int sg = 0; sg < 2; ++sg) {
                const f32x16& O = dl ? st.O1 : st.O0;
                const u32x4 wv = part[dl * 2 + sg];
                u32x4 w;
                w.x = cvt_pk_bf16(O[8 * sg + 0] * g1l + bf16lo(wv.x), O[8 * sg + 1] * g1l + bf16hi(wv.x)); w.y = cvt_pk_bf16(O[8 * sg + 2] * g1l + bf16lo(wv.y), O[8 * sg + 3] * g1l + bf16hi(wv.y));
                w.z = cvt_pk_bf16(O[8 * sg + 4] * g1l + bf16lo(wv.z), O[8 * sg + 5] * g1l + bf16hi(wv.z)); w.w = cvt_pk_bf16(O[8 * sg + 6] * g1l + bf16lo(wv.w), O[8 * sg + 7] * g1l + bf16hi(wv.w));
                *(u32x4*)(dst + 32 * dl + 16 * sg + 8 * hq) = w;
            }
    }
}
struct EpiGate {
    static constexpr bool PERM = true;
    const float* rs; bf16_t* DST;
    __device__ __forceinline__ void operator()(const AccT& acc, const pg8::Unit& u, int wr, int wc, int fr, int fq) const {
        const int row0 = u.pm * 256 + wr * 64 + fr;
        float rr[2][4];
#pragma unroll
        for (int ai = 0; ai < 2; ++ai)
#pragma unroll
            for (int m = 0; m < 4; ++m) rr[ai][m] = rs[row0 + ai * 128 + m * 16];
#pragma unroll
        for (int ai = 0; ai < 2; ++ai)
#pragma unroll
            for (int m = 0; m < 4; ++m) {
                const float r = rr[ai][m];
                bf16_t* dp = DST + (long)(row0 + ai * 128 + m * 16) * 1024 + u.pn * 256 + wc * 32 + fq * 8;
#pragma unroll
                for (int bj = 0; bj < 2; ++bj) {
                    const f32x4 v0 = acc[ai][bj][m][0], v1 = acc[ai][bj][m][1];
                    u32x4 w; w.x = cvt_pk_bf16(fast_sigmoid(v0[0] * r), fast_sigmoid(v0[1] * r)); w.y = cvt_pk_bf16(fast_sigmoid(v0[2] * r), fast_sigmoid(v0[3] * r));
                    w.z = cvt_pk_bf16(fast_sigmoid(v1[0] * r), fast_sigmoid(v1[1] * r)); w.w = cvt_pk_bf16(fast_sigmoid(v1[2] * r), fast_sigmoid(v1[3] * r));
                    *(u32x4*)(dp + bj * 128) = w;
                    __builtin_amdgcn_sched_barrier(0);
                }
            }
    }
};
struct EpiMerge2 {
    static constexpr bool PERM = true;
    bf16_t* MERGED; const bf16_t* GB;
    static __device__ __forceinline__ float gclamp(float g) { return fmaxf(g, 1e-30f); }
    __device__ __forceinline__ void mid(AccT& acc, const pg8::Unit& u, int wr, int wc, int fr, int fq) const {
        int row0 = u.pm * 256 + wr * 64 + fr;
        asm volatile("" : "+v"(row0));
        const long cbase = (long)u.pn * 256 + wc * 32 + fq * 8;
        u32x4 ac[2], bc[2], an[2], bn[2];
#pragma unroll
        for (int bj = 0; bj < 2; ++bj) {
            ac[bj] = *(const u32x4*)(MERGED + (long)row0 * 1024 + cbase + bj * 128); bc[bj] = *(const u32x4*)(GB + (long)row0 * 1024 + cbase + bj * 128);
            an[bj] = ac[bj]; bn[bj] = bc[bj];
        }
#pragma unroll
        for (int i = 0; i < 8; ++i) {
            const int ai = i >> 2, m = i & 3;
            if (i < 7) {
                const long on = (long)(row0 + ((i + 1) >> 2) * 128 + ((i + 1) & 3) * 16) * 1024 + cbase;
#pragma unroll
                for (int bj = 0; bj < 2; ++bj) { an[bj] = *(const u32x4*)(MERGED + on + bj * 128); bn[bj] = *(const u32x4*)(GB + on + bj * 128); }
            }
#pragma unroll
            for (int bj = 0; bj < 2; ++bj) {
                const u32x4 a = ac[bj], b = bc[bj];
                f32x4& v0 = acc[ai][bj][m][0]; f32x4& v1 = acc[ai][bj][m][1];
                v0[0] *= bf16lo(a.x) * __builtin_amdgcn_rcpf(gclamp(bf16lo(b.x))); v0[1] *= bf16hi(a.x) * __builtin_amdgcn_rcpf(gclamp(bf16hi(b.x)));
                v0[2] *= bf16lo(a.y) * __builtin_amdgcn_rcpf(gclamp(bf16lo(b.y))); v0[3] *= bf16hi(a.y) * __builtin_amdgcn_rcpf(gclamp(bf16hi(b.y)));
                v1[0] *= bf16lo(a.z) * __builtin_amdgcn_rcpf(gclamp(bf16lo(b.z))); v1[1] *= bf16hi(a.z) * __builtin_amdgcn_rcpf(gclamp(bf16hi(b.z)));
                v1[2] *= bf16lo(a.w) * __builtin_amdgcn_rcpf(gclamp(bf16lo(b.w))); v1[3] *= bf16hi(a.w) * __builtin_amdgcn_rcpf(gclamp(bf16hi(b.w)));
            }
#pragma unroll
            for (int bj = 0; bj < 2; ++bj) { ac[bj] = an[bj]; bc[bj] = bn[bj]; }
            __builtin_amdgcn_sched_barrier(0);
        }
    }
    __device__ __forceinline__ void operator()(const AccT& acc, const pg8::Unit& u, int wr, int wc, int fr, int fq) const {
        const int row0 = u.pm * 256 + wr * 64 + fr;
        const long cbase = (long)u.pn * 256 + wc * 32 + fq * 8;
        u32x4 gc[2], gn[2];
#pragma unroll
        for (int bj = 0; bj < 2; ++bj) { gc[bj] = *(const u32x4*)(GB + (long)row0 * 1024 + cbase + bj * 128); gn[bj] = gc[bj]; }
#pragma unroll
        for (int i = 0; i < 8; ++i) {
            const int ai = i >> 2, m = i & 3;
            const long o = (long)(row0 + ai * 128 + m * 16) * 1024 + cbase;
            if (i < 7) {
                const long on = (long)(row0 + ((i + 1) >> 2) * 128 + ((i + 1) & 3) * 16) * 1024 + cbase;
#pragma unroll
                for (int bj = 0; bj < 2; ++bj) gn[bj] = *(const u32x4*)(GB + on + bj * 128);
            }
#pragma unroll
            for (int bj = 0; bj < 2; ++bj) {
                const f32x4 v0 = acc[ai][bj][m][0], v1 = acc[ai][bj][m][1];
                const u32x4 gg = gc[bj];
                u32x4 w;
                w.x = cvt_pk_bf16(gclamp(bf16lo(gg.x)) * v0[0], gclamp(bf16hi(gg.x)) * v0[1]); w.y = cvt_pk_bf16(gclamp(bf16lo(gg.y)) * v0[2], gclamp(bf16hi(gg.y)) * v0[3]);
                w.z = cvt_pk_bf16(gclamp(bf16lo(gg.z)) * v1[0], gclamp(bf16hi(gg.z)) * v1[1]); w.w = cvt_pk_bf16(gclamp(bf16lo(gg.w)) * v1[2], gclamp(bf16hi(gg.w)) * v1[3]);
                *(u32x4*)(MERGED + o + bj * 128) = w;
            }
#pragma unroll
            for (int bj = 0; bj < 2; ++bj) gc[bj] = gn[bj];
            __builtin_amdgcn_sched_barrier(0);
        }
    }
};
struct EpiOut {
    static constexpr bool PERM = true;
    bf16_t* HB; float* ssq16;
    __device__ __forceinline__ void operator()(const AccT& acc, const pg8::Unit& u, int wr, int wc, int fr, int fq) const {
        const int row0 = u.pm * 256 + wr * 64 + fr;
        const long cbase = (long)u.pn * 256 + wc * 32 + fq * 8;
        u32x4 cur[2], nxt[2];
#pragma unroll
        for (int bj = 0; bj < 2; ++bj) cur[bj] = *(const u32x4*)(HB + (long)row0 * 1024 + cbase + bj * 128);
#pragma unroll
        for (int i = 0; i < 8; ++i) {
            const int ai = i >> 2, m = i & 3;
            const int row = row0 + ai * 128 + m * 16;
            if (i < 7) {
                const int rown = row0 + ((i + 1) >> 2) * 128 + ((i + 1) & 3) * 16;
#pragma unroll
                for (int bj = 0; bj < 2; ++bj) nxt[bj] = *(const u32x4*)(HB + (long)rown * 1024 + cbase + bj * 128);
            }
            float ss = 0.f;
#pragma unroll
            for (int bj = 0; bj < 2; ++bj) {
                const long oo = (long)row * 1024 + cbase + bj * 128;
                const u32x4 c = cur[bj];
                const f32x4 h0 = {bf16lo(c.x), bf16hi(c.x), bf16lo(c.y), bf16hi(c.y)}, h1 = {bf16lo(c.z), bf16hi(c.z), bf16lo(c.w), bf16hi(c.w)};
                const f32x4 v0 = h0 + acc[ai][bj][m][0], v1 = h1 + acc[ai][bj][m][1];
                u32x4 w; w.x = cvt_pk_bf16(v0[0], v0[1]); w.y = cvt_pk_bf16(v0[2], v0[3]); w.z = cvt_pk_bf16(v1[0], v1[1]); w.w = cvt_pk_bf16(v1[2], v1[3]);
                *(u32x4*)(HB + oo) = w;
                ss += ((v0[0] * v0[0] + v0[1] * v0[1]) + (v0[2] * v0[2] + v0[3] * v0[3])) + ((v1[0] * v1[0] + v1[1] * v1[1]) + (v1[2] * v1[2] + v1[3] * v1[3]));
            }
            ss += swz_xor<16>(ss); ss = half_swap_sum(ss);
            if (fq == 0) ssq16[(long)row * 16 + u.pn * 4 + wc] = ss;
#pragma unroll
            for (int bj = 0; bj < 2; ++bj) cur[bj] = nxt[bj];
            __builtin_amdgcn_sched_barrier(0);
        }
    }
};

__device__ __forceinline__ void gates24_phase(const Params& p, int l, LAS unsigned char* lds) {
    constexpr int WROW = 136;
    LAS bf16_t* WB = (LAS bf16_t*)lds;
    int tid = threadIdx.x; asm volatile("" : "+v"(tid));
    const int wave = tid >> 6, lane = tid & 63, fr = lane & 15, kq = lane >> 4;
    const bf16_t* W = p.WinT + ((long)l * 4352 + 2048) * 1024;
    for (int tile = blockIdx.x; tile < T_TOK / 128; tile += gridDim.x) {
        const long t0 = (long)tile * 128;
        const bf16_t* xrow = p.HB + (t0 + wave * 16 + fr) * DM + kq * 8;
        f32x4 acc[2];
#pragma unroll
        for (int ct = 0; ct < 2; ++ct) acc[ct] = (f32x4){0.f, 0.f, 0.f, 0.f};
        for (int kc = 0; kc < 1024; kc += 128) {
            bf16x8 xv[4];
#pragma unroll
            for (int ks = 0; ks < 4; ++ks) xv[ks] = *(const bf16x8*)(xrow + kc + ks * 32);
            __syncthreads();
            { const int row = tid >> 4, piece = tid & 15;
              const u32x4 v = *(const u32x4*)(W + (long)row * 1024 + kc + piece * 8);
              *(LAS u32x4*)(WB + row * WROW + piece * 8) = v; }
            __syncthreads();
#pragma unroll
            for (int ks = 0; ks < 4; ++ks)
#pragma unroll
                for (int ct = 0; ct < 2; ++ct) {
                    const bf16x8 bw = *(LAS const bf16x8*)(WB + (ct * 16 + fr) * WROW + ks * 32 + kq * 8);
                    acc[ct] = __builtin_amdgcn_mfma_f32_16x16x32_bf16(xv[ks], bw, acc[ct], 0, 0, 0);
                }
        }
#pragma unroll
        for (int j = 0; j < 4; ++j) {
            const long t = t0 + wave * 16 + 4 * kq + j;
            const float r = p.rsA[t];
            p.G24[t * 32 + fr] = fast_sigmoid(acc[0][j] * r);
            if (fr < 8) p.G24[t * 32 + 16 + fr] = fast_sigmoid(acc[1][j] * r);
        }
    }
    __syncthreads();
}
typedef __bf16 bf16x8n __attribute__((ext_vector_type(8)));
__device__ __forceinline__ void router_phase(const Params& p, int l, LAS unsigned char* lds) {
    constexpr int WROW = 136;
    LAS bf16_t* WB = (LAS bf16_t*)lds;
    LAS float* LG = (LAS float*)(lds + 2 * 48 * WROW * 2);
    LAS int* HIST = (LAS int*)(lds + 2 * 48 * WROW * 2 + 128 * 37 * 4);
    int tid = threadIdx.x; asm volatile("" : "+v"(tid));
    const int wave = tid >> 6, lane = tid & 63, fr = lane & 15, kq = lane >> 4;
    const bf16_t* WH = p.WRH + (long)l * 48 * 1024; const bf16_t* WL = p.WRL + (long)l * 48 * 1024;
    if (blockIdx.x == 0 && tid == 0) p.rsB[T_TOK] = 1.0f;
    for (int tile = blockIdx.x; tile < T_TOK / 128; tile += gridDim.x) {
        const long t0 = (long)tile * 128;
        const bf16_t* xrow = p.HB + (t0 + wave * 16 + fr) * DM + kq * 8;
        f32x4 acc[3];
#pragma unroll
        for (int ct = 0; ct < 3; ++ct) acc[ct] = (f32x4){0.f, 0.f, 0.f, 0.f};
        if (tid < 32) HIST[tid] = 0;
        for (int kc = 0; kc < 1024; kc += 128) {
            bf16x8 xv[4];
#pragma unroll
            for (int ks = 0; ks < 4; ++ks) xv[ks] = *(const bf16x8*)(xrow + kc + ks * 32);
            __syncthreads();
#pragma unroll
            for (int i = 0; i < 3; ++i) {
                const int idx = tid + 512 * i, part = idx / 768, rem = idx % 768, row = rem >> 4, piece = rem & 15;
                const u32x4 v = *(const u32x4*)((part ? WL : WH) + (long)row * 1024 + kc + piece * 8);
                *(LAS u32x4*)(WB + (part * 48 + row) * WROW + piece * 8) = v;
            }
            __syncthreads();
#pragma unroll
            for (int ks = 0; ks < 4; ++ks) {
#pragma unroll
                for (int ct = 0; ct < 3; ++ct) {
                    const bf16x8 bh = *(LAS const bf16x8*)(WB + (ct * 16 + fr) * WROW + ks * 32 + kq * 8);
                    const bf16x8 bl = *(LAS const bf16x8*)(WB + (48 + ct * 16 + fr) * WROW + ks * 32 + kq * 8);
                    acc[ct] = __builtin_amdgcn_mfma_f32_16x16x32_bf16(xv[ks], bh, acc[ct], 0, 0, 0);
                    acc[ct] = __builtin_amdgcn_mfma_f32_16x16x32_bf16(xv[ks], bl, acc[ct], 0, 0, 0);
                }
            }
        }
#pragma unroll
        for (int ct = 0; ct < 3; ++ct) {
            const int n = ct * 16 + fr;
            if (n < 36) {
#pragma unroll
                for (int j = 0; j < 4; ++j) LG[(wave * 16 + 4 * kq + j) * 37 + n] = acc[ct][j];
            }
        }
        __syncthreads();
        if (tid < 128) {
            const long t = t0 + tid;
            float ss = 0.f;
#pragma unroll
            for (int i = 0; i < 4; ++i) { const float4 q = *(const float4*)(p.ssq16 + t * 16 + i * 4); ss += (q.x + q.y) + (q.z + q.w); }
            const float r = rsqrtf(ss * (1.0f / DM) + 1e-5f);
            p.rsB[t] = r;
            float gl[4]; int gs = 0; float gmax;
#pragma unroll
            for (int j = 0; j < 4; ++j) gl[j] = LG[tid * 37 + j] * r + p.b_group[l * 4 + j];
            gmax = gl[0];
#pragma unroll
            for (int j = 1; j < 4; ++j) if (gl[j] > gmax) { gmax = gl[j]; gs = j; }
            float den = 0.f;
#pragma unroll
            for (int j = 0; j < 4; ++j) den += __expf(gl[j] - gmax);
            const float gw = 1.0f / den;
            float el[8];
#pragma unroll
            for (int j = 0; j < 8; ++j) el[j] = LG[tid * 37 + 4 + gs * 8 + j] * r + p.b_expert[l * 32 + gs * 8 + j];
            int i0 = 0; float v0 = el[0];
#pragma unroll
            for (int j = 1; j < 8; ++j) if (el[j] > v0) { v0 = el[j]; i0 = j; }
            int i1 = -1; float v1 = NEG_INF;
#pragma unroll
            for (int j = 0; j < 8; ++j) if (j != i0 && (i1 < 0 || el[j] > v1)) { v1 = el[j]; i1 = j; }
            const float ex = __expf(v1 - v0);
            const float w0 = 1.0f / (1.0f + ex), w1 = ex / (1.0f + ex);
            const int e0 = gs * 8 + i0, e1 = gs * 8 + i1;
            p.eid[t * 2] = e0; p.eid[t * 2 + 1] = e1;
            p.ew[t * 2] = w0 * gw; p.ew[t * 2 + 1] = w1 * gw;
            __hip_atomic_fetch_add(HIST + e0, 1, __ATOMIC_RELAXED, __HIP_MEMORY_SCOPE_WORKGROUP);
            __hip_atomic_fetch_add(HIST + e1, 1, __ATOMIC_RELAXED, __HIP_MEMORY_SCOPE_WORKGROUP);
        }
        __syncthreads();
        if (tid < 32) p.cnt_tile[tile * 32 + tid] = HIST[tid];
        __syncthreads();
    }
}
__device__ __forceinline__ void scatter_phase(const Params& p, LAS unsigned char* lds) {
    LAS int* PST = (LAS int*)lds;
    LAS int* CNT = PST + 64;
    LAS int* PRE = PST + 128;
    LAS int* LCN = PST + 192;
    int tid = threadIdx.x; asm volatile("" : "+v"(tid));
    for (int tile = blockIdx.x; tile < T_TOK / 128; tile += gridDim.x) {
        __syncthreads();
        {
            LAS int* RT = PST + 256;
            LAS int* RP = RT + 512;
            const int e = tid & 31, grp = tid >> 5;
            int tot = 0, pre = 0;
#pragma unroll 4
            for (int i = grp; i < T_TOK / 128; i += 16) { const int c = p.cnt_tile[i * 32 + e]; tot += c; pre += (i < tile) ? c : 0; }
            RT[grp * 32 + e] = tot; RP[grp * 32 + e] = pre;
        }
        __syncthreads();
        if (tid < 32) {
            int tot = 0, pre = 0;
#pragma unroll
            for (int gq = 0; gq < 16; ++gq) { tot += PST[256 + gq * 32 + tid]; pre += PST[256 + 512 + gq * 32 + tid]; }
            CNT[tid] = tot; PRE[tid] = pre; LCN[tid] = 0;
        }
        __syncthreads();
        if (tid == 0) { int acc = 0; for (int e = 0; e < 32; ++e) { PST[e] = acc; acc += (CNT[e] + 255) / 256 * 256; } PST[32] = acc; }
        __syncthreads();
        if (tile == 0 && tid == 0) p.ntiles[0] = PST[32] / 256;
        if (tile == 0 && tid < 32) { p.counts[tid] = PST[tid] / 256; p.counts[32 + tid] = (PST[tid + 1] - PST[tid]) / 256; }
        if (tile < 32) {
            const int e = tile, s0 = PST[e], s1 = PST[e + 1], c = CNT[e];
            for (int tI = s0 / 256 + tid; tI < s1 / 256; tI += NTHR) p.tile_e[tI] = e;
            for (int s = s0 + c + tid; s < s1; s += NTHR) { p.toks[s] = T_TOK; p.slotw[s] = 0.f; p.slotdst[s] = -1; }
        }
        if (tid < 256) {
            const int a = tile * 256 + tid;
            const int e = p.eid[a];
            const int lp = __hip_atomic_fetch_add(LCN + e, 1, __ATOMIC_RELAXED, __HIP_MEMORY_SCOPE_WORKGROUP);
            const int s = PST[e] + PRE[e] + lp;
            p.toks[s] = a >> 1; p.slotw[s] = p.ew[a]; p.slotdst[s] = a;
        }
    }
}
template <int WHICH>
__device__ __forceinline__ void moe_stage_units(const Params& p, LAS unsigned char* lds) {
    LAS int* ul = (LAS int*)(lds + LDS_META_OFF);
    LAS int* ia = ul + 64; LAS float* fa = (LAS float*)(ia + 6 * 256);
    int tid = threadIdx.x; asm volatile("" : "+v"(tid));
    const int nt = p.ntiles[0];
    const int W = (int)gridDim.x >> 3, x = (int)blockIdx.x & 7, r = (int)blockIdx.x >> 3;
    int mx = 0;
#pragma unroll
    for (int q = 0; q < 8; ++q) { const int s = p.counts[32 + q] + p.counts[40 + q] + p.counts[48 + q] + p.counts[56 + q]; mx = s > mx ? s : mx; }
    const int rounds_plain = (nt * 4 + (int)gridDim.x - 1) / (int)gridDim.x;
    const bool local = ((int)gridDim.x & 7) == 0 && W > 0 && (mx * 4 + W - 1) / W <= (rounds_plain < 6 ? rounds_plain : 6);
    if (local) {
        const int n0 = p.counts[32 + x], n1 = p.counts[40 + x], n2 = p.counts[48 + x], n3 = p.counts[56 + x], tot = 4 * (n0 + n1 + n2 + n3);
        if (tid < 6) {
            const int j = tid * W + r, jt = j >> 2;
            const bool ok = j < tot;
            int pm = 0;
            if (ok) {
                if (jt < n0) pm = p.counts[x] + jt;
                else if (jt < n0 + n1) pm = p.counts[8 + x] + (jt - n0);
                else if (jt < n0 + n1 + n2) pm = p.counts[16 + x] + (jt - n0 - n1);
                else pm = p.counts[24 + x] + (jt - n0 - n1 - n2);
            }
            ul[2 + 2 * tid] = pm; ul[3 + 2 * tid] = ok ? p.tile_e[pm] * 4 + (j & 3) : 0;
        }
        if (tid == 0) { const int n = tot > r ? (tot - r + W - 1) / W : 0; ul[0] = n > 6 ? 6 : n; }
    } else {
        if (tid < 6) {
            const long L = (long)tid * gridDim.x + blockIdx.x;
            const bool ok = L < (long)nt * 4;
            const int pm = ok ? (int)(L >> 2) : 0;
            ul[2 + 2 * tid] = pm; ul[3 + 2 * tid] = ok ? p.tile_e[pm] * 4 + (int)(L & 3) : 0;
        }
        if (tid == 0) { const long rem = (long)nt * 4 - blockIdx.x; int n = rem > 0 ? (int)((rem + gridDim.x - 1) / gridDim.x) : 0; ul[0] = n > 6 ? 6 : n; }
    }
    __syncthreads();
    const int nu = ul[0];
    for (int e = tid; e < nu * 256; e += NTHR) {
        const int li = e >> 8, r = e & 255, row = ul[2 + 2 * li] * 256 + r;
        if (WHICH == 0) { const int tk = p.toks[row]; ia[e] = tk; fa[e] = p.rsB[tk]; }
        else { ia[e] = p.slotdst[row]; fa[e] = p.slotw[row]; }
    }
    __syncthreads();
}
struct EpiMoe1 {
    static constexpr bool PERM = true;
    const LAS float* rsl; bf16_t* HMID;
    __device__ __forceinline__ void operator()(const AccT& acc, const pg8::Unit& u, int wr, int wc, int fr, int fq) const {
        const int row0 = u.pm * 256 + wr * 64 + fr;
        const int q = u.pn & 3;
        float rr[2][4];
#pragma unroll
        for (int ai = 0; ai < 2; ++ai)
#pragma unroll
            for (int m = 0; m < 4; ++m) rr[ai][m] = rsl[u.li * 256 + wr * 64 + fr + ai * 128 + m * 16];
#pragma unroll
        for (int ai = 0; ai < 2; ++ai)
#pragma unroll
            for (int m = 0; m < 4; ++m) {
                const float r = rr[ai][m];
                float y[8];
#pragma unroll
                for (int j = 0; j < 4; ++j) {
                    const float a0 = acc[ai][0][m][0][j] * r, b0 = acc[ai][1][m][0][j] * r, a1 = acc[ai][0][m][1][j] * r, b1 = acc[ai][1][m][1][j] * r;
                    y[j] = a0 * fast_sigmoid(a0) * b0; y[4 + j] = a1 * fast_sigmoid(a1) * b1;
                }
                u32x4 w; w.x = cvt_pk_bf16(y[0], y[1]); w.y = cvt_pk_bf16(y[2], y[3]); w.z = cvt_pk_bf16(y[4], y[5]); w.w = cvt_pk_bf16(y[6], y[7]);
                *(u32x4*)(HMID + (long)(row0 + ai * 128 + m * 16) * 512 + q * 128 + wc * 32 + fq * 8) = w;
                __builtin_amdgcn_sched_barrier(0);
            }
    }
};
struct EpiMoe2 {
    static constexpr bool PERM = true;
    const LAS int* dstl; const LAS float* wl; bf16_t* YS;
    __device__ __forceinline__ void operator()(const AccT& acc, const pg8::Unit& u, int wr, int wc, int fr, int fq) const {
        const int row0 = u.pm * 256 + wr * 64 + fr;
        const int q = u.pn & 3;
        int dd[2][4]; float ww[2][4];
#pragma unroll
        for (int ai = 0; ai < 2; ++ai)
#pragma unroll
            for (int m = 0; m < 4; ++m) { const int lr = u.li * 256 + wr * 64 + fr + ai * 128 + m * 16; dd[ai][m] = dstl[lr]; ww[ai][m] = wl[lr]; }
#pragma unroll
        for (int ai = 0; ai < 2; ++ai)
#pragma unroll
            for (int m = 0; m < 4; ++m) {
                if (dd[ai][m] >= 0) {
                    const float wv = ww[ai][m];
                    bf16_t* dp = YS + (long)dd[ai][m] * 1024 + q * 256 + wc * 32 + fq * 8;
#pragma unroll
                    for (int bj = 0; bj < 2; ++bj) {
                        const f32x4 v0 = acc[ai][bj][m][0], v1 = acc[ai][bj][m][1];
                        u32x4 w; w.x = cvt_pk_bf16(v0[0] * wv, v0[1] * wv); w.y = cvt_pk_bf16(v0[2] * wv, v0[3] * wv); w.z = cvt_pk_bf16(v1[0] * wv, v1[1] * wv); w.w = cvt_pk_bf16(v1[2] * wv, v1[3] * wv);
                        *(u32x4*)(dp + bj * 128) = w;
                    }
                }
                __builtin_amdgcn_sched_barrier(0);
            }
    }
};

#define FAST_PHASES_2_TO_10 \
        if (IN(2)) { \
            if ((int)blockIdx.x < 32) { \
                pg8::Gemm g{p.KVC, p.CW1T + (size_t)l * 512 * 2048, 2048, 1024, 2048, nullptr}; \
                pg8::CmpOrder S{(int)blockIdx.x}; \
                EpiCmp1 E{p.CB1 + l * 512, p.CHID}; \
                pg8::gemm_phase<EpiCmp1, pg8::CmpOrder, false>(lds, g, S, E); \
                cmp_gemm2(p, l, blockIdx.x); \
                if (l == 0) cvt_fill<0>(p, lds, NCH0, FILL_P2C); \
                  \
                  \
                if (gridDim.x == 256) { \
                    __syncthreads(); \
                    if (__builtin_amdgcn_readfirstlane((int)threadIdx.x) >= 256) __builtin_amdgcn_s_setprio(1); \
                    { const int u = 896 + (int)blockIdx.x; attn_aw_unit(p, l, (u & 15) >> 1, u & 1, 63 - (u >> 4), lds, 3); } \
                    __builtin_amdgcn_s_setprio(0); \
                } \
            } else { \
                const int nw = (int)gridDim.x - 32, w_ = (int)blockIdx.x - 32; \
                const bool g256 = gridDim.x == 256; \
                if (__builtin_amdgcn_readfirstlane((int)threadIdx.x) >= 256) __builtin_amdgcn_s_setprio(1);     \
                for (int i = 0; ; ++i) { \
                    int u, parts = 3; \
                    if (g256) { \
                        if (i < 4) u = w_ + 224 * i; \
                        else if (i == 4 && w_ < 192) { const int x_ = w_ & 63, k_ = w_ >> 6;             \
                            u = (k_ == 2 ? 928 : 960) + (x_ & 31) + ((k_ == 2) ? 0 : (x_ & 32)); parts = 1 + ((k_ == 2) ? (x_ >> 5) : k_); }     \
                        else break; \
                    } else { u = w_ + nw * i; if (u >= 1024) break; }        \
                    attn_aw_unit(p, l, (u & 15) >> 1, u & 1, 63 - (u >> 4), lds, parts); \
                } \
                __builtin_amdgcn_s_setprio(0); \
            } \
            GRID_BAR(); \
        } \
        if (IN(3)) { \
            if (__builtin_amdgcn_readfirstlane((int)threadIdx.x) >= 256) __builtin_amdgcn_s_setprio(1); \
            for (int k = blockIdx.x; k < 1024; k += gridDim.x) { \
                const int bgk = k & 15, cg = (k >> 4) & 15, i4 = k >> 8; \
                const int c = (i4 == 0) ? 63 - cg : (i4 == 1) ? 32 + cg : (i4 == 2) ? 31 - cg : cg; \
                attn_cs_unit(p, bgk >> 1, bgk & 1, c, lds); \
            } \
            __builtin_amdgcn_s_setprio(0); \
            GRID_BAR(); \
        } \
        if (IN(4)) { \
            pg8::StaticOrder S; S.init(T_TOK, 1024, gridDim.x, blockIdx.x); \
            { pg8::Gemm g{p.HB, p.WinT + ((size_t)l * 4352 + 2072) * 1024, 1024, 1024, 1024, nullptr}; EpiGate E{p.rsA, p.MERGED}; \
              pg8::gemm_phase<EpiGate, pg8::StaticOrder, false>(lds, g, S, E); } \
            { pg8::Gemm g{p.HB, p.WinT + ((size_t)l * 4352 + 3096) * 1024, 1024, 1024, 1024, nullptr}; EpiGate E{p.rsA, p.TMP2}; \
              pg8::gemm_phase<EpiGate, pg8::StaticOrder, false>(lds, g, S, E); } \
            { pg8::Gemm g{p.OAB, p.WabT + (size_t)l * 1024 * 1024, 1024, 1024, 1024, nullptr}; EpiMerge2 E{p.MERGED, p.TMP2}; \
              pg8::gemm_phase<EpiMerge2, pg8::StaticOrder, false, true>(lds, g, S, E); } \
            GRID_BAR(); \
        } \
        if (IN(5)) { \
            pg8::StaticOrder S; S.init(T_TOK, 1024, gridDim.x, blockIdx.x); \
            pg8::Gemm g{p.MERGED, p.WoutT + (size_t)l * 1024 * 1024, 1024, 1024, 1024, nullptr}; \
            EpiOut E{p.HB, p.ssq16}; \
            pg8::gemm_phase<EpiOut, pg8::StaticOrder, false>(lds, g, S, E); \
            GRID_BAR(); \
        } \
        if (IN(6)) { router_phase(p, l, lds); GRID_BAR(); } \
        if (IN(7)) { if (l == 0) cvt_fill<0>(p, lds, NCH0, 100000); scatter_phase(p, lds); GRID_BAR(); } \
        if (IN(8)) { \
            moe_stage_units<0>(p, lds); \
            LAS int* ul_ = (LAS int*)(lds + LDS_META_OFF); \
            pg8::MoeOrder S{ul_}; \
            pg8::Gemm g{p.HB, l ? p.W13T1 : p.W13T, 1024, 1024, 1024, ul_ + 64}; \
            EpiMoe1 E{(LAS float*)(ul_ + 64 + 6 * 256), p.HMID}; \
            pg8::gemm_phase<EpiMoe1, pg8::MoeOrder, true>(lds, g, S, E); \
            if (l == 0 && ul_[0] < (p.ntiles[0] * 4 + (int)gridDim.x - 1) / (int)gridDim.x) cvt_fill<1>(p, lds, 0, FILL_P8); \
            GRID_BAR(); \
        } \
        if (IN(9)) { \
            moe_stage_units<1>(p, lds); \
            LAS int* ul_ = (LAS int*)(lds + LDS_META_OFF); \
            pg8::MoeOrder S{ul_}; \
            pg8::Gemm g{p.HMID, l ? p.W2T1 : p.W2T, 512, 512, 512, nullptr}; \
            EpiMoe2 E{ul_ + 64, (LAS float*)(ul_ + 64 + 6 * 256), p.YS}; \
            pg8::gemm_phase<EpiMoe2, pg8::MoeOrder, false>(lds, g, S, E); \
            if (l == 0 && ul_[0] < (p.ntiles[0] * 4 + (int)gridDim.x - 1) / (int)gridDim.x) cvt_fill<1>(p, lds, 0, FILL_P9); \
            GRID_BAR(); \
        } \
        if (IN(10)) { \
            if (l == 1) fin_phase<true, true>(p, nullptr, p.norm_final); \
            else { fin_phase<true, false>(p, nullptr, nullptr); cvt_fill<1>(p, lds, 0, 100000); } \
            GRID_BAR(); \
        }
__global__ void __launch_bounds__(NTHR, 2) mega(Params p) {
    extern __shared__ __attribute__((aligned(16))) unsigned char lds_raw[];
    LAS unsigned char* lds = (LAS unsigned char*)lds_raw;
    volatile LAS unsigned* misc = (volatile LAS unsigned*)(lds + LDS_MISC_OFF);
    if (threadIdx.x < 64) misc[threadIdx.x] = 0u;
    build_tables(p, lds);
    const bool multi = (p.ph_hi - p.ph_lo > 1) || (p.l_hi - p.l_lo > 1);
    XcdBarrier bar; bar.bar = p.bar; bar.x = 0; bar.st = misc;
    if (multi) bar = xcd_barrier_post(p.bar, misc);
#define GRID_BAR() do { if (multi) xcd_barrier(bar); } while (0)
#define IN(k) (p.ph_lo <= (k) && (k) < p.ph_hi)

    if (IN(0) && p.l_lo == 0) {
        cvt_phase<0, 8>(p, lds);
        cvt_static<0>(p, lds, NCH0);
        prep_small(p);
        fin_phase<false, false>(p, p.x, nullptr);
        GRID_BAR();
    }
    for (int l = p.l_lo; l < p.l_hi; ++l) {
        if (IN(1)) {
            if (l == 0) cb1_reduce(p);
            pg8::Gemm g{p.HB, p.WinT + (size_t)l * 4352 * 1024, 1024, 1024, 1024, nullptr};
            pg8::StaticOrder S; S.init(T_TOK, 2048, gridDim.x, blockIdx.x);
            EpiProj E{p.rsA, p.QA, p.KA, p.G24};
            pg8::gemm_phase<EpiProj, pg8::StaticOrder, false>(lds, g, S, E);
            gates24_phase(p, l, lds);
            GRID_BAR();
        }
        FAST_PHASES_2_TO_10
    }
#undef IN
#undef GRID_BAR
}

struct HostState { int grid; bool ok; };
static void setup_params(Params& p, void* const* d_in, void* d_out, void* d_ws, size_t ws_size, size_t& used) {
    p.x = (const float*)d_in[0]; p.rel_bias = (const float*)d_in[1]; p.norm_mix = (const float*)d_in[2]; p.w_in = (const float*)d_in[3];
    p.a_sinks = (const float*)d_in[4]; p.cmp_pos_k = (const float*)d_in[5]; p.cmp_w1_k = (const float*)d_in[6]; p.cmp_w2_k = (const float*)d_in[7];
    p.cmp_pos_v = (const float*)d_in[8]; p.cmp_w1_v = (const float*)d_in[9]; p.cmp_w2_v = (const float*)d_in[10];
    p.w_br_a = (const float*)d_in[11]; p.w_br_b = (const float*)d_in[12]; p.w_out = (const float*)d_in[13]; p.norm_ffn = (const float*)d_in[14];
    p.w_group = (const float*)d_in[15]; p.b_group = (const float*)d_in[16]; p.w_expert = (const float*)d_in[17]; p.b_expert = (const float*)d_in[18];
    p.w1 = (const float*)d_in[19]; p.w3 = (const float*)d_in[20]; p.w2 = (const float*)d_in[21]; p.norm_final = (const float*)d_in[22];
    p.out = (float*)d_out;
    char* ws = (char*)d_ws; size_t off = 0;
    auto alloc = [&](size_t bytes) { void* q = ws + off; off += (bytes + 4095) & ~(size_t)4095; return q; };
    p.bar = (unsigned*)alloc(XCD_BAR_WORDS * 4);
    p.counts = (int*)alloc(256); p.cursor = (int*)alloc(256); p.ntiles = (int*)alloc(256); p.tile_e = (int*)alloc(NTILE_MAX * 4 + 256); p.cnt_tile = (int*)alloc((size_t)(T_TOK / 128) * 32 * 4);
    p.rsA = (float*)alloc(T_TOK * 4); p.rsB = (float*)alloc(T_TOK * 4); p.ssq16 = (float*)alloc((size_t)T_TOK * 16 * 4);
    p.HB = (bf16_t*)alloc((size_t)(T_TOK + 256) * DM * 2);
    p.WinT = (bf16_t*)alloc((size_t)2 * 4352 * 1024 * 2);
    p.WabT = (bf16_t*)alloc((size_t)2 * 1024 * 1024 * 2); p.WoutT = (bf16_t*)alloc((size_t)2 * 1024 * 1024 * 2);
    p.CW1T = (bf16_t*)alloc((size_t)2 * 512 * 2048 * 2); p.CW2T = (bf16_t*)alloc((size_t)2 * 2 * 64 * 256 * 2); p.CB1 = (float*)alloc(1024 * 4); p.CBP = (float*)alloc((size_t)512 * 256 * 4);
    p.W13T = (bf16_t*)alloc((size_t)32 * 1024 * 1024 * 2); p.W2T = (bf16_t*)alloc((size_t)32 * 1024 * 512 * 2);
    p.W13T1 = (bf16_t*)d_out; p.W2T1 = p.W13T1 + (size_t)32 * 1024 * 1024;
    p.cvtcur = (int*)(p.bar + 3584);
    p.WRH = (bf16_t*)alloc((size_t)2 * 48 * 1024 * 2); p.WRL = (bf16_t*)alloc((size_t)2 * 48 * 1024 * 2);
    p.eid = (int*)alloc((size_t)T_TOK * 2 * 4); p.ew = (float*)alloc((size_t)T_TOK * 2 * 4);
    p.toks = (int*)alloc((size_t)PMAXF * 4); p.slotw = (float*)alloc((size_t)PMAXF * 4); p.slotdst = (int*)alloc((size_t)PMAXF * 4);
    const size_t region0 = off;
    p.QA = (bf16_t*)alloc((size_t)T_TOK * 512 * 2); p.QB = (bf16_t*)alloc((size_t)T_TOK * 512 * 2);
    {
        const size_t slot = (size_t)16 * SEQ * 64;
        p.KA = (bf16_t*)alloc(8 * slot * 2); p.KVC = p.KA + slot; p.KS = p.KA + 3 * slot; p.KW = p.KA + 4 * slot; p.VAT = p.KA + 5 * slot; p.VST = p.KA + 6 * slot; p.VWT = p.KA + 7 * slot;
    }
    p.G24 = (float*)alloc((size_t)T_TOK * 32 * 4);
    p.CHID = (bf16_t*)alloc((size_t)8192 * 256 * 2); p.KCMP = (bf16_t*)alloc((size_t)16 * 256 * 64 * 2); p.VCMPT = (bf16_t*)alloc((size_t)16 * 64 * 256 * 2);
    p.OAB = (bf16_t*)alloc((size_t)T_TOK * 1024 * 2); p.OW = (bf16_t*)alloc((size_t)T_TOK * 512 * 2);
    p.MERGED = (bf16_t*)alloc((size_t)T_TOK * 1024 * 2);
    const size_t region1 = off;
    p.TMP2 = p.QA;
    p.HMID = (bf16_t*)(ws + region0);
    size_t moe_end = region0 + (((size_t)PMAXF * 512 * 2 + 4095) & ~(size_t)4095);
    p.YS = (bf16_t*)(ws + moe_end); moe_end += (size_t)T_TOK * 2 * 1024 * 2;
    used = (moe_end > region1) ? moe_end : region1;
    (void)ws_size;
    auto task = [&](int i, const float* src, bf16_t* dst, const float* scale, int scstride, int ld, int K, int N, int mapmode, int nb, long ss, long ds, int dld = 0) {
        CvtTask& t = p.cvt[i]; t.dld = dld ? dld : K; t.src = src; t.dst = dst; t.scale = scale; t.scstride = scstride; t.ld = ld; t.K = K; t.N = N; t.mapmode = mapmode; t.nb = nb; t.sstride = ss; t.dstride = ds; };
    task(0, p.w_in, p.WinT, p.norm_mix, 1024, INC, 1024, INC, 0, 2, (long)1024 * INC, (long)4352 * 1024);
    task(1, p.w_br_a, p.WabT, nullptr, 0, 1024, 512, 1024, 0, 2, (long)512 * 1024, (long)1024 * 1024, 1024);
    task(2, p.w_br_b, p.WabT + 512, nullptr, 0, 1024, 512, 1024, 0, 2, (long)512 * 1024, (long)1024 * 1024, 1024);
    task(3, p.w_out, p.WoutT, nullptr, 0, 1024, 1024, 1024, 0, 2, (long)1024 * 1024, (long)1024 * 1024);
    task(4, p.cmp_w1_k, p.CW1T, nullptr, 0, 256, 2048, 256, 0, 2, (long)2048 * 256, (long)512 * 2048);
    task(5, p.cmp_w1_v, p.CW1T + (size_t)256 * 2048, nullptr, 0, 256, 2048, 256, 0, 2, (long)2048 * 256, (long)512 * 2048);
    task(6, p.cmp_w2_k, p.CW2T, nullptr, 0, 64, 256, 64, 0, 2, (long)256 * 64, (long)2 * 64 * 256);
    task(7, p.cmp_w2_v, p.CW2T + (size_t)64 * 256, nullptr, 0, 64, 256, 64, 0, 2, (long)256 * 64, (long)2 * 64 * 256);
}
static HostState& host_state() {
    static HostState hs{0, false};
    if (hs.grid == 0) {
        int dev = 0, cus = 0, per_cu = 0;
        hs.grid = -1;
        if (hipGetDevice(&dev) != hipSuccess) return hs;
        if (hipDeviceGetAttribute(&cus, hipDeviceAttributeMultiprocessorCount, dev) != hipSuccess) return hs;
        if (hipFuncSetAttribute((const void*)mega, hipFuncAttributeMaxDynamicSharedMemorySize, LDS_TOTAL) != hipSuccess) return hs;
        if (hipOccupancyMaxActiveBlocksPerMultiprocessor(&per_cu, (const void*)mega, NTHR, LDS_TOTAL) != hipSuccess || per_cu < 1) { (void)hipGetLastError(); return hs; }
        hs.grid = cus;
        hs.ok = true;
    }
    return hs;
}
static void launch_mega(const Params& base, int ph_lo, int ph_hi, int l_lo, int l_hi, hipStream_t stream) {
    Params p = base; p.ph_lo = ph_lo; p.ph_hi = ph_hi; p.l_lo = l_lo; p.l_hi = l_hi;
    hipLaunchKernelGGL(mega, dim3(host_state().grid), dim3(NTHR), LDS_TOTAL, stream, p);
}
extern "C" void kernel_launch(void* const* d_in, const int* in_sizes, int n_in, void* d_out, int out_size, void* d_ws, size_t ws_size,
                              hipStream_t stream) {
    HostState& hs = host_state();
    if (!hs.ok) return;
    Params P; memset(&P, 0, sizeof(P));
    size_t used = 0;
    setup_params(P, d_in, d_out, d_ws, ws_size, used);
    if (used > ws_size) return;
    (void)in_sizes; (void)n_in; (void)out_size;
    hipMemsetAsync(P.bar, 0, 16384, stream);
    launch_mega(P, 0, 11, 0, 2, stream);
}
```
